# Optimizing an MI355X kernel written in HIP

```python
import jax, jax.numpy as jnp
from jax import lax
import numpy as np

D_MODEL = 2048
BATCH = 16
SEQ = 256
DEPTH = 2
DEC_BATCH = 2
DEC_SEQ = 1024
PAST_LEN = 256

GRID_W = 64
HEAD_DIM = 128
N_Q_HEADS = 8
N_KV_HEADS = 2
Q_PER_KV = N_Q_HEADS // N_KV_HEADS
ATT_WIDTH = N_Q_HEADS * HEAD_DIM
KV_WIDTH = N_KV_HEADS * HEAD_DIM
HG_HEADS = 8
HG_DK = 128
HG_DV = 128
HG_KW = HG_HEADS * HG_DK
HG_VW = HG_HEADS * HG_DV
IN_AB = ATT_WIDTH + 2 * KV_WIDTH + 3 * HG_KW + 2 * HG_VW
MIX_WIDTH = ATT_WIDTH + HG_VW
N_AB_LAYERS = (DEPTH + 1) // 2
N_C_LAYERS = DEPTH // 2
POOL_WINDOWS = (2, 4, 8, 16)
POOL_GROUP = D_MODEL // len(POOL_WINDOWS)
D_FF = 4 * D_MODEL
Q_BLOCK = 128
HG_CHUNK = 16
ROPE_THETA = 10000.0
ROPE_HALF = HEAD_DIM // 2
EPS = 1e-6
N_MOD = 6

kernel_name = "hybrid_diffusion_prefix_ctx_step"


def rmsnorm(x, gain):
    xf = x.astype(jnp.float32)
    y = xf * lax.rsqrt(jnp.mean(xf * xf, axis=-1, keepdims=True) + EPS)
    return (y * gain.astype(jnp.float32)).astype(x.dtype)


def adaln_params(cvec, w_ada_l, b_ada_l):
    m = jax.nn.silu(cvec) @ w_ada_l + b_ada_l
    return jnp.split(m[:, None, :], N_MOD, axis=-1)


def modulate(x, gain, shift, scale):
    return rmsnorm(x, gain) * (1 + scale) + shift


def axial_rope(x):
    T = x.shape[1]
    rows = T // GRID_W
    row = jnp.repeat(jnp.arange(rows), GRID_W).astype(jnp.float32)
    col = jnp.tile(jnp.arange(GRID_W), rows).astype(jnp.float32)
    inv = ROPE_THETA ** (-jnp.arange(0, ROPE_HALF, 2, dtype=jnp.float32) / ROPE_HALF)
    ar = row[:, None] * inv
    ac = col[:, None] * inv
    ang = jnp.concatenate([ar, ar, ac, ac], axis=-1)
    bshape = (1, T) + (1,) * (x.ndim - 3) + (HEAD_DIM,)
    cos = jnp.cos(ang).reshape(bshape)
    sin = jnp.sin(ang).reshape(bshape)
    xf = x.astype(jnp.float32)
    a, b, c, d = jnp.split(xf, 4, axis=-1)
    rot = jnp.concatenate([-b, a, -d, c], axis=-1)
    return (xf * cos + rot * sin).astype(x.dtype)


def attend(q, k, v):
    B, Tq = q.shape[0], q.shape[1]
    nb = Tq // Q_BLOCK
    qb = jnp.moveaxis(q.reshape(B, nb, Q_BLOCK, N_KV_HEADS, Q_PER_KV, HEAD_DIM), 1, 0)
    scale = HEAD_DIM ** -0.5

    def one_block(qblk):
        s = jnp.einsum('bqhgd,bkhd->bhgqk', qblk, k).astype(jnp.float32) * scale
        p = jax.nn.softmax(s, axis=-1)
        return jnp.einsum('bhgqk,bkhd->bqhgd', p.astype(v.dtype), v)

    out = lax.map(one_block, qb)
    return jnp.moveaxis(out, 0, 1).reshape(B, Tq, ATT_WIDTH)


def hgrn_scan(q, logf, k, i, s0):
    B, T, H, _ = q.shape
    N = T // HG_CHUNK
    r = lambda a: a.reshape(B, N, HG_CHUNK, H, a.shape[-1])
    q, logf, k, i = r(q), r(logf), r(k), r(i)
    b = jnp.cumsum(logf, axis=2)
    mask = jnp.tril(jnp.ones((HG_CHUNK, HG_CHUNK), dtype=bool))
    diff = b[:, :, :, None] - b[:, :, None]
    decay = jnp.exp(jnp.where(mask[None, None, :, :, None, None], diff, -jnp.inf))
    att = jnp.einsum('bnthd,bnshd,bntshd->bnhts', q, k, decay)
    o = jnp.einsum('bnhts,bnshe->bnthe', att, i)
    b_last = b[:, :, -1]
    dS = jnp.einsum('bnshd,bnshe->bnhde', k * jnp.exp(b_last[:, :, None] - b), i)
    a = jnp.exp(b_last)

    def step(S, xs):
        a_n, dS_n = xs
        return a_n[..., None] * S + dS_n, S

    s_fin, s_starts = lax.scan(step, s0, (jnp.swapaxes(a, 0, 1), jnp.swapaxes(dS, 0, 1)))
    s_starts = jnp.swapaxes(s_starts, 0, 1)
    o = o + jnp.einsum('bnthd,bnhde->bnthe', q * jnp.exp(b), s_starts)
    return o.reshape(B, T, H, i.shape[-1]), s_fin


def mixer_ab(h, w_in, w_out, q_gain, k_gain, o_gain, lb, ctx_k=None, ctx_v=None, s0_f=None, s0_b=None):
    B, T, _ = h.shape
    latent = ctx_k is not None
    sizes = [ATT_WIDTH, KV_WIDTH, KV_WIDTH, HG_KW, HG_KW, HG_KW, HG_VW, HG_VW]
    pts, acc = [], 0
    for s in sizes[:-1]:
        acc += s
        pts.append(acc)
    q, k, v, hq, zf, zb, hi, hg = jnp.split(h @ w_in, pts, axis=-1)
    q = rmsnorm(q.reshape(B, T, N_KV_HEADS, Q_PER_KV, HEAD_DIM), q_gain)
    k = rmsnorm(k.reshape(B, T, N_KV_HEADS, HEAD_DIM), k_gain)
    v = v.reshape(B, T, N_KV_HEADS, HEAD_DIM)
    new_k, new_v = k, v
    if latent:
        q = axial_rope(q)
        k = jnp.concatenate([axial_rope(k), ctx_k.astype(k.dtype)], axis=1)
        v = jnp.concatenate([v, ctx_v.astype(v.dtype)], axis=1)
    att = attend(q, k, v)
    kshape = (B, T, HG_HEADS, HG_DK)
    hq = jax.nn.silu(hq.astype(jnp.float32)).reshape(kshape)
    f_f = lb[0] + (1 - lb[0]) * jax.nn.sigmoid(zf.astype(jnp.float32).reshape(kshape))
    f_b = lb[1] + (1 - lb[1]) * jax.nn.sigmoid(zb.astype(jnp.float32).reshape(kshape))
    iv = hi.astype(jnp.float32).reshape(B, T, HG_HEADS, HG_DV)
    if s0_f is None:
        s0_f = jnp.zeros((B, HG_HEADS, HG_DK, HG_DV), jnp.float32)
        s0_b = jnp.zeros((B, HG_HEADS, HG_DK, HG_DV), jnp.float32)
    o_f, s_f = hgrn_scan(hq, jnp.log(f_f), 1 - f_f, iv, s0_f.astype(jnp.float32))
    fl = lambda a: a[:, ::-1]
    o_b, s_b = hgrn_scan(fl(hq), fl(jnp.log(f_b)), fl(1 - f_b), fl(iv), s0_b.astype(jnp.float32))
    o = o_f + fl(o_b)
    o = rmsnorm(o, o_gain).reshape(B, T, HG_VW) * jax.nn.silu(hg.astype(jnp.float32))
    out = jnp.concatenate([att, o.astype(att.dtype)], axis=-1) @ w_out
    return out, (new_k, new_v, s_f.astype(h.dtype), s_b.astype(h.dtype))


def pool_mixer(h, w_pool_l, scale_l):
    B, T, _ = h.shape
    hf = h.astype(jnp.float32)
    cs = jnp.concatenate([jnp.zeros((B, 1, D_MODEL), jnp.float32), jnp.cumsum(hf, axis=1)], axis=1)
    t = jnp.arange(T)
    outs = []
    for g, w in enumerate(POOL_WINDOWS):
        lo_c, hi_c = g * POOL_GROUP, (g + 1) * POOL_GROUP
        lo = jnp.clip(t - w // 2, 0, T)
        hi = jnp.clip(t + w - w // 2, 0, T)
        csg = cs[:, :, lo_c:hi_c]
        mean = (csg[:, hi] - csg[:, lo]) / (hi - lo).astype(jnp.float32)[None, :, None]
        pooled = (mean - hf[:, :, lo_c:hi_c]).astype(h.dtype)
        outs.append(pooled @ w_pool_l[g])
    return jnp.concatenate(outs, axis=-1) * scale_l


def mlp(h, w1, w2):
    return jnp.square(jax.nn.relu(h @ w1)) @ w2


def setup_inputs(seed: int = 0) -> dict:
    key = jax.random.key(seed)
    ks = jax.random.split(key, 24)
    f32 = jnp.float32
    nrm = lambda k, shape, s=1.0: jax.random.normal(k, shape, f32) * s
    return {
        "x_prompt": nrm(ks[0], (BATCH, SEQ, D_MODEL)),
        "x_sample": nrm(ks[1], (DEC_BATCH, DEC_SEQ, D_MODEL)),
        "cache_k": nrm(ks[2], (DEC_BATCH, N_AB_LAYERS, PAST_LEN, N_KV_HEADS, HEAD_DIM)),
        "cache_v": nrm(ks[3], (DEC_BATCH, N_AB_LAYERS, PAST_LEN, N_KV_HEADS, HEAD_DIM)),
        "state_hgrn_fwd": nrm(ks[4], (DEC_BATCH, N_AB_LAYERS, HG_HEADS, HG_DK, HG_DV), 0.5),
        "state_hgrn_bwd": nrm(ks[5], (DEC_BATCH, N_AB_LAYERS, HG_HEADS, HG_DK, HG_DV), 0.5),
        "c": nrm(ks[6], (DEC_BATCH, D_MODEL)),
        "c_ctx": nrm(ks[7], (D_MODEL,)),
        "w_ada": nrm(ks[8], (DEPTH, D_MODEL, N_MOD * D_MODEL), 0.5 * D_MODEL ** -0.5),
        "b_ada": nrm(ks[9], (DEPTH, N_MOD * D_MODEL), 0.01),
        "norm_mix": 1.0 + nrm(ks[10], (DEPTH, D_MODEL), 0.02),
        "norm_mlp": 1.0 + nrm(ks[11], (DEPTH, D_MODEL), 0.02),
        "w_in_ab": nrm(ks[12], (N_AB_LAYERS, D_MODEL, IN_AB), D_MODEL ** -0.5),
        "w_out_ab": nrm(ks[13], (N_AB_LAYERS, MIX_WIDTH, D_MODEL), MIX_WIDTH ** -0.5),
        "q_norm": 1.0 + nrm(ks[14], (N_AB_LAYERS, HEAD_DIM), 0.02),
        "k_norm": 1.0 + nrm(ks[15], (N_AB_LAYERS, HEAD_DIM), 0.02),
        "hg_norm": 1.0 + nrm(ks[16], (N_AB_LAYERS, HG_DV), 0.02),
        "lb_raw": nrm(ks[17], (2, DEPTH + 1, HG_KW), 0.5),
        "w_pool": nrm(ks[18], (N_C_LAYERS, len(POOL_WINDOWS), POOL_GROUP, POOL_GROUP), POOL_GROUP ** -0.5),
        "pool_scale": 1.0 + nrm(ks[19], (N_C_LAYERS, D_MODEL), 0.1),
        "w_mlp_in": nrm(ks[20], (DEPTH, D_MODEL, D_FF), D_MODEL ** -0.5),
        "w_mlp_out": nrm(ks[21], (DEPTH, D_FF, D_MODEL), D_FF ** -0.5),
        "final_norm": 1.0 + nrm(ks[22], (D_MODEL,), 0.02),
    }


def reference(x_prompt, x_sample, cache_k, cache_v, state_hgrn_fwd, state_hgrn_bwd, c, c_ctx,
              w_ada, b_ada, norm_mix, norm_mlp, w_in_ab, w_out_ab, q_norm, k_norm, hg_norm, lb_raw,
              w_pool, pool_scale, w_mlp_in, w_mlp_out, final_norm):
    lb_all = jnp.cumsum(jax.nn.softmax(lb_raw.astype(jnp.float32), axis=1), axis=1)

    def run_stream(x, cvec, ctx):
        states = []
        for l in range(DEPTH):
            sh1, sc1, g1, sh2, sc2, g2 = adaln_params(cvec, w_ada[l], b_ada[l])
            h = modulate(x, norm_mix[l], sh1, sc1)
            j = l // 2
            if l % 2 == 0:
                lb_l = lb_all[:, l].reshape(2, HG_HEADS, HG_DK)
                if ctx is None:
                    mix, st = mixer_ab(h, w_in_ab[j], w_out_ab[j], q_norm[j], k_norm[j], hg_norm[j], lb_l)
                else:
                    mix, st = mixer_ab(h, w_in_ab[j], w_out_ab[j], q_norm[j], k_norm[j], hg_norm[j], lb_l,
                                       ctx_k=ctx[0][:, j], ctx_v=ctx[1][:, j],
                                       s0_f=ctx[2][:, j], s0_b=ctx[3][:, j])
                states.append(st)
            else:
                mix = pool_mixer(h, w_pool[j], pool_scale[j])
            x = x + g1 * mix
            h = modulate(x, norm_mlp[l], sh2, sc2)
            x = x + g2 * mlp(h, w_mlp_in[l], w_mlp_out[l])
        return rmsnorm(x, final_norm), states

    y_prompt, st_p = run_stream(x_prompt, c_ctx[None, :], None)
    y_sample, _ = run_stream(x_sample, c, (cache_k, cache_v, state_hgrn_fwd, state_hgrn_bwd))

    new_k = jnp.stack([s[0] for s in st_p], axis=1)
    new_v = jnp.stack([s[1] for s in st_p], axis=1)
    new_s_fwd = jnp.stack([s[2] for s in st_p], axis=1)
    new_s_bwd = jnp.stack([s[3] for s in st_p], axis=1)
    return (y_prompt, y_sample, new_k, new_v, new_s_fwd, new_s_bwd)
```

```cpp
#include <hip/hip_runtime.h>
#include <hip/hip_bf16.h>
#include <cstdio>
#include <cstdint>

#ifndef MK_PER_PHASE
#define MK_PER_PHASE 0
#endif

constexpr int DM = 2048, NTOK_P = 4096, NTOK_S = 2048, NTOK = 6144, SEQ_P = 256, SEQ_S = 1024, NB_P = 16, NB_S = 2, PAST = 256;
constexpr int IN_AB = 6656, DFF = 8192, NMODC = 12288;
constexpr int C_Q = 0, C_K = 1024, C_V = 1280, C_HQ = 1536, C_ZF = 2560, C_ZB = 3584, C_HI = 4608, C_HG = 5632;
constexpr float EPS = 1e-6f;

#define GAS __attribute__((address_space(1)))
#define LAS __attribute__((address_space(3)))
typedef unsigned short bf16_t;
typedef short bf16x8 __attribute__((ext_vector_type(8)));
typedef short s16x4 __attribute__((ext_vector_type(4)));
typedef float f32x4 __attribute__((ext_vector_type(4)));
typedef float f32x2 __attribute__((ext_vector_type(2)));
typedef float f32x16 __attribute__((ext_vector_type(16)));
typedef unsigned u32x4 __attribute__((ext_vector_type(4)));
typedef unsigned u32x2 __attribute__((ext_vector_type(2)));
typedef __bf16 bf16x2_t __attribute__((ext_vector_type(2)));
typedef GAS unsigned gu32;

__device__ __forceinline__ unsigned cvtpk(float lo, float hi) { f32x2 v = {lo, hi}; bf16x2_t b = __builtin_convertvector(v, bf16x2_t); return __builtin_bit_cast(unsigned, b); }
__device__ __forceinline__ float bf2f(unsigned short u) { return __uint_as_float(((unsigned)u) << 16); }
__device__ __forceinline__ float bflo(unsigned u) { return __uint_as_float(u << 16); }
__device__ __forceinline__ float bfhi(unsigned u) { return __uint_as_float(u & 0xffff0000u); }
__device__ __forceinline__ float siluf(float x) { return x / (1.f + __expf(-x)); }
__device__ __forceinline__ float wave_sum(float v) {
#pragma unroll
    for (int o = 1; o < 64; o <<= 1) v += __shfl_xor(v, o);
    return v;
}
__device__ __forceinline__ float half_sum(float v) {
#pragma unroll
    for (int o = 1; o < 32; o <<= 1) v += __shfl_xor(v, o);
    return v;
}

namespace pg8 {
#define PG8_LAS __attribute__((address_space(3)))
constexpr int BM = 256, BK = 64, HALF = 128, HTB = HALF * BK * 2, STAGE_BYTES = 8 * HTB, NXCD = 8, WGM = 8;
__host__ __device__ __forceinline__ int lds_byte(int r, int c) { const int st = (r >> 4) * 2 + (c >> 5), rr = r & 15, cc = c & 31, ob = rr * 64 + cc * 2; return st * 1024 + (ob ^ (((ob >> 9) & 1) << 5)); }
__host__ __device__ __forceinline__ void stage_rc(int b, int& R, int& C) { const int st = b / 1024, sb = b % 1024, swz = sb ^ (((sb >> 9) & 1) << 5); R = (st >> 1) * 16 + swz / 64; C = (st & 1) * 32 + (swz % 64) / 2; }
__host__ __device__ __forceinline__ int perm32(int rho) { const int n = rho >> 4, i = rho & 15; return 8 * (i >> 2) + 4 * n + (i & 3); }

struct Unit { int pm, pn; };
struct Gemm { const bf16_t* A; const bf16_t* Bt; int M, N, K, lda, ldb, apn_shift, apn_mul; };

struct StaticOrder {
    int nM, nN, nwg, G, c;
    __host__ __device__ void init(int M, int N, int G_, int c_) { nM = M / BM; nN = N / BM; nwg = nM * nN; G = G_; c = c_; }
    __host__ __device__ bool next(int i, Unit& u) const {
        const long L = (long)i * G + c; if (L >= nwg) return false;
        int wgid = (int)L; { const int q = nwg / NXCD, r = nwg % NXCD, xcd = wgid % NXCD, off = wgid / NXCD; wgid = (xcd < r ? xcd * (q + 1) : r * (q + 1) + (xcd - r) * q) + off; }
        const int nig = WGM * nN, gid = wgid / nig, fm = gid * WGM, gsz = (nM - fm) < WGM ? (nM - fm) : WGM;
        u.pm = fm + ((wgid % nig) % gsz); u.pn = (wgid % nig) / gsz; return true;
    }
};

template <class Epi, bool ALIGN_EPI = true>
__device__ __forceinline__ void gemm_phase(PG8_LAS unsigned char* lds, const Gemm g, const StaticOrder& S, const Epi& E) {
    const int tid = threadIdx.x, wid = __builtin_amdgcn_readfirstlane(tid >> 6), lane = tid & 63, wr = wid >> 2, wc = wid & 3, fr = lane & 15, fq = lane >> 4;
    const int K = g.K, nt = K / BK;
    unsigned voffA[2], voffB[2];
#pragma unroll
    for (int i = 0; i < 2; ++i) { int R, C; stage_rc(tid * 16 + i * 8192, R, C); const int Rb = Epi::PERM ? ((R & ~31) + perm32(R & 31)) : R;
        voffA[i] = (unsigned)(R * g.lda + C) * 2u; voffB[i] = (unsigned)(Rb * g.ldb + C) * 2u; }
    const size_t kstep = (size_t)(BK * 2);
    const size_t hstepA = (size_t)HALF * g.lda * 2, hstepB = (size_t)HALF * g.ldb * 2;
    const size_t tstepA = 2 * hstepA, tstepB = 2 * hstepB;
    const unsigned ldsw = (unsigned)wid * 1024u;
    const int aoff = lds_byte(wr * 64 + fr, fq * 8), boff = lds_byte(wc * 32 + fr, fq * 8);
#define PG8_SA(b, h) (((b) * 2 + (h)) * HTB)
#define PG8_SB(b, h) ((4 + (b) * 2 + (h)) * HTB)
#define PG8_STAGE(bufoff, gbase, voff) do { _Pragma("unroll") for (int _i = 0; _i < 2; ++_i) \
        __builtin_amdgcn_global_load_lds((const unsigned*)((const char*)(gbase) + (voff)[_i]), (PG8_LAS unsigned*)(lds + (bufoff) + ldsw + _i * 8192), 16, 0, 0); } while (0)
#define PG8_LDA(dst, b, h) do { _Pragma("unroll") for (int m = 0; m < 4; ++m) _Pragma("unroll") for (int k = 0; k < 2; ++k) dst[m][k] = *(const PG8_LAS bf16x8*)(lds + PG8_SA(b, h) + aoff + m * 2048 + k * 1024); } while (0)
#define PG8_LDB(dst, b, h) do { _Pragma("unroll") for (int n = 0; n < 2; ++n) _Pragma("unroll") for (int k = 0; k < 2; ++k) dst[n][k] = *(const PG8_LAS bf16x8*)(lds + PG8_SB(b, h) + boff + n * 2048 + k * 1024); } while (0)
#define PG8_MMA(ai, bj, At, Bt) do { __builtin_amdgcn_s_setprio(1); _Pragma("unroll") for (int m = 0; m < 4; ++m) _Pragma("unroll") for (int n = 0; n < 2; ++n) _Pragma("unroll") for (int k = 0; k < 2; ++k) \
        acc[ai][bj][m][n] = __builtin_amdgcn_mfma_f32_16x16x32_bf16(Bt[n][k], At[m][k], acc[ai][bj][m][n], 0, 0, 0); __builtin_amdgcn_s_setprio(0); } while (0)
#define PG8_WAIT_V(n) asm volatile("s_waitcnt vmcnt(" #n ")" ::: "memory")
#define PG8_WAIT_L(n) asm volatile("s_waitcnt lgkmcnt(" #n ")" ::: "memory")
#define PG8_BAR __builtin_amdgcn_s_barrier()
#define PG8_SCHED __builtin_amdgcn_sched_barrier(0)
#define PG8_AOFF(u) ((size_t)(((u).pn >> g.apn_shift) * g.apn_mul) * 2)
    Unit cur, nxt; int ui = 0;
    if (!S.next(0, cur)) return;
    f32x4 acc[2][2][4][2];
#pragma unroll
    for (int a = 0; a < 2; ++a)
#pragma unroll
        for (int b = 0; b < 2; ++b)
#pragma unroll
            for (int m = 0; m < 4; ++m)
#pragma unroll
                for (int n = 0; n < 2; ++n) acc[a][b][m][n] = (f32x4){0.f, 0.f, 0.f, 0.f};
    bf16x8 At[4][2], B0[2][2], B1[2][2];
    const char* cA = (const char*)g.A + (size_t)cur.pm * tstepA + PG8_AOFF(cur); const char* cB = (const char*)g.Bt + (size_t)cur.pn * tstepB;
    {
        PG8_STAGE(PG8_SB(0, 0), cB, voffB); PG8_STAGE(PG8_SB(0, 1), cB + hstepB, voffB); PG8_STAGE(PG8_SA(0, 0), cA, voffA); PG8_STAGE(PG8_SA(0, 1), cA + hstepA, voffA);
        if (wr == 1) PG8_BAR;
        PG8_WAIT_V(2); PG8_BAR;
        PG8_STAGE(PG8_SB(1, 0), cB + kstep, voffB); PG8_STAGE(PG8_SA(1, 0), cA + kstep, voffA); PG8_STAGE(PG8_SB(1, 1), cB + hstepB + kstep, voffB);
        PG8_WAIT_V(6); PG8_BAR;
    }
    for (;;) {
        const bool has_next = S.next(ui + 1, nxt);
        const char* nA = has_next ? (const char*)g.A + (size_t)nxt.pm * tstepA + PG8_AOFF(nxt) : cA; const char* nB = has_next ? (const char*)g.Bt + (size_t)nxt.pn * tstepB : cB;
        for (int t = 0; t < nt; t += 2) {
            const bool last = (t == nt - 2);
            const char* a1 = cA + (size_t)(t + 1) * kstep;
            const char* a2 = last ? nA : cA + (size_t)(t + 2) * kstep; const char* b2 = last ? nB : cB + (size_t)(t + 2) * kstep;
            const char* a3 = a2 + kstep; const char* b3 = b2 + kstep;
            PG8_LDB(B0, 0, 0); PG8_LDB(B1, 0, 1); PG8_SCHED; PG8_LDA(At, 0, 0); PG8_STAGE(PG8_SA(1, 1), a1 + hstepA, voffA);
            PG8_WAIT_V(8); PG8_WAIT_L(0); PG8_BAR; PG8_MMA(0, 0, At, B0); PG8_MMA(0, 1, At, B1); PG8_BAR; PG8_SCHED;
            PG8_LDA(At, 0, 1); PG8_STAGE(PG8_SB(0, 0), b2, voffB); PG8_STAGE(PG8_SB(0, 1), b2 + hstepB, voffB); PG8_STAGE(PG8_SA(0, 0), a2, voffA);
            PG8_WAIT_V(8); PG8_WAIT_L(0); PG8_BAR; PG8_MMA(1, 0, At, B0); PG8_MMA(1, 1, At, B1); PG8_BAR; PG8_SCHED;
            PG8_LDB(B0, 1, 0); PG8_LDB(B1, 1, 1); PG8_SCHED; PG8_LDA(At, 1, 0); PG8_STAGE(PG8_SA(0, 1), a2 + hstepA, voffA);
            PG8_WAIT_V(8); PG8_WAIT_L(0); PG8_BAR; PG8_MMA(0, 0, At, B0); PG8_MMA(0, 1, At, B1); PG8_BAR; PG8_SCHED;
            PG8_LDA(At, 1, 1); PG8_STAGE(PG8_SB(1, 0), b3, voffB); PG8_STAGE(PG8_SB(1, 1), b3 + hstepB, voffB); PG8_STAGE(PG8_SA(1, 0), a3, voffA);
            PG8_WAIT_V(8); PG8_WAIT_L(0); PG8_BAR; PG8_MMA(1, 0, At, B0); PG8_MMA(1, 1, At, B1); PG8_BAR; PG8_SCHED;
        }
        if constexpr (ALIGN_EPI) { if (wr == 0) PG8_BAR; }
        E(acc, cur, wr, wc, fr, fq);
        if (!has_next) break;
#pragma unroll
        for (int a = 0; a < 2; ++a)
#pragma unroll
            for (int b = 0; b < 2; ++b)
#pragma unroll
                for (int m = 0; m < 4; ++m)
#pragma unroll
                    for (int n = 0; n < 2; ++n) acc[a][b][m][n] = (f32x4){0.f, 0.f, 0.f, 0.f};
        cur = nxt; cA = nA; cB = nB; ++ui;
        if constexpr (ALIGN_EPI) { if (wr == 1) PG8_BAR; }
    }
    PG8_WAIT_V(0);
    if constexpr (!ALIGN_EPI) { if (wr == 0) PG8_BAR; }
    PG8_BAR;
#undef PG8_SA
#undef PG8_SB
#undef PG8_STAGE
#undef PG8_LDA
#undef PG8_LDB
#undef PG8_MMA
#undef PG8_WAIT_V
#undef PG8_WAIT_L
#undef PG8_BAR
#undef PG8_SCHED
#undef PG8_AOFF
}
}

constexpr size_t MiB = 1u << 20;
constexpr size_t WS_CTL = 0, CTL_ZERO_BYTES = 64 * 1024;
constexpr size_t WS_MOD = 1 * MiB;
constexpr size_t WS_WIN = 2 * MiB;
constexpr size_t WS_WOUT = 28 * MiB;
constexpr size_t WS_WPOOL = 36 * MiB;
constexpr size_t WS_WM1 = 38 * MiB;
constexpr size_t WS_WM2 = 102 * MiB;
constexpr size_t WS_H = 166 * MiB;
constexpr size_t WS_ZB = 190 * MiB;
constexpr size_t WS_LF = 268 * MiB;
constexpr size_t WS_QN = 316 * MiB;
constexpr size_t WS_KP = 328 * MiB;
constexpr size_t WS_VP = 330 * MiB;
constexpr size_t WS_KS = 332 * MiB;
constexpr size_t WS_VS = 334 * MiB;
constexpr size_t WS_OF = 336 * MiB;
constexpr size_t WS_OB = 360 * MiB;
constexpr size_t WS_A2 = 384 * MiB;
constexpr size_t WS_XA = 408 * MiB;
constexpr size_t WS_U = 456 * MiB;
constexpr size_t WS_END = 552 * MiB;
constexpr int CW_BAR = 1024;

constexpr int RING_BYTES = 131072, LDSCTL_OFF = RING_BYTES, MISC_OFF = LDSCTL_OFF + 320, LDS_BYTES = 147456;
constexpr int NWAVES = 8;

#define RLX_AGENT __ATOMIC_RELAXED, __HIP_MEMORY_SCOPE_AGENT
#define LDS_WAIT() asm volatile("s_waitcnt lgkmcnt(0)" ::: "memory")
#define VM_WAIT() asm volatile("s_waitcnt vmcnt(0)" ::: "memory")

#define XB_TMO      128
#define XB_XCNT(j)  (256  + 64 * (j))
#define XB_XSUB(j)  (1280 + 64 * (j))
#define XB_XGEN(j)  (2304 + 64 * (j))
#define XB_TOP      3328
#define XB_TOPGEN   3392
#define XCD_BAR_WORDS 3456
#define XB_SPIN_CAP (1u << 18)
__device__ __forceinline__ unsigned xb_ld(unsigned* p)              { return __hip_atomic_load(p, __ATOMIC_RELAXED, __HIP_MEMORY_SCOPE_AGENT); }
__device__ __forceinline__ unsigned xb_add(unsigned* p, unsigned v) { return __hip_atomic_fetch_add(p, v, __ATOMIC_RELAXED, __HIP_MEMORY_SCOPE_AGENT); }
__device__ __forceinline__ unsigned xb_xcc_id() { return (unsigned)__builtin_amdgcn_s_getreg((3 << 11) | 20) & 0xFu; }
#define XB_SPIN(cond, bar) do { unsigned _sp = 0; while (cond) { __builtin_amdgcn_s_sleep(1); \
    if ((++_sp & 255u) == 0u) { if (xb_ld(&(bar)[XB_TMO])) break; if (_sp > XB_SPIN_CAP) { atomicAdd(&(bar)[XB_TMO], 1u); break; } } } } while (0)
struct XcdBarrier { unsigned* bar; unsigned x; volatile LAS unsigned* st; };
__device__ __forceinline__ XcdBarrier xcd_barrier_post(unsigned* bar, volatile LAS unsigned* st) {
    XcdBarrier b; b.bar = bar; b.x = xb_xcc_id(); b.st = st;
    if (threadIdx.x == 0) (void)xb_add(&bar[XB_XCNT(b.x)], 1u);
    return b;
}
__device__ __forceinline__ void xcd_barrier_complete(unsigned* bar, unsigned x, unsigned& nloc, unsigned& nx) {
    const unsigned G = gridDim.x * gridDim.y * gridDim.z;
    unsigned sum, cnt, mine, sp = 0u;
    for (;;) {
        sum = 0u; cnt = 0u; mine = 0u;
#pragma unroll
        for (unsigned j = 0; j < 16; ++j) { const unsigned c = xb_ld(&bar[XB_XCNT(j)]); sum += c; cnt += (c > 0u) ? 1u : 0u; mine = (j == x) ? c : mine; }
        if (sum == G) break;
        __builtin_amdgcn_s_sleep(1);
        if ((++sp & 255u) == 0u) { if (xb_ld(&bar[XB_TMO])) break; if (sp > XB_SPIN_CAP) { atomicAdd(&bar[XB_TMO], 1u); break; } }
    }
    nloc = mine > 0u ? mine : 1u; nx = cnt > 0u ? cnt : 1u;
}
__device__ __forceinline__ void xcd_barrier(const XcdBarrier& b) {
    asm volatile("s_waitcnt vmcnt(0)" ::: "memory");
    __syncthreads();
    if (threadIdx.x == 0) {
        unsigned* bar = b.bar;
        __builtin_amdgcn_s_waitcnt(0);
        unsigned nloc = b.st[0], nx = b.st[1];
        if (nloc == 0u) { xcd_barrier_complete(bar, b.x, nloc, nx); b.st[0] = nloc; b.st[1] = nx; }
        const unsigned old = xb_add(&bar[XB_XSUB(b.x)], 1u);
        const unsigned gen = old / nloc;
        if (old + 1u == (gen + 1u) * nloc) {
            __builtin_amdgcn_fence(__ATOMIC_RELEASE, "agent");
            asm volatile("s_waitcnt vmcnt(0)" ::: "memory");
            const unsigned og = xb_add(&bar[XB_TOP], 1u);
            const unsigned tg = og / nx;
            if (og + 1u == (tg + 1u) * nx) xb_add(&bar[XB_TOPGEN], 1u);
            else XB_SPIN(xb_ld(&bar[XB_TOPGEN]) == tg, bar);
            __builtin_amdgcn_fence(__ATOMIC_ACQUIRE, "agent");
            xb_add(&bar[XB_XGEN(b.x)], 1u);
            asm volatile("s_waitcnt vmcnt(0)" ::: "memory");
        } else {
            XB_SPIN(xb_ld(&bar[XB_XGEN(b.x)]) == gen, bar);
            __builtin_amdgcn_fence(__ATOMIC_ACQUIRE, "agent");
            asm volatile("s_waitcnt vmcnt(0)" ::: "memory");
        }
    }
    __syncthreads();
}

struct Args { const float* in[23]; float* out; unsigned char* ws; int ph_lo, ph_hi; };

__device__ __forceinline__ int cvec_of_row(int row) { return row < NTOK_P ? 0 : 1 + ((row - NTOK_P) >> 10); }
__device__ __forceinline__ const float* xin_row(const Args& a, int row) { return row < NTOK_P ? a.in[0] + (size_t)row * DM : a.in[1] + (size_t)(row - NTOK_P) * DM; }

struct EpiIn {
    static constexpr bool PERM = true;
    bf16_t* ZB; float* LF; const float* lb_raw;
    __device__ __forceinline__ void operator()(const f32x4 (&acc)[2][2][4][2], const pg8::Unit& u, int wr, int wc, int fr, int fq) const {
        const int row0 = u.pm * 256 + wr * 64 + fr, colt = u.pn * 256, cl = wc * 32 + 8 * fq;
        if (colt >= C_ZF && colt < C_HI) {
#pragma unroll
            for (int bj = 0; bj < 2; ++bj) {
                const int c2 = colt + bj * 128 + cl - C_ZF, dir = c2 >> 10, ch = c2 & 1023;
                float lb[8];
#pragma unroll
                for (int e = 0; e < 8; ++e) { const float x0 = lb_raw[dir * 3072 + ch + e], x1 = lb_raw[dir * 3072 + 1024 + ch + e], x2 = lb_raw[dir * 3072 + 2048 + ch + e];
                    lb[e] = 1.f / (1.f + __expf(x1 - x0) + __expf(x2 - x0)); }
#pragma unroll
                for (int ai = 0; ai < 2; ++ai)
#pragma unroll
                    for (int m = 0; m < 4; ++m) {
                        float* dst = LF + (size_t)(row0 + ai * 128 + m * 16) * 2048 + c2;
                        f32x4 o[2];
#pragma unroll
                        for (int n = 0; n < 2; ++n)
#pragma unroll
                            for (int e = 0; e < 4; ++e) { const float z = acc[ai][bj][m][n][e], sg = 1.f / (1.f + __expf(-z)), l = lb[n * 4 + e]; o[n][e] = __logf(l + (1.f - l) * sg); }
                        *(f32x4*)dst = o[0]; *(f32x4*)(dst + 4) = o[1];
                    }
            }
        } else {
            const bool act = (colt >= C_HQ && colt < C_ZF) || colt >= C_HG;
#pragma unroll
            for (int ai = 0; ai < 2; ++ai)
#pragma unroll
                for (int m = 0; m < 4; ++m) {
                    bf16_t* rowp = ZB + (size_t)(row0 + ai * 128 + m * 16) * IN_AB + colt + cl;
#pragma unroll
                    for (int bj = 0; bj < 2; ++bj) { f32x4 v0 = acc[ai][bj][m][0], v1 = acc[ai][bj][m][1];
                        if (act) {
#pragma unroll
                            for (int e = 0; e < 4; ++e) { v0[e] = siluf(v0[e]); v1[e] = siluf(v1[e]); } }
                        u32x4 w; w.x = cvtpk(v0[0], v0[1]); w.y = cvtpk(v0[2], v0[3]); w.z = cvtpk(v1[0], v1[1]); w.w = cvtpk(v1[2], v1[3]);
                        *(u32x4*)(rowp + bj * 128) = w; }
                }
        }
    }
};
struct EpiRes {
    static constexpr bool PERM = false;
    const float* baseP; const float* baseS; float* out; const float* gate; const float* pscale;
    __device__ __forceinline__ void operator()(const f32x4 (&acc)[2][2][4][2], const pg8::Unit& u, int wr, int wc, int fr, int fq) const {
        const int col0 = u.pn * 256 + wc * 32 + 4 * fq;
        const int cv = u.pm < 16 ? 0 : 1 + ((u.pm - 16) >> 2);
        const float* gp = gate + (size_t)cv * 2 * NMODC;
        const float* bp = u.pm < 16 ? baseP + (size_t)u.pm * 256 * DM : baseS + (size_t)(u.pm - 16) * 256 * DM;
        float* op = out + (size_t)u.pm * 256 * DM;
#pragma unroll
        for (int bj = 0; bj < 2; ++bj)
#pragma unroll
            for (int n = 0; n < 2; ++n) {
                const int col = col0 + bj * 128 + n * 16;
                f32x4 g4 = *(const f32x4*)(gp + col);
                if (pscale) g4 = g4 * *(const f32x4*)(pscale + col);
#pragma unroll
                for (int ai = 0; ai < 2; ++ai)
#pragma unroll
                    for (int m = 0; m < 4; ++m) { const size_t off = (size_t)(ai * 128 + wr * 64 + m * 16 + fr) * DM + col;
                        const f32x4 b = *(const f32x4*)(bp + off); *(f32x4*)(op + off) = b + g4 * acc[ai][bj][m][n]; }
            }
    }
};
struct EpiRelu2 {
    static constexpr bool PERM = true;
    bf16_t* U;
    __device__ __forceinline__ void operator()(const f32x4 (&acc)[2][2][4][2], const pg8::Unit& u, int wr, int wc, int fr, int fq) const {
        const int row0 = u.pm * 256 + wr * 64 + fr, col0 = u.pn * 256 + wc * 32 + 8 * fq;
#pragma unroll
        for (int ai = 0; ai < 2; ++ai)
#pragma unroll
            for (int m = 0; m < 4; ++m) { bf16_t* rowp = U + (size_t)(row0 + ai * 128 + m * 16) * DFF + col0;
#pragma unroll
                for (int bj = 0; bj < 2; ++bj) { f32x4 v0 = acc[ai][bj][m][0], v1 = acc[ai][bj][m][1];
#pragma unroll
                    for (int e = 0; e < 4; ++e) { const float a = fmaxf(v0[e], 0.f), b = fmaxf(v1[e], 0.f); v0[e] = a * a; v1[e] = b * b; }
                    u32x4 w; w.x = cvtpk(v0[0], v0[1]); w.y = cvtpk(v0[2], v0[3]); w.z = cvtpk(v1[0], v1[1]); w.w = cvtpk(v1[2], v1[3]);
                    *(u32x4*)(rowp + bj * 128) = w; } }
    }
};

__device__ __forceinline__ void p0_transpose_item(const float* W, int K, int N, bf16_t* WT, int row_off, LAS float* scr, int item, int lane) {
    const int nblk = N / 32, kb = item / nblk, nb = item % nblk, k0 = 64 * kb, n0 = 32 * nb;
#pragma unroll 8
    for (int i = 0; i < 32; ++i) { const int kk = 2 * i + (lane >> 5); scr[kk * 33 + (lane & 31)] = W[(size_t)(k0 + kk) * N + n0 + (lane & 31)]; }
    LDS_WAIT(); asm volatile("" ::: "memory");
    const int c = lane & 7;
#pragma unroll
    for (int j = 0; j < 4; ++j) { const int n = (lane >> 3) + 8 * j; const LAS float* s = scr + (8 * c) * 33 + n;
        u32x4 o; o.x = cvtpk(s[0 * 33], s[1 * 33]); o.y = cvtpk(s[2 * 33], s[3 * 33]); o.z = cvtpk(s[4 * 33], s[5 * 33]); o.w = cvtpk(s[6 * 33], s[7 * 33]);
        *(u32x4*)(WT + (size_t)(row_off + n0 + n) * K + k0 + 8 * c) = o; }
    LDS_WAIT(); asm volatile("" ::: "memory");
}
__device__ __forceinline__ void p0_ada_item(const Args& a, LAS unsigned char* lds, int wi, int tid) {
    LAS float* sc = (LAS float*)lds;
    LAS float* red = (LAS float*)(lds + 24576);
    const int l = wi >> 7, col0 = 96 * (wi & 127);
    for (int i = tid; i < 3 * 2048; i += 512) { const int v = i >> 11, k = i & 2047; const float x = v == 0 ? a.in[7][k] : a.in[6][(v - 1) * 2048 + k]; sc[i] = siluf(x); }
    __syncthreads();
    const int c4 = tid % 24, r = tid / 24;
    if (r < 21) {
        f32x4 a0 = {0.f, 0.f, 0.f, 0.f}, a1 = a0, a2 = a0;
        const float* wp = a.in[8] + (size_t)l * 2048 * NMODC + col0 + 4 * c4;
#pragma unroll 4
        for (int k = r; k < 2048; k += 21) { const f32x4 w = *(const f32x4*)(wp + (size_t)k * NMODC); a0 += w * sc[k]; a1 += w * sc[2048 + k]; a2 += w * sc[4096 + k]; }
        LAS float* rp = red + (r * 24 + c4) * 12;
        *(LAS f32x4*)rp = a0; *(LAS f32x4*)(rp + 4) = a1; *(LAS f32x4*)(rp + 8) = a2;
    }
    __syncthreads();
    if (tid < 288) { const int v = tid / 96, c = tid % 96; float s = 0.f;
        for (int rr = 0; rr < 21; ++rr) s += red[(rr * 24 + (c >> 2)) * 12 + v * 4 + (c & 3)];
        float* mod = (float*)(a.ws + WS_MOD);
        mod[(size_t)v * 2 * NMODC + l * NMODC + col0 + c] = s + a.in[9][l * NMODC + col0 + c]; }
    __syncthreads();
}

__device__ __forceinline__ void norm_rows_bf16(const Args& a, const float* xa  , const float* gain, int layer, int soff, bf16_t* H, int gw, int ngw, int lane) {
    const float* mod = (const float*)(a.ws + WS_MOD);
    for (int row = gw; row < NTOK; row += ngw) {
        const float* xr = xa ? xa + (size_t)row * DM : xin_row(a, row);
        const float* mp = mod + (size_t)cvec_of_row(row) * 2 * NMODC + layer * NMODC + soff;
        f32x4 v[8]; float ss = 0.f;
#pragma unroll
        for (int j = 0; j < 8; ++j) { v[j] = *(const f32x4*)(xr + 4 * (lane + 64 * j)); ss += v[j].x * v[j].x + v[j].y * v[j].y + v[j].z * v[j].z + v[j].w * v[j].w; }
        const float rstd = rsqrtf(wave_sum(ss) * (1.f / DM) + EPS);
#pragma unroll
        for (int j = 0; j < 8; ++j) { const int c = 4 * (lane + 64 * j);
            const f32x4 g = *(const f32x4*)(gain + c), sh = *(const f32x4*)(mp + c), sc = *(const f32x4*)(mp + 2048 + c);
            const f32x4 y = v[j] * rstd * g * (sc + 1.f) + sh;
            u32x2 w; w.x = cvtpk(y.x, y.y); w.y = cvtpk(y.z, y.w);
            *(u32x2*)(H + (size_t)row * DM + c) = w; }
    }
}
__device__ __forceinline__ void norm_rows_f32(const Args& a, const float* xa, const float* gain, int layer, int soff  , float* O, int gw, int ngw, int lane) {
    const float* mod = (const float*)(a.ws + WS_MOD);
    for (int row = gw; row < NTOK; row += ngw) {
        const float* xr = xa + (size_t)row * DM;
        const float* mp = mod + (size_t)cvec_of_row(row) * 2 * NMODC + layer * NMODC + (soff < 0 ? 0 : soff);
        f32x4 v[8]; float ss = 0.f;
#pragma unroll
        for (int j = 0; j < 8; ++j) { v[j] = *(const f32x4*)(xr + 4 * (lane + 64 * j)); ss += v[j].x * v[j].x + v[j].y * v[j].y + v[j].z * v[j].z + v[j].w * v[j].w; }
        const float rstd = rsqrtf(wave_sum(ss) * (1.f / DM) + EPS);
#pragma unroll
        for (int j = 0; j < 8; ++j) { const int c = 4 * (lane + 64 * j);
            const f32x4 g = *(const f32x4*)(gain + c);
            f32x4 y = v[j] * rstd * g;
            if (soff >= 0) { const f32x4 sh = *(const f32x4*)(mp + c), sc = *(const f32x4*)(mp + 2048 + c); y = y * (sc + 1.f) + sh; }
            *(f32x4*)(O + (size_t)row * DM + c) = y; }
    }
}
__device__ __forceinline__ void pool_items(const float* H3, bf16_t* P, int gw, int ngw, int lane) {
    for (int it = gw; it < NTOK * 8; it += ngw) {
        const int row = it >> 3, cb = it & 7, c = cb * 256 + lane * 4, g = cb >> 1, hw = 1 << g;
        int s0, T, t;
        if (row < NTOK_P) { s0 = row & ~255; T = SEQ_P; t = row & 255; } else { s0 = NTOK_P + ((row - NTOK_P) & ~1023); T = SEQ_S; t = (row - NTOK_P) & 1023; }
        const int lo = max(t - hw, 0), hi = min(t + hw, T);
        f32x4 s = {0.f, 0.f, 0.f, 0.f};
        for (int u = lo; u < hi; ++u) s += *(const f32x4*)(H3 + (size_t)(s0 + u) * DM + c);
        const f32x4 x = *(const f32x4*)(H3 + (size_t)row * DM + c);
        const f32x4 y = s * (1.f / (float)(hi - lo)) - x;
        u32x2 w; w.x = cvtpk(y.x, y.y); w.y = cvtpk(y.z, y.w);
        *(u32x2*)(P + (size_t)row * DM + c) = w;
    }
}

__device__ __forceinline__ void post_token(const Args& a, int row, int lane) {
    const bf16_t* ZB = (const bf16_t*)(a.ws + WS_ZB);
    bf16_t* QN = (bf16_t*)(a.ws + WS_QN);
    const bool samp = row >= NTOK_P;
    const int bb = samp ? (row - NTOK_P) >> 10 : row >> 8, t = samp ? (row - NTOK_P) & 1023 : row & 255;
    const int e0 = (lane & 31) * 4, hsel = lane >> 5;
    const int sect = e0 >> 5;
    float cs[4], sn[4];
    if (samp) {
        const float pos = (float)((sect < 2) ? (t >> 6) : (t & 63));
#pragma unroll
        for (int i = 0; i < 4; ++i) { const int j = (e0 + i) & 31; const float inv = exp2f(-(float)j * 0.41524101186092033f); const float ang = pos * inv; cs[i] = __cosf(ang); sn[i] = __sinf(ang); }
    }
#pragma unroll
    for (int p = 0; p < 6; ++p) {
        const int col = p * 256 + lane * 4;
        const u32x2 raw = *(const u32x2*)(ZB + (size_t)row * IN_AB + col);
        float y[4] = {bflo(raw.x), bfhi(raw.x), bflo(raw.y), bfhi(raw.y)};
        if (p < 5) {
            const float ss = half_sum(y[0] * y[0] + y[1] * y[1] + y[2] * y[2] + y[3] * y[3]);
            const float rstd = rsqrtf(ss * (1.f / 128.f) + EPS);
            const f32x4 g = *(const f32x4*)((p < 4 ? a.in[14] : a.in[15]) + e0);
            y[0] *= rstd * g.x; y[1] *= rstd * g.y; y[2] *= rstd * g.z; y[3] *= rstd * g.w;
        }
        if (!samp && p >= 4) {
            float* o = a.out + (p == 4 ? 12582912 : 13631488) + (size_t)row * 256 + lane * 4;
            *(f32x4*)o = (f32x4){y[0], y[1], y[2], y[3]};
        }
        if (samp && p < 5) {
#pragma unroll
            for (int i = 0; i < 4; ++i) { const float py = __shfl_xor(y[i], 8); const float rot = (sect & 1) ? py : -py; y[i] = y[i] * cs[i] + rot * sn[i]; }
        }
        u32x2 w; w.x = cvtpk(y[0], y[1]); w.y = cvtpk(y[2], y[3]);
        if (p < 4) *(u32x2*)(QN + (size_t)row * 1024 + col) = w;
        else {
            bf16_t* dst;
            if (samp) dst = (bf16_t*)(a.ws + (p == 4 ? WS_KS : WS_VS)) + ((size_t)(bb * 2 + hsel) * 1280 + t) * 128 + e0;
            else      dst = (bf16_t*)(a.ws + (p == 4 ? WS_KP : WS_VP)) + ((size_t)(bb * 2 + hsel) * 256 + t) * 128 + e0;
            *(u32x2*)dst = w;
        }
    }
}
__device__ __forceinline__ void cache_item(const Args& a, int item, int lane) {
    const int which = item >> 9, b = (item >> 8) & 1, t = item & 255, hsel = lane >> 5, e0 = (lane & 31) * 4;
    const f32x4 v = *(const f32x4*)(a.in[2 + which] + ((size_t)(b * 256 + t) * 2 + hsel) * 128 + e0);
    bf16_t* dst = (bf16_t*)(a.ws + (which == 0 ? WS_KS : WS_VS)) + ((size_t)(b * 2 + hsel) * 1280 + 1024 + t) * 128 + e0;
    u32x2 w; w.x = cvtpk(v.x, v.y); w.y = cvtpk(v.z, v.w);
    *(u32x2*)dst = w;
}
__device__ __forceinline__ void combine_token(const Args& a, int row, int lane) {
    const float* OF = (const float*)(a.ws + WS_OF); const float* OB = (const float*)(a.ws + WS_OB);
    const bf16_t* ZB = (const bf16_t*)(a.ws + WS_ZB); bf16_t* A2 = (bf16_t*)(a.ws + WS_A2);
    const int e0 = (lane & 31) * 4;
    const f32x4 g = *(const f32x4*)(a.in[16] + e0);
#pragma unroll
    for (int p = 0; p < 4; ++p) {
        const int col = p * 256 + lane * 4;
        const f32x4 o = *(const f32x4*)(OF + (size_t)row * 1024 + col) + *(const f32x4*)(OB + (size_t)row * 1024 + col);
        const float ss = half_sum(o.x * o.x + o.y * o.y + o.z * o.z + o.w * o.w);
        const float rstd = rsqrtf(ss * (1.f / 128.f) + EPS);
        const u32x2 raw = *(const u32x2*)(ZB + (size_t)row * IN_AB + C_HG + col);
        const f32x4 y = o * rstd * g * (f32x4){bflo(raw.x), bfhi(raw.x), bflo(raw.y), bfhi(raw.y)};
        u32x2 w; w.x = cvtpk(y.x, y.y); w.y = cvtpk(y.z, y.w);
        *(u32x2*)(A2 + (size_t)row * DM + 1024 + col) = w;
    }
}

constexpr int HG_ROW = 136, HG_TROW = 40;
constexpr int HG_QI = 0, HG_KI = 32 * HG_ROW * 2, HG_QS = 2 * 32 * HG_ROW * 2, HG_KST = 3 * 32 * HG_ROW * 2, HG_IT = HG_KST + 128 * HG_TROW * 2, HG_A = HG_IT + 128 * HG_TROW * 2, HG_GT = HG_A + 512, HG_SEQ_BYTES = HG_GT + 4096;
static_assert(HG_SEQ_BYTES % 16 == 0 && 2 * HG_SEQ_BYTES <= RING_BYTES, "hgrn lds");
__device__ __forceinline__ int crow(int r, int hi) { return (r & 3) + 8 * (r >> 2) + 4 * hi; }
__device__ __forceinline__ int kpos(int k) { const int kp = k & 15; return (k & 16) + (((kp >> 2) & 1) << 3) + ((kp >> 3) << 2) + (kp & 3); }
#define MFMA32(a, b, c) __builtin_amdgcn_mfma_f32_32x32x16_bf16((a), (b), (c), 0, 0, 0)
__device__ __forceinline__ bf16x8 pack8(const f32x16& x, int s) {
    u32x4 p; p.x = cvtpk(x[8 * s], x[8 * s + 1]); p.y = cvtpk(x[8 * s + 2], x[8 * s + 3]); p.z = cvtpk(x[8 * s + 4], x[8 * s + 5]); p.w = cvtpk(x[8 * s + 6], x[8 * s + 7]);
    return __builtin_bit_cast(bf16x8, p);
}
__device__ __forceinline__ void hgrn_task(const Args& a, LAS unsigned char* lds0, int task, int tid) {
    const bool samp = task < 16;
    const int bb = samp ? task >> 3 : (task - 16) >> 3, hh = task & 7;
    const int rowbase = samp ? NTOK_P + bb * SEQ_S : bb * SEQ_P, NCH = samp ? SEQ_S / 32 : SEQ_P / 32;
    const int dir = tid >> 8, tl = tid & 255, lane = tid & 63, wq = (tid >> 6) & 3, r32 = lane & 31, hi = lane >> 5;
    LAS unsigned char* L = lds0 + dir * HG_SEQ_BYTES;
    const bf16_t* ZB = (const bf16_t*)(a.ws + WS_ZB); const float* LF = (const float*)(a.ws + WS_LF);
    float* OUT = (float*)(a.ws + (dir == 0 ? WS_OF : WS_OB));
    const int cg = tl & 31, tg = tl >> 5, e0 = 32 * wq;
    f32x16 S[4];
    if (samp) { const float* s0 = a.in[4 + dir] + (size_t)(bb * 8 + hh) * 16384;
#pragma unroll
        for (int db = 0; db < 4; ++db)
#pragma unroll
            for (int i = 0; i < 16; ++i) S[db][i] = s0[(size_t)(32 * db + crow(i, hi)) * 128 + e0 + r32];
    } else {
#pragma unroll
        for (int db = 0; db < 4; ++db)
#pragma unroll
            for (int i = 0; i < 16; ++i) S[db][i] = 0.f;
    }
    f32x4 lf[4]; u32x2 qv[4], iv[4];
#define HG_LOAD(ch) do { _Pragma("unroll") for (int jj = 0; jj < 4; ++jj) { const int j = 4 * tg + jj; \
        const int row = rowbase + (dir == 0 ? 32 * (ch) + j : 32 * (NCH - 1 - (ch)) + 31 - j); \
        lf[jj] = *(const f32x4*)(LF + (size_t)row * 2048 + dir * 1024 + hh * 128 + 4 * cg); \
        qv[jj] = *(const u32x2*)(ZB + (size_t)row * IN_AB + C_HQ + hh * 128 + 4 * cg); \
        iv[jj] = *(const u32x2*)(ZB + (size_t)row * IN_AB + C_HI + hh * 128 + 4 * cg); } } while (0)
    HG_LOAD(0);
    for (int ch = 0; ch < NCH; ++ch) {
        f32x4 cb[4]; cb[0] = lf[0]; cb[1] = cb[0] + lf[1]; cb[2] = cb[1] + lf[2]; cb[3] = cb[2] + lf[3];
        *(LAS f32x4*)(L + HG_GT + (tg * 128 + 4 * cg) * 4) = cb[3];
        __syncthreads();
        f32x4 off = {0.f, 0.f, 0.f, 0.f}, bm = off, bl = off;
#pragma unroll
        for (int g = 0; g < 8; ++g) { const f32x4 t4 = *(const LAS f32x4*)(L + HG_GT + (g * 128 + 4 * cg) * 4); if (g < tg) off += t4; if (g < 4) bm += t4; bl += t4; }
        f32x4 em, elm;
#pragma unroll
        for (int c = 0; c < 4; ++c) { em[c] = __expf(bm[c]); elm[c] = __expf(bl[c] - bm[c]); }
        if (tg == 0) { f32x4 av;
#pragma unroll
            for (int c = 0; c < 4; ++c) av[c] = __expf(bl[c]);
            *(LAS f32x4*)(L + HG_A + 16 * cg) = av; }
        float kI_[4][4], kS_[4][4], iv_[4][4];
#pragma unroll
        for (int jj = 0; jj < 4; ++jj) {
            const int j = 4 * tg + jj;
            const float q4[4] = {bflo(qv[jj].x), bfhi(qv[jj].x), bflo(qv[jj].y), bfhi(qv[jj].y)};
            iv_[jj][0] = bflo(iv[jj].x); iv_[jj][1] = bfhi(iv[jj].x); iv_[jj][2] = bflo(iv[jj].y); iv_[jj][3] = bfhi(iv[jj].y);
            float qI[4], qS[4];
#pragma unroll
            for (int c = 0; c < 4; ++c) {
                const float b = off[c] + cb[jj][c];
                const float E1 = __expf(fminf(fmaxf(b - bm[c], -80.f), 80.f)), R1 = 1.f / E1;
                const float kk = 1.f - __expf(lf[jj][c]);
                qI[c] = q4[c] * E1; qS[c] = qI[c] * em[c];
                kI_[jj][c] = kk * R1; kS_[jj][c] = kI_[jj][c] * elm[c];
            }
            u32x2 w; w.x = cvtpk(qI[0], qI[1]); w.y = cvtpk(qI[2], qI[3]);
            *(LAS u32x2*)(L + HG_QI + (j * HG_ROW + 4 * cg) * 2) = w;
            w.x = cvtpk(kI_[jj][0], kI_[jj][1]); w.y = cvtpk(kI_[jj][2], kI_[jj][3]);
            *(LAS u32x2*)(L + HG_KI + (j * HG_ROW + 4 * cg) * 2) = w;
            w.x = cvtpk(qS[0], qS[1]); w.y = cvtpk(qS[2], qS[3]);
            *(LAS u32x2*)(L + HG_QS + (j * HG_ROW + (4 * cg & ~31) + kpos(4 * cg & 31)) * 2) = w;
        }
        {
            const int p0 = kpos(4 * tg);
#pragma unroll
            for (int c = 0; c < 4; ++c) { u32x2 w; w.x = cvtpk(kS_[0][c], kS_[1][c]); w.y = cvtpk(kS_[2][c], kS_[3][c]);
                *(LAS u32x2*)(L + HG_KST + ((4 * cg + c) * HG_TROW + p0) * 2) = w;
                w.x = cvtpk(iv_[0][c], iv_[1][c]); w.y = cvtpk(iv_[2][c], iv_[3][c]);
                *(LAS u32x2*)(L + HG_IT + ((4 * cg + c) * HG_TROW + p0) * 2) = w; }
        }
        if (ch + 1 < NCH) HG_LOAD(ch + 1);
        __syncthreads();
        f32x16 x;
#pragma unroll
        for (int i = 0; i < 16; ++i) x[i] = 0.f;
#pragma unroll
        for (int ks = 0; ks < 8; ++ks) {
            const bf16x8 fa = *(const LAS bf16x8*)(L + HG_KI + (r32 * HG_ROW + 16 * ks + 8 * hi) * 2);
            const bf16x8 fb = *(const LAS bf16x8*)(L + HG_QI + (r32 * HG_ROW + 16 * ks + 8 * hi) * 2);
            x = MFMA32(fa, fb, x);
        }
#pragma unroll
        for (int i = 0; i < 16; ++i) x[i] = (crow(i, hi) <= r32) ? x[i] : 0.f;
        f32x16 y;
#pragma unroll
        for (int i = 0; i < 16; ++i) y[i] = 0.f;
        bf16x8 fi[2];
#pragma unroll
        for (int ks = 0; ks < 2; ++ks) {
            fi[ks] = *(const LAS bf16x8*)(L + HG_IT + ((e0 + r32) * HG_TROW + 16 * ks + 8 * hi) * 2);
            y = MFMA32(fi[ks], pack8(x, ks), y);
        }
#pragma unroll
        for (int db = 0; db < 4; ++db)
#pragma unroll
            for (int ks = 0; ks < 2; ++ks) {
                const bf16x8 fq_ = *(const LAS bf16x8*)(L + HG_QS + (r32 * HG_ROW + 32 * db + 16 * ks + 8 * hi) * 2);
                y = MFMA32(pack8(S[db], ks), fq_, y);
            }
        {
            const int row = rowbase + (dir == 0 ? 32 * ch + r32 : 32 * (NCH - 1 - ch) + 31 - r32);
            float* op = OUT + (size_t)row * 1024 + hh * 128 + e0 + 4 * hi;
#pragma unroll
            for (int g4 = 0; g4 < 4; ++g4) *(f32x4*)(op + 8 * g4) = (f32x4){y[4 * g4], y[4 * g4 + 1], y[4 * g4 + 2], y[4 * g4 + 3]};
        }
#pragma unroll
        for (int db = 0; db < 4; ++db) {
#pragma unroll
            for (int g4 = 0; g4 < 4; ++g4) { const f32x4 a4 = *(const LAS f32x4*)(L + HG_A + (32 * db + 8 * g4 + 4 * hi) * 4);
#pragma unroll
                for (int c = 0; c < 4; ++c) S[db][4 * g4 + c] *= a4[c]; }
#pragma unroll
            for (int ks = 0; ks < 2; ++ks) {
                const bf16x8 fk = *(const LAS bf16x8*)(L + HG_KST + ((32 * db + r32) * HG_TROW + 16 * ks + 8 * hi) * 2);
                S[db] = MFMA32(fk, fi[ks], S[db]);
            }
        }
    }
#undef HG_LOAD
    if (!samp) { float* so = a.out + (dir == 0 ? 14680064 : 16777216) + (size_t)(bb * 8 + hh) * 16384;
#pragma unroll
        for (int db = 0; db < 4; ++db)
#pragma unroll
            for (int i = 0; i < 16; ++i) so[(size_t)(32 * db + crow(i, hi)) * 128 + e0 + r32] = S[db][i];
    }
    __syncthreads();
}

namespace att {
constexpr int D = 128, NW = 8, QBLK = 32, KVBLK = 64;
constexpr float SCALE = 0.088388347648318440f;
constexpr float THR = 0.f;
constexpr int LDQ = 1024, LDK = 128, LDO = 2048;
constexpr int SHM_V = KVBLK * D * 2, SHM_K = KVBLK * D * 2, SHM_ATTN = 2 * SHM_V + 2 * SHM_K + NW * 64 * 4;
#define KSWZ(row, colB) ((row) * 256 + ((colB) ^ (((row) & 7) << 4)))
#define SBAR() __builtin_amdgcn_sched_barrier(0)
__device__ __forceinline__ unsigned cvtpk_a(float lo, float hi) { unsigned r; asm volatile("v_cvt_pk_bf16_f32 %0, %1, %2" : "=v"(r) : "v"(lo), "v"(hi)); return r; }
__device__ __forceinline__ void partialSM(f32x16& p0, f32x16& p1, float& m_reg, float& mn, float& alpha) {
  constexpr float C = SCALE * 1.4426950408889634f;
  float pmax = p0[0]; for (int r = 1; r < 16; ++r) pmax = fmaxf(pmax, p0[r]); for (int r = 0; r < 16; ++r) pmax = fmaxf(pmax, p1[r]);
  { auto rr = __builtin_amdgcn_permlane32_swap(__float_as_uint(pmax), __float_as_uint(pmax), false, false);
    pmax = fmaxf(__uint_as_float(rr[0]), __uint_as_float(rr[1])); }
  if (__builtin_expect(__all(pmax - m_reg <= THR / SCALE), 1)) { mn = m_reg; alpha = 1.f; }
  else { mn = fmaxf(m_reg, pmax); alpha = __builtin_amdgcn_exp2f((m_reg - mn) * C); m_reg = mn; }
  float mnC = -mn * C;
  for (int r = 0; r < 16; ++r) p0[r] = fmaf(p0[r], C, mnC); for (int r = 0; r < 16; ++r) p1[r] = fmaf(p1[r], C, mnC);
  for (int r = 0; r < 16; ++r) p0[r] = __builtin_amdgcn_exp2f(p0[r]);
}
__device__ __forceinline__ void finishSM(f32x16& p0, f32x16& p1, float alpha, float& l_reg, bf16x8& pa0, bf16x8& pa1, bf16x8& pa2, bf16x8& pa3) {
  for (int r = 0; r < 16; ++r) p1[r] = __builtin_amdgcn_exp2f(p1[r]);
  float ps = 0; for (int r = 0; r < 16; ++r) ps += p0[r]; for (int r = 0; r < 16; ++r) ps += p1[r];
  { auto rr = __builtin_amdgcn_permlane32_swap(__float_as_uint(ps), __float_as_uint(ps), false, false);
    ps = __uint_as_float(rr[0]) + __uint_as_float(rr[1]); }
  l_reg = l_reg * alpha + ps;
#define PK4(P, BASE, OUT) do { unsigned a0 = cvtpk_a(P[BASE + 0], P[BASE + 1]), a1 = cvtpk_a(P[BASE + 2], P[BASE + 3]);   \
    unsigned b0 = cvtpk_a(P[BASE + 4], P[BASE + 5]), b1 = cvtpk_a(P[BASE + 6], P[BASE + 7]);                              \
    auto r0 = __builtin_amdgcn_permlane32_swap(a0, b0, false, false); auto r1 = __builtin_amdgcn_permlane32_swap(a1, b1, false, false); \
    u32x4 w = {r0[0], r1[0], r0[1], r1[1]}; OUT = *reinterpret_cast<bf16x8*>(&w); } while (0)
  PK4(p0, 0, pa0); PK4(p0, 8, pa1); PK4(p1, 0, pa2); PK4(p1, 8, pa3);
#undef PK4
}
__device__ __forceinline__ void qkt(f32x16& p0, f32x16& p1, const bf16_t* Ks, const bf16x8* qr, int r32, int hi) {
  p0 = f32x16{}; p1 = f32x16{};
  for (int d0 = 0; d0 < 8; ++d0) { int cb = (d0 * 16 + hi * 8) * 2;
    bf16x8 b0 = *reinterpret_cast<const bf16x8*>((const char*)Ks + KSWZ(r32, cb));
    bf16x8 b1 = *reinterpret_cast<const bf16x8*>((const char*)Ks + KSWZ(32 + r32, cb));
    p0 = __builtin_amdgcn_mfma_f32_32x32x16_bf16(b0, qr[d0], p0, 0, 0, 0);
    p1 = __builtin_amdgcn_mfma_f32_32x32x16_bf16(b1, qr[d0], p1, 0, 0, 0); }
}
__device__ __forceinline__ int v_st(int k, int c) { const int kk = (k & ~0xC) | ((k & 4) << 1) | ((k & 8) >> 1); return ((kk >> 3) * 4 + (c >> 5)) * 512 + ((kk & 7) * 32 + (c & 31)) * 2; }
__device__ __forceinline__ int v_rd_base(int lane) { return ((lane & 3) << 3) | (((lane >> 2) & 3) << 6) | (((lane >> 4) & 1) << 5) | (((lane >> 5) & 1) << 8); }
constexpr int v_rd_off(int d0, int ks, int half) { return d0 * 512 + ks * 4096 + half * 2048; }
template <int OFF> __device__ __forceinline__ s16x4 tr_read(int vb) {
  s16x4 r; asm volatile("ds_read_b64_tr_b16 %0, %1 offset:%2" : "=&v"(r) : "v"(vb), "i"(OFF) : "memory"); return r;
}
template <int D0> __device__ __forceinline__ void pv_one(f32x16& od, int vb, bf16x8 pa0, bf16x8 pa1, bf16x8 pa2, bf16x8 pa3) {
  const s16x4 l0 = tr_read<v_rd_off(D0, 0, 0)>(vb), h0 = tr_read<v_rd_off(D0, 0, 1)>(vb), l1 = tr_read<v_rd_off(D0, 1, 0)>(vb), h1 = tr_read<v_rd_off(D0, 1, 1)>(vb);
  const s16x4 l2 = tr_read<v_rd_off(D0, 2, 0)>(vb), h2 = tr_read<v_rd_off(D0, 2, 1)>(vb), l3 = tr_read<v_rd_off(D0, 3, 0)>(vb), h3 = tr_read<v_rd_off(D0, 3, 1)>(vb);
  asm volatile("s_waitcnt lgkmcnt(0)" ::: "memory"); SBAR();
#define PK(L, H) (bf16x8){L[0], L[1], L[2], L[3], H[0], H[1], H[2], H[3]}
  od = __builtin_amdgcn_mfma_f32_32x32x16_bf16(pa0, PK(l0, h0), od, 0, 0, 0);
  od = __builtin_amdgcn_mfma_f32_32x32x16_bf16(pa1, PK(l1, h1), od, 0, 0, 0);
  od = __builtin_amdgcn_mfma_f32_32x32x16_bf16(pa2, PK(l2, h2), od, 0, 0, 0);
  od = __builtin_amdgcn_mfma_f32_32x32x16_bf16(pa3, PK(l3, h3), od, 0, 0, 0);
#undef PK
}
__device__ __forceinline__ void pv_d0(f32x16* o, int vb, bf16x8 pa0, bf16x8 pa1, bf16x8 pa2, bf16x8 pa3) {
  pv_one<0>(o[0], vb, pa0, pa1, pa2, pa3); pv_one<1>(o[1], vb, pa0, pa1, pa2, pa3); pv_one<2>(o[2], vb, pa0, pa1, pa2, pa3); pv_one<3>(o[3], vb, pa0, pa1, pa2, pa3);
}
__device__ __forceinline__ void attn_dense_body(const bf16_t* __restrict__ Qb, const bf16_t* __restrict__ Kh, const bf16_t* __restrict__ Vh,
                                                bf16_t* __restrict__ Ob, int seq, char* lds) {
  const int tid = threadIdx.x, wid = tid >> 6, lane = tid & 63, r32 = lane & 31, hi = lane >> 5;
  bf16_t* V_lds = (bf16_t*)lds; bf16_t* K_lds = (bf16_t*)(lds + 2 * SHM_V);
  float* ws = (float*)(lds + 2 * SHM_V + 2 * SHM_K) + wid * 64; float* li_l = ws; float* al_l = ws + 32;
  float m_reg = -1e30f, l_reg = 0; f32x16 o[4] = {}; bf16x8 qr[8];
  const bf16_t* Qw = Qb + (long)(wid * QBLK + r32) * LDQ + hi * 8;
#pragma unroll
  for (int d0 = 0; d0 < 8; ++d0) qr[d0] = *reinterpret_cast<const bf16x8*>(Qw + d0 * 16);
  const int sr = tid >> 4, sc = (tid & 15) * 8, vst0 = v_st(sr, sc), vst1 = v_st(32 + sr, sc);
  const int vb0 = (int)(uintptr_t)V_lds + v_rd_base(lane);
  struct { bf16x8 vs0, vs1, ks0, ks1; } sr_[2];
#define LD8(p) (*reinterpret_cast<const bf16x8*>(p))
#define SLOAD(i, k0) do { sr_[i].vs0 = LD8(&Vh[(long)((k0) + sr) * LDK + sc]); sr_[i].vs1 = LD8(&Vh[(long)((k0) + 32 + sr) * LDK + sc]); \
    sr_[i].ks0 = LD8(&Kh[(long)((k0) + sr) * LDK + sc]); sr_[i].ks1 = LD8(&Kh[(long)((k0) + 32 + sr) * LDK + sc]); } while (0)
#define SWRITE(b, i) do { *(bf16x8*)((char*)V_lds + (b) * SHM_V + vst0) = sr_[i].vs0;          \
    *(bf16x8*)((char*)V_lds + (b) * SHM_V + vst1) = sr_[i].vs1; int kc = sc * 2;               \
    *(bf16x8*)((char*)K_lds + (b) * SHM_K + KSWZ(sr, kc)) = sr_[i].ks0;                       \
    *(bf16x8*)((char*)K_lds + (b) * SHM_K + KSWZ(32 + sr, kc)) = sr_[i].ks1; } while (0)
#define SWAIT() asm volatile("s_waitcnt vmcnt(4)" ::: "memory")
#define RESC(a) do { if (__any((a) < 1.f)) { if (hi == 0) al_l[r32] = (a); asm volatile("s_waitcnt lgkmcnt(0)" ::: "memory"); \
    for (int d = 0; d < 4; ++d) for (int r = 0; r < 16; ++r) o[d][r] *= al_l[crow(r, hi)]; } } while (0)
  f32x16 pA0, pA1, pB0, pB1; float mnA, mnB, alA, alB; bf16x8 pa0, pa1, pa2, pa3; const int NT = seq / KVBLK;
  constexpr int SE = 0, SO = 1;
  SLOAD(SE, 0); asm volatile("s_waitcnt vmcnt(0)" ::: "memory"); SWRITE(0, SE); __syncthreads();
  qkt(pA0, pA1, K_lds, qr, r32, hi); partialSM(pA0, pA1, m_reg, mnA, alA);
  SLOAD(SO, KVBLK); if (2 < NT) SLOAD(SE, 2 * KVBLK);
  SWAIT(); SWRITE(1, SO); __syncthreads();
  for (int j = 1; j + 1 < NT; j += 2) {
    SBAR(); qkt(pB0, pB1, (bf16_t*)((char*)K_lds + SHM_K), qr, r32, hi);
    finishSM(pA0, pA1, alA, l_reg, pa0, pa1, pa2, pa3); SBAR();
    SLOAD(SO, (j + 2) * KVBLK); SBAR();
    pv_d0(o, vb0, pa0, pa1, pa2, pa3); partialSM(pB0, pB1, m_reg, mnB, alB);
    __syncthreads(); SWAIT(); SWRITE(0, SE);
    RESC(alB); __syncthreads();
    SBAR(); qkt(pA0, pA1, K_lds, qr, r32, hi);
    finishSM(pB0, pB1, alB, l_reg, pa0, pa1, pa2, pa3); SBAR();
    if (j + 3 < NT) SLOAD(SE, (j + 3) * KVBLK); SBAR();
    pv_d0(o, vb0 + (int)SHM_V, pa0, pa1, pa2, pa3); partialSM(pA0, pA1, m_reg, mnA, alA);
    __syncthreads(); SWAIT(); SWRITE(1, SO);
    RESC(alA); __syncthreads();
  }
  SBAR(); qkt(pB0, pB1, (bf16_t*)((char*)K_lds + SHM_K), qr, r32, hi);
  finishSM(pA0, pA1, alA, l_reg, pa0, pa1, pa2, pa3); SBAR();
  pv_d0(o, vb0, pa0, pa1, pa2, pa3); partialSM(pB0, pB1, m_reg, mnB, alB);
  __syncthreads(); RESC(alB);
  finishSM(pB0, pB1, alB, l_reg, pa0, pa1, pa2, pa3); SBAR();
  pv_d0(o, vb0 + (int)SHM_V, pa0, pa1, pa2, pa3);
  if (hi == 0) li_l[r32] = l_reg; asm volatile("s_waitcnt lgkmcnt(0)" ::: "memory");
  float rli[16];
#pragma unroll
  for (int r = 0; r < 16; ++r) rli[r] = __builtin_amdgcn_rcpf(li_l[crow(r, hi)]);
  bf16_t* Ow = Ob + (long)(wid * QBLK) * LDO;
#pragma unroll
  for (int r = 0; r < 16; ++r) { int orow = crow(r, hi);
    for (int d0 = 0; d0 < 4; ++d0) { const float v = o[d0][r] * rli[r]; Ow[(long)orow * LDO + d0 * 32 + r32] = (bf16_t)(cvtpk(v, v) & 0xffffu); } }
  __syncthreads();
#undef LD8
#undef SLOAD
#undef SWRITE
#undef SWAIT
#undef RESC
}
#undef SBAR
}

constexpr int N_PHASES = 16;
__global__ void __launch_bounds__(NWAVES * 64, 2) fwd_kernel(Args args) {
    extern __shared__ __attribute__((aligned(16))) unsigned char lds_raw[];
    LAS unsigned char* lds = (LAS unsigned char*)lds_raw;
    volatile LAS unsigned* MISC = (volatile LAS unsigned*)(lds + MISC_OFF);
    const int tid = threadIdx.x, lane = tid & 63, wave = __builtin_amdgcn_readfirstlane(tid >> 6);
    const int G = gridDim.x, bx = blockIdx.x;
    const int gw = bx * NWAVES + wave, NGW = G * NWAVES;
    unsigned char* ws = args.ws;
    gu32* ctl = (gu32*)(ws + WS_CTL);
    for (int u = tid; u < (LDS_BYTES - LDSCTL_OFF) / 4; u += NWAVES * 64) ((LAS unsigned*)(lds + LDSCTL_OFF))[u] = 0u;
    __syncthreads();
    XcdBarrier bar; bar.bar = (unsigned*)(ctl + CW_BAR); bar.x = 0; bar.st = nullptr;
    if (!MK_PER_PHASE) bar = xcd_barrier_post((unsigned*)(ctl + CW_BAR), MISC + 8);
    const int lo = args.ph_lo, hi = args.ph_hi;
#define IN(k) (lo <= (k) && (k) < hi)
#define SEAM(k) do { if (IN(k) && IN((k) + 1)) xcd_barrier(bar); } while (0)
    bf16_t* W_IN = (bf16_t*)(ws + WS_WIN); bf16_t* W_OUT = (bf16_t*)(ws + WS_WOUT); bf16_t* W_POOL = (bf16_t*)(ws + WS_WPOOL);
    bf16_t* W_M1 = (bf16_t*)(ws + WS_WM1); bf16_t* W_M2 = (bf16_t*)(ws + WS_WM2);
    bf16_t* Hb = (bf16_t*)(ws + WS_H); bf16_t* ZB = (bf16_t*)(ws + WS_ZB); float* LFb = (float*)(ws + WS_LF);
    bf16_t* A2 = (bf16_t*)(ws + WS_A2); float* XA = (float*)(ws + WS_XA); bf16_t* Ub = (bf16_t*)(ws + WS_U);
    const float* MOD = (const float*)(ws + WS_MOD);

    if (IN(0)) {
        for (int wi = bx; wi < 256; wi += G) p0_ada_item(args, lds, wi, tid);
        LAS float* scr = (LAS float*)(lds + wave * 16384);
        constexpr int I_IN = 32 * 208, I_OUT = 32 * 64, I_POOL = 8 * 16, I_M1 = 32 * 256, I_M2 = 128 * 64;
        constexpr int NITEMS = I_IN + I_OUT + 4 * I_POOL + 2 * I_M1 + 2 * I_M2;
        for (int it = gw; it < NITEMS; it += NGW) {
            int r = it;
            if (r < I_IN) { p0_transpose_item(args.in[12], 2048, IN_AB, W_IN, 0, scr, r, lane); continue; } r -= I_IN;
            if (r < I_OUT) { p0_transpose_item(args.in[13], 2048, 2048, W_OUT, 0, scr, r, lane); continue; } r -= I_OUT;
            if (r < 4 * I_POOL) { const int g = r / I_POOL; p0_transpose_item(args.in[18] + (size_t)g * 512 * 512, 512, 512, W_POOL, g * 512, scr, r % I_POOL, lane); continue; } r -= 4 * I_POOL;
            if (r < 2 * I_M1) { const int l = r / I_M1; p0_transpose_item(args.in[20] + (size_t)l * 2048 * DFF, 2048, DFF, W_M1 + (size_t)l * DFF * 2048, 0, scr, r % I_M1, lane); continue; } r -= 2 * I_M1;
            { const int l = r / I_M2; p0_transpose_item(args.in[21] + (size_t)l * DFF * 2048, DFF, 2048, W_M2 + (size_t)l * 2048 * DFF, 0, scr, r % I_M2, lane); }
        }
    }
    SEAM(0);
    if (IN(1)) norm_rows_bf16(args, nullptr, args.in[10], 0, 0, Hb, gw, NGW, lane);
    SEAM(1);
    if (IN(2)) { pg8::Gemm g{Hb, W_IN, NTOK, IN_AB, 2048, 2048, 2048, 0, 0}; pg8::StaticOrder S; S.init(NTOK, IN_AB, G, bx);
        EpiIn E{ZB, LFb, args.in[17]}; pg8::gemm_phase<EpiIn>(lds, g, S, E); }
    SEAM(2);
    if (IN(3)) {
        for (int row = gw; row < NTOK; row += NGW) post_token(args, row, lane);
        for (int it = gw; it < 1024; it += NGW) cache_item(args, it, lane);
        __syncthreads();
        for (int task = bx; task < 144; task += G) hgrn_task(args, lds, task, tid);
    }
    SEAM(3);
    if (IN(4)) {
        for (int u = bx; u < 192; u += G) {
            const bf16_t *Q, *K, *V; bf16_t* O; int seq;
            if (u < 64) { const int b = u >> 5, h = (u >> 2) & 7, qb = u & 3; const size_t row0 = NTOK_P + b * SEQ_S + qb * 256;
                Q = (const bf16_t*)(ws + WS_QN) + row0 * 1024 + h * 128; O = A2 + row0 * DM + h * 128;
                K = (const bf16_t*)(ws + WS_KS) + (size_t)(b * 2 + (h >> 2)) * 1280 * 128; V = (const bf16_t*)(ws + WS_VS) + (size_t)(b * 2 + (h >> 2)) * 1280 * 128; seq = 1280; }
            else { const int v = u - 64, b = v >> 3, h = v & 7; const size_t row0 = b * 256;
                Q = (const bf16_t*)(ws + WS_QN) + row0 * 1024 + h * 128; O = A2 + row0 * DM + h * 128;
                K = (const bf16_t*)(ws + WS_KP) + (size_t)(b * 2 + (h >> 2)) * 256 * 128; V = (const bf16_t*)(ws + WS_VP) + (size_t)(b * 2 + (h >> 2)) * 256 * 128; seq = 256; }
            att::attn_dense_body(Q, K, V, O, seq, (char*)lds_raw);
        }
        {
            const int nfree = G > 192 ? G - 192 : G, fb = G > 192 ? bx - 192 : bx;
            if (fb >= 0) for (int row = fb * NWAVES + wave; row < NTOK; row += nfree * NWAVES) combine_token(args, row, lane);
        }
    }
    SEAM(4);
    if (IN(5)) { pg8::Gemm g{A2, W_OUT, NTOK, DM, 2048, 2048, 2048, 0, 0}; pg8::StaticOrder S; S.init(NTOK, DM, G, bx);
        EpiRes E{args.in[0], args.in[1], XA, MOD + 2 * 2048, nullptr}; pg8::gemm_phase<EpiRes>(lds, g, S, E); }
    SEAM(5);
    if (IN(6)) norm_rows_bf16(args, XA, args.in[11], 0, 3 * 2048, Hb, gw, NGW, lane);
    SEAM(6);
    if (IN(7)) { pg8::Gemm g{Hb, W_M1, NTOK, DFF, 2048, 2048, 2048, 0, 0}; pg8::StaticOrder S; S.init(NTOK, DFF, G, bx);
        EpiRelu2 E{Ub}; pg8::gemm_phase<EpiRelu2>(lds, g, S, E); }
    SEAM(7);
    if (IN(8)) { pg8::Gemm g{Ub, W_M2, NTOK, DM, DFF, DFF, DFF, 0, 0}; pg8::StaticOrder S; S.init(NTOK, DM, G, bx);
        EpiRes E{XA, XA + (size_t)NTOK_P * DM, XA, MOD + 5 * 2048, nullptr}; pg8::gemm_phase<EpiRes>(lds, g, S, E); }
    SEAM(8);
    if (IN(9)) norm_rows_f32(args, XA, args.in[10] + 2048, 1, 0, LFb, gw, NGW, lane);
    SEAM(9);
    if (IN(10)) pool_items(LFb, Hb, gw, NGW, lane);
    SEAM(10);
    if (IN(11)) { pg8::Gemm g{Hb, W_POOL, NTOK, DM, 512, 2048, 512, 1, 512}; pg8::StaticOrder S; S.init(NTOK, DM, G, bx);
        EpiRes E{XA, XA + (size_t)NTOK_P * DM, XA, MOD + NMODC + 2 * 2048, args.in[19]}; pg8::gemm_phase<EpiRes>(lds, g, S, E); }
    SEAM(11);
    if (IN(12)) norm_rows_bf16(args, XA, args.in[11] + 2048, 1, 3 * 2048, Hb, gw, NGW, lane);
    SEAM(12);
    if (IN(13)) { pg8::Gemm g{Hb, W_M1 + (size_t)DFF * 2048, NTOK, DFF, 2048, 2048, 2048, 0, 0}; pg8::StaticOrder S; S.init(NTOK, DFF, G, bx);
        EpiRelu2 E{Ub}; pg8::gemm_phase<EpiRelu2>(lds, g, S, E); }
    SEAM(13);
    if (IN(14)) { pg8::Gemm g{Ub, W_M2 + (size_t)2048 * DFF, NTOK, DM, DFF, DFF, DFF, 0, 0}; pg8::StaticOrder S; S.init(NTOK, DM, G, bx);
        EpiRes E{XA, XA + (size_t)NTOK_P * DM, XA, MOD + NMODC + 5 * 2048, nullptr}; pg8::gemm_phase<EpiRes>(lds, g, S, E); }
    SEAM(14);
    if (IN(15)) norm_rows_f32(args, XA, args.in[22], 0, -1, args.out, gw, NGW, lane);
#undef IN
#undef SEAM
}

extern "C" void kernel_launch(void* const* d_in, const int* in_sizes, int n_in, void* d_out, int out_size, void* d_ws, size_t ws_size, hipStream_t stream) {
    static int grid = 0;
    if (grid == 0) {
        if (n_in != 23 || out_size != 18874368 || ws_size < WS_END) { fprintf(stderr, "kernel_launch: unexpected shapes (n_in %d out %d ws %zu)\n", n_in, out_size, ws_size); grid = -1; return; }
        int dev = 0, cus = 0;
        if (hipGetDevice(&dev) != hipSuccess || hipDeviceGetAttribute(&cus, hipDeviceAttributeMultiprocessorCount, dev) != hipSuccess) { grid = -1; return; }
        if (hipFuncSetAttribute((const void*)fwd_kernel, hipFuncAttributeMaxDynamicSharedMemorySize, LDS_BYTES) != hipSuccess) { fprintf(stderr, "kernel_launch: hipFuncSetAttribute failed\n"); grid = -1; return; }
        int per_cu = 0;
        if (hipOccupancyMaxActiveBlocksPerMultiprocessor(&per_cu, (const void*)fwd_kernel, NWAVES * 64, LDS_BYTES) != hipSuccess || per_cu < 1) fprintf(stderr, "kernel_launch: occupancy query says %d\n", per_cu);
        (void)hipGetLastError();
        grid = cus;
    }
    if (grid < 0) return;
    (void)hipMemsetAsync((char*)d_ws + WS_CTL, 0, CTL_ZERO_BYTES, stream);
    Args a{};
    for (int i = 0; i < 23; ++i) a.in[i] = (const float*)d_in[i];
    a.out = (float*)d_out; a.ws = (unsigned char*)d_ws;
#if MK_PER_PHASE
    for (int p = 0; p < N_PHASES; ++p) { a.ph_lo = p; a.ph_hi = p + 1; hipLaunchKernelGGL(fwd_kernel, dim3(grid), dim3(NWAVES * 64), LDS_BYTES, stream, a); }
#else
    a.ph_lo = 0; a.ph_hi = N_PHASES;
    hipLaunchKernelGGL(fwd_kernel, dim3(grid), dim3(NWAVES * 64), LDS_BYTES, stream, a);
#endif
}
```

```cpp
#include <hip/hip_runtime.h>
#include <hip/hip_bf16.h>
#include <cstdio>
#include <cstdint>

#ifndef MK_PER_PHASE
#define MK_PER_PHASE 0
#endif

#ifndef REP_PHASE
#define REP_PHASE -1
#endif
constexpr int DM = 2048, NTOK_P = 4096, NTOK_S = 2048, NTOK = 6144, SEQ_P = 256, SEQ_S = 1024, NB_P = 16, NB_S = 2, PAST = 256;
constexpr int IN_AB = 6656, DFF = 8192, NMODC = 12288;
constexpr int C_Q = 0, C_K = 1024, C_V = 1280, C_HQ = 1536, C_ZF = 2560, C_ZB = 3584, C_HI = 4608, C_HG = 5632;
constexpr float EPS = 1e-6f;

#define GAS __attribute__((address_space(1)))
#define LAS __attribute__((address_space(3)))
typedef unsigned short bf16_t;
typedef short bf16x8 __attribute__((ext_vector_type(8)));
typedef short s16x4 __attribute__((ext_vector_type(4)));
typedef float f32x4 __attribute__((ext_vector_type(4)));
typedef float f32x2 __attribute__((ext_vector_type(2)));
typedef float f32x16 __attribute__((ext_vector_type(16)));
typedef unsigned u32x4 __attribute__((ext_vector_type(4)));
typedef unsigned u32x2 __attribute__((ext_vector_type(2)));
typedef __bf16 bf16x2_t __attribute__((ext_vector_type(2)));
typedef GAS unsigned gu32;

__device__ __forceinline__ unsigned cvtpk(float lo, float hi) { f32x2 v = {lo, hi}; bf16x2_t b = __builtin_convertvector(v, bf16x2_t); return __builtin_bit_cast(unsigned, b); }
__device__ __forceinline__ float bf2f(unsigned short u) { return __uint_as_float(((unsigned)u) << 16); }
__device__ __forceinline__ float bflo(unsigned u) { return __uint_as_float(u << 16); }
__device__ __forceinline__ float bfhi(unsigned u) { return __uint_as_float(u & 0xffff0000u); }
__device__ __forceinline__ float siluf(float x) { return x / (1.f + __expf(-x)); }
__device__ __forceinline__ float wave_sum(float v) {
#pragma unroll
    for (int o = 1; o < 64; o <<= 1) v += __shfl_xor(v, o);
    return v;
}
__device__ __forceinline__ float half_sum(float v) {
#pragma unroll
    for (int o = 1; o < 32; o <<= 1) v += __shfl_xor(v, o);
    return v;
}

namespace pg8 {
#define PG8_LAS __attribute__((address_space(3)))
constexpr int BM = 256, BK = 64, HALF = 128, HTB = HALF * BK * 2, STAGE_BYTES = 8 * HTB, NXCD = 8, WGM = 8;
__host__ __device__ __forceinline__ int lds_byte(int r, int c) { const int st = (r >> 4) * 2 + (c >> 5), rr = r & 15, cc = c & 31, ob = rr * 64 + cc * 2; return st * 1024 + (ob ^ (((ob >> 9) & 1) << 5)); }
__host__ __device__ __forceinline__ void stage_rc(int b, int& R, int& C) { const int st = b / 1024, sb = b % 1024, swz = sb ^ (((sb >> 9) & 1) << 5); R = (st >> 1) * 16 + swz / 64; C = (st & 1) * 32 + (swz % 64) / 2; }
__host__ __device__ __forceinline__ int perm32(int rho) { const int n = rho >> 4, i = rho & 15; return 8 * (i >> 2) + 4 * n + (i & 3); }

struct Unit { int pm, pn; };
struct Gemm { const bf16_t* A; const bf16_t* Bt; int M, N, K, lda, ldb, apn_shift, apn_mul; };

struct StaticOrder {
    int nM, nN, nwg, G, c;
    __host__ __device__ void init(int M, int N, int G_, int c_) { nM = M / BM; nN = N / BM; nwg = nM * nN; G = G_; c = c_; }
    __host__ __device__ bool next(int i, Unit& u) const {
        const long L = (long)i * G + c; if (L >= nwg) return false;
        int wgid = (int)L; { const int q = nwg / NXCD, r = nwg % NXCD, xcd = wgid % NXCD, off = wgid / NXCD; wgid = (xcd < r ? xcd * (q + 1) : r * (q + 1) + (xcd - r) * q) + off; }
        const int nig = WGM * nN, gid = wgid / nig, fm = gid * WGM, gsz = (nM - fm) < WGM ? (nM - fm) : WGM;
        u.pm = fm + ((wgid % nig) % gsz); u.pn = (wgid % nig) / gsz; return true;
    }
};

template <class Epi, bool ALIGN_EPI = true>
__device__ __forceinline__ void gemm_phase(PG8_LAS unsigned char* lds, const Gemm g, const StaticOrder& S, const Epi& E) {
    const int tid = threadIdx.x, wid = __builtin_amdgcn_readfirstlane(tid >> 6), lane = tid & 63, wr = wid >> 2, wc = wid & 3, fr = lane & 15, fq = lane >> 4;
    const int K = g.K, nt = K / BK;
    unsigned voffA[2], voffB[2];
#pragma unroll
    for (int i = 0; i < 2; ++i) { int R, C; stage_rc(tid * 16 + i * 8192, R, C); const int Rb = Epi::PERM ? ((R & ~31) + perm32(R & 31)) : R;
        voffA[i] = (unsigned)(R * g.lda + C) * 2u; voffB[i] = (unsigned)(Rb * g.ldb + C) * 2u; }
    const size_t kstep = (size_t)(BK * 2);
    const size_t hstepA = (size_t)HALF * g.lda * 2, hstepB = (size_t)HALF * g.ldb * 2;
    const size_t tstepA = 2 * hstepA, tstepB = 2 * hstepB;
    const unsigned ldsw = (unsigned)wid * 1024u;
    const int aoff = lds_byte(wr * 64 + fr, fq * 8), boff = lds_byte(wc * 32 + fr, fq * 8);
#define PG8_SA(b, h) (((b) * 2 + (h)) * HTB)
#define PG8_SB(b, h) ((4 + (b) * 2 + (h)) * HTB)
#define PG8_STAGE(bufoff, gbase, voff) do { _Pragma("unroll") for (int _i = 0; _i < 2; ++_i) \
        __builtin_amdgcn_global_load_lds((const unsigned*)((const char*)(gbase) + (voff)[_i]), (PG8_LAS unsigned*)(lds + (bufoff) + ldsw + _i * 8192), 16, 0, 0); } while (0)
#define PG8_LDA(dst, b, h) do { _Pragma("unroll") for (int m = 0; m < 4; ++m) _Pragma("unroll") for (int k = 0; k < 2; ++k) dst[m][k] = *(const PG8_LAS bf16x8*)(lds + PG8_SA(b, h) + aoff + m * 2048 + k * 1024); } while (0)
#define PG8_LDB(dst, b, h) do { _Pragma("unroll") for (int n = 0; n < 2; ++n) _Pragma("unroll") for (int k = 0; k < 2; ++k) dst[n][k] = *(const PG8_LAS bf16x8*)(lds + PG8_SB(b, h) + boff + n * 2048 + k * 1024); } while (0)
#define PG8_MMA(ai, bj, At, Bt) do { __builtin_amdgcn_s_setprio(1); _Pragma("unroll") for (int m = 0; m < 4; ++m) _Pragma("unroll") for (int n = 0; n < 2; ++n) _Pragma("unroll") for (int k = 0; k < 2; ++k) \
        acc[ai][bj][m][n] = __builtin_amdgcn_mfma_f32_16x16x32_bf16(Bt[n][k], At[m][k], acc[ai][bj][m][n], 0, 0, 0); __builtin_amdgcn_s_setprio(0); } while (0)
#define PG8_WAIT_V(n) asm volatile("s_waitcnt vmcnt(" #n ")" ::: "memory")
#define PG8_WAIT_L(n) asm volatile("s_waitcnt lgkmcnt(" #n ")" ::: "memory")
#define PG8_BAR __builtin_amdgcn_s_barrier()
#define PG8_SCHED __builtin_amdgcn_sched_barrier(0)
#define PG8_AOFF(u) ((size_t)(((u).pn >> g.apn_shift) * g.apn_mul) * 2)
    Unit cur, nxt; int ui = 0;
    if (!S.next(0, cur)) return;
    f32x4 acc[2][2][4][2];
#pragma unroll
    for (int a = 0; a < 2; ++a)
#pragma unroll
        for (int b = 0; b < 2; ++b)
#pragma unroll
            for (int m = 0; m < 4; ++m)
#pragma unroll
                for (int n = 0; n < 2; ++n) acc[a][b][m][n] = (f32x4){0.f, 0.f, 0.f, 0.f};
    bf16x8 At[4][2], B0[2][2], B1[2][2];
    const char* cA = (const char*)g.A + (size_t)cur.pm * tstepA + PG8_AOFF(cur); const char* cB = (const char*)g.Bt + (size_t)cur.pn * tstepB;
    {
        PG8_STAGE(PG8_SB(0, 0), cB, voffB); PG8_STAGE(PG8_SB(0, 1), cB + hstepB, voffB); PG8_STAGE(PG8_SA(0, 0), cA, voffA); PG8_STAGE(PG8_SA(0, 1), cA + hstepA, voffA);
        if (wr == 1) PG8_BAR;
        PG8_WAIT_V(2); PG8_BAR;
        PG8_STAGE(PG8_SB(1, 0), cB + kstep, voffB); PG8_STAGE(PG8_SA(1, 0), cA + kstep, voffA); PG8_STAGE(PG8_SB(1, 1), cB + hstepB + kstep, voffB);
        PG8_WAIT_V(6); PG8_BAR;
    }
    for (;;) {
        const bool has_next = S.next(ui + 1, nxt);
        const char* nA = has_next ? (const char*)g.A + (size_t)nxt.pm * tstepA + PG8_AOFF(nxt) : cA; const char* nB = has_next ? (const char*)g.Bt + (size_t)nxt.pn * tstepB : cB;
        for (int t = 0; t < nt; t += 2) {
            const bool last = (t == nt - 2);
            const char* a1 = cA + (size_t)(t + 1) * kstep;
            const char* a2 = last ? nA : cA + (size_t)(t + 2) * kstep; const char* b2 = last ? nB : cB + (size_t)(t + 2) * kstep;
            const char* a3 = a2 + kstep; const char* b3 = b2 + kstep;
            PG8_LDB(B0, 0, 0); PG8_LDB(B1, 0, 1); PG8_SCHED; PG8_LDA(At, 0, 0); PG8_STAGE(PG8_SA(1, 1), a1 + hstepA, voffA);
            PG8_WAIT_V(8); PG8_WAIT_L(0); PG8_BAR; PG8_MMA(0, 0, At, B0); PG8_MMA(0, 1, At, B1); PG8_BAR; PG8_SCHED;
            PG8_LDA(At, 0, 1); PG8_STAGE(PG8_SB(0, 0), b2, voffB); PG8_STAGE(PG8_SB(0, 1), b2 + hstepB, voffB); PG8_STAGE(PG8_SA(0, 0), a2, voffA);
            PG8_WAIT_V(8); PG8_WAIT_L(0); PG8_BAR; PG8_MMA(1, 0, At, B0); PG8_MMA(1, 1, At, B1); PG8_BAR; PG8_SCHED;
            PG8_LDB(B0, 1, 0); PG8_LDB(B1, 1, 1); PG8_SCHED; PG8_LDA(At, 1, 0); PG8_STAGE(PG8_SA(0, 1), a2 + hstepA, voffA);
            PG8_WAIT_V(8); PG8_WAIT_L(0); PG8_BAR; PG8_MMA(0, 0, At, B0); PG8_MMA(0, 1, At, B1); PG8_BAR; PG8_SCHED;
            PG8_LDA(At, 1, 1); PG8_STAGE(PG8_SB(1, 0), b3, voffB); PG8_STAGE(PG8_SB(1, 1), b3 + hstepB, voffB); PG8_STAGE(PG8_SA(1, 0), a3, voffA);
            PG8_WAIT_V(8); PG8_WAIT_L(0); PG8_BAR; PG8_MMA(1, 0, At, B0); PG8_MMA(1, 1, At, B1); PG8_BAR; PG8_SCHED;
        }
        if constexpr (ALIGN_EPI) { if (wr == 0) PG8_BAR; }
        E(acc, cur, wr, wc, fr, fq);
        if (!has_next) break;
#pragma unroll
        for (int a = 0; a < 2; ++a)
#pragma unroll
            for (int b = 0; b < 2; ++b)
#pragma unroll
                for (int m = 0; m < 4; ++m)
#pragma unroll
                    for (int n = 0; n < 2; ++n) acc[a][b][m][n] = (f32x4){0.f, 0.f, 0.f, 0.f};
        cur = nxt; cA = nA; cB = nB; ++ui;
        if constexpr (ALIGN_EPI) { if (wr == 1) PG8_BAR; }
    }
    PG8_WAIT_V(0);
    if constexpr (!ALIGN_EPI) { if (wr == 0) PG8_BAR; }
    PG8_BAR;
#undef PG8_SA
#undef PG8_SB
#undef PG8_STAGE
#undef PG8_LDA
#undef PG8_LDB
#undef PG8_MMA
#undef PG8_WAIT_V
#undef PG8_WAIT_L
#undef PG8_BAR
#undef PG8_SCHED
#undef PG8_AOFF
}
}

constexpr size_t MiB = 1u << 20;
constexpr size_t WS_CTL = 0, CTL_ZERO_BYTES = 384 * 1024;
constexpr size_t WS_ROWSS = 64 * 1024;
constexpr size_t WS_SW = 160 * 1024;
constexpr size_t WS_MOD = 1 * MiB;
constexpr size_t WS_WIN = 2 * MiB;
constexpr size_t WS_WOUT = 28 * MiB;
constexpr size_t WS_WPOOL = 36 * MiB;
constexpr size_t WS_WM1 = 38 * MiB;
constexpr size_t WS_WM2 = 102 * MiB;
constexpr size_t WS_H = 166 * MiB;
constexpr size_t WS_ZB = 190 * MiB;
constexpr size_t WS_LF = 268 * MiB;
constexpr size_t WS_QN = 316 * MiB;
constexpr size_t WS_KP = 328 * MiB;
constexpr size_t WS_VP = 330 * MiB;
constexpr size_t WS_KS = 332 * MiB;
constexpr size_t WS_VS = 334 * MiB;
constexpr size_t WS_OF = 336 * MiB;
constexpr size_t WS_OB = 360 * MiB;
constexpr size_t WS_A2 = 384 * MiB;
constexpr size_t WS_XA = 408 * MiB;
constexpr size_t WS_U = 456 * MiB;
constexpr size_t WS_END = 552 * MiB;
constexpr int CW_BAR = 1024;

constexpr int RING_BYTES = 131072, LDSCTL_OFF = RING_BYTES, MISC_OFF = LDSCTL_OFF + 320, LDS_BYTES = 147456;
constexpr int NWAVES = 8;

#define RLX_AGENT __ATOMIC_RELAXED, __HIP_MEMORY_SCOPE_AGENT
#define LDS_WAIT() asm volatile("s_waitcnt lgkmcnt(0)" ::: "memory")
#define VM_WAIT() asm volatile("s_waitcnt vmcnt(0)" ::: "memory")

#define XB_TMO      128
#define XB_XCNT(j)  (256  + 64 * (j))
#define XB_XSUB(j)  (1280 + 64 * (j))
#define XB_XGEN(j)  (2304 + 64 * (j))
#define XB_TOP      3328
#define XB_TOPGEN   3392
#define XCD_BAR_WORDS 3456
#define XB_SPIN_CAP (1u << 18)
__device__ __forceinline__ unsigned xb_ld(unsigned* p)              { return __hip_atomic_load(p, __ATOMIC_RELAXED, __HIP_MEMORY_SCOPE_AGENT); }
__device__ __forceinline__ unsigned xb_add(unsigned* p, unsigned v) { return __hip_atomic_fetch_add(p, v, __ATOMIC_RELAXED, __HIP_MEMORY_SCOPE_AGENT); }
__device__ __forceinline__ unsigned xb_xcc_id() { return (unsigned)__builtin_amdgcn_s_getreg((3 << 11) | 20) & 0xFu; }
#define XB_SPIN(cond, bar) do { unsigned _sp = 0; while (cond) { __builtin_amdgcn_s_sleep(1); \
    if ((++_sp & 255u) == 0u) { if (xb_ld(&(bar)[XB_TMO])) break; if (_sp > XB_SPIN_CAP) { atomicAdd(&(bar)[XB_TMO], 1u); break; } } } } while (0)
struct XcdBarrier { unsigned* bar; unsigned x; volatile LAS unsigned* st; };
__device__ __forceinline__ XcdBarrier xcd_barrier_post(unsigned* bar, volatile LAS unsigned* st) {
    XcdBarrier b; b.bar = bar; b.x = xb_xcc_id(); b.st = st;
    if (threadIdx.x == 0) (void)xb_add(&bar[XB_XCNT(b.x)], 1u);
    return b;
}
__device__ __forceinline__ void xcd_barrier_complete(unsigned* bar, unsigned x, unsigned& nloc, unsigned& nx) {
    const unsigned G = gridDim.x * gridDim.y * gridDim.z;
    unsigned sum, cnt, mine, sp = 0u;
    for (;;) {
        sum = 0u; cnt = 0u; mine = 0u;
#pragma unroll
        for (unsigned j = 0; j < 16; ++j) { const unsigned c = xb_ld(&bar[XB_XCNT(j)]); sum += c; cnt += (c > 0u) ? 1u : 0u; mine = (j == x) ? c : mine; }
        if (sum == G) break;
        __builtin_amdgcn_s_sleep(1);
        if ((++sp & 255u) == 0u) { if (xb_ld(&bar[XB_TMO])) break; if (sp > XB_SPIN_CAP) { atomicAdd(&bar[XB_TMO], 1u); break; } }
    }
    nloc = mine > 0u ? mine : 1u; nx = cnt > 0u ? cnt : 1u;
}
__device__ __forceinline__ void xcd_barrier(const XcdBarrier& b) {
    asm volatile("s_waitcnt vmcnt(0)" ::: "memory");
    __syncthreads();
    if (threadIdx.x == 0) {
        unsigned* bar = b.bar;
        __builtin_amdgcn_s_waitcnt(0);
        unsigned nloc = b.st[0], nx = b.st[1];
        if (nloc == 0u) { xcd_barrier_complete(bar, b.x, nloc, nx); b.st[0] = nloc; b.st[1] = nx; }
        const unsigned old = xb_add(&bar[XB_XSUB(b.x)], 1u);
        const unsigned gen = old / nloc;
        if (old + 1u == (gen + 1u) * nloc) {
            __builtin_amdgcn_fence(__ATOMIC_RELEASE, "agent");
            asm volatile("s_waitcnt vmcnt(0)" ::: "memory");
            const unsigned og = xb_add(&bar[XB_TOP], 1u);
            const unsigned tg = og / nx;
            if (og + 1u == (tg + 1u) * nx) xb_add(&bar[XB_TOPGEN], 1u);
            else XB_SPIN(xb_ld(&bar[XB_TOPGEN]) == tg, bar);
            __builtin_amdgcn_fence(__ATOMIC_ACQUIRE, "agent");
            xb_add(&bar[XB_XGEN(b.x)], 1u);
            asm volatile("s_waitcnt vmcnt(0)" ::: "memory");
        } else {
            XB_SPIN(xb_ld(&bar[XB_XGEN(b.x)]) == gen, bar);
            __builtin_amdgcn_fence(__ATOMIC_ACQUIRE, "agent");
            asm volatile("s_waitcnt vmcnt(0)" ::: "memory");
        }
    }
    __syncthreads();
}

struct Args { const float* in[23]; float* out; unsigned char* ws; int ph_lo, ph_hi; };

__device__ __forceinline__ int cvec_of_row(int row) { return row < NTOK_P ? 0 : 1 + ((row - NTOK_P) >> 10); }
__device__ __forceinline__ const float* xin_row(const Args& a, int row) { return row < NTOK_P ? a.in[0] + (size_t)row * DM : a.in[1] + (size_t)(row - NTOK_P) * DM; }

struct EpiIn {
    static constexpr bool PERM = true;
    bf16_t* ZB; float* LF; const float* lb_raw;
    __device__ __forceinline__ void operator()(const f32x4 (&acc)[2][2][4][2], const pg8::Unit& u, int wr, int wc, int fr, int fq) const {
        const int row0 = u.pm * 256 + wr * 64 + fr, colt = u.pn * 256, cl = wc * 32 + 8 * fq;
        if (colt >= C_ZF && colt < C_HI) {
#pragma unroll
            for (int bj = 0; bj < 2; ++bj) {
                const int c2 = colt + bj * 128 + cl - C_ZF, dir = c2 >> 10, ch = c2 & 1023;
                float lb[8];
#pragma unroll
                for (int e = 0; e < 8; ++e) { const float x0 = lb_raw[dir * 3072 + ch + e], x1 = lb_raw[dir * 3072 + 1024 + ch + e], x2 = lb_raw[dir * 3072 + 2048 + ch + e];
                    lb[e] = 1.f / (1.f + __expf(x1 - x0) + __expf(x2 - x0)); }
#pragma unroll
                for (int ai = 0; ai < 2; ++ai)
#pragma unroll
                    for (int m = 0; m < 4; ++m) {
                        float* dst = LF + (size_t)(row0 + ai * 128 + m * 16) * 2048 + c2;
                        f32x4 o[2];
#pragma unroll
                        for (int n = 0; n < 2; ++n)
#pragma unroll
                            for (int e = 0; e < 4; ++e) { const float z = acc[ai][bj][m][n][e], sg = 1.f / (1.f + __expf(-z)), l = lb[n * 4 + e]; o[n][e] = __logf(l + (1.f - l) * sg); }
                        *(f32x4*)dst = o[0]; *(f32x4*)(dst + 4) = o[1];
                    }
            }
        } else {
            const bool act = (colt >= C_HQ && colt < C_ZF) || colt >= C_HG;
#pragma unroll
            for (int ai = 0; ai < 2; ++ai)
#pragma unroll
                for (int m = 0; m < 4; ++m) {
                    bf16_t* rowp = ZB + (size_t)(row0 + ai * 128 + m * 16) * IN_AB + colt + cl;
#pragma unroll
                    for (int bj = 0; bj < 2; ++bj) { f32x4 v0 = acc[ai][bj][m][0], v1 = acc[ai][bj][m][1];
                        if (act) {
#pragma unroll
                            for (int e = 0; e < 4; ++e) { v0[e] = siluf(v0[e]); v1[e] = siluf(v1[e]); } }
                        u32x4 w; w.x = cvtpk(v0[0], v0[1]); w.y = cvtpk(v0[2], v0[3]); w.z = cvtpk(v1[0], v1[1]); w.w = cvtpk(v1[2], v1[3]);
                        *(u32x4*)(rowp + bj * 128) = w; }
                }
        }
    }
};
struct EpiRes {
    static constexpr bool PERM = false;
    const float* baseP; const float* baseS; float* out; const float* gate; const float* pscale;
    bf16_t* XG; const float* ngain; const float* nsc;
    float* rowss;
    __device__ __forceinline__ void operator()(const f32x4 (&acc)[2][2][4][2], const pg8::Unit& u, int wr, int wc, int fr, int fq) const {
        const int col0 = u.pn * 256 + wc * 32 + 4 * fq;
        const int cv = u.pm < 16 ? 0 : 1 + ((u.pm - 16) >> 2);
        const float* gp = gate + (size_t)cv * 2 * NMODC;
        const float* bp = u.pm < 16 ? baseP + (size_t)u.pm * 256 * DM : baseS + (size_t)(u.pm - 16) * 256 * DM;
        float* op = out + (size_t)u.pm * 256 * DM;
        float ss[2][4];
#pragma unroll
        for (int ai = 0; ai < 2; ++ai)
#pragma unroll
            for (int m = 0; m < 4; ++m) ss[ai][m] = 0.f;
#pragma unroll
        for (int bj = 0; bj < 2; ++bj)
#pragma unroll
            for (int n = 0; n < 2; ++n) {
                const int col = col0 + bj * 128 + n * 16;
                f32x4 g4 = *(const f32x4*)(gp + col);
                if (pscale) g4 = g4 * *(const f32x4*)(pscale + col);
                f32x4 gm = {0.f, 0.f, 0.f, 0.f};
                if (XG) gm = *(const f32x4*)(ngain + col) * (*(const f32x4*)(nsc + (size_t)cv * 2 * NMODC + col) + 1.f);
#pragma unroll
                for (int ai = 0; ai < 2; ++ai)
#pragma unroll
                    for (int m = 0; m < 4; ++m) { const size_t off = (size_t)(ai * 128 + wr * 64 + m * 16 + fr) * DM + col;
                        const f32x4 b = *(const f32x4*)(bp + off); const f32x4 x = b + g4 * acc[ai][bj][m][n]; *(f32x4*)(op + off) = x;
                        ss[ai][m] += (x.x * x.x + x.y * x.y) + (x.z * x.z + x.w * x.w);
                        if (XG) { const f32x4 y = x * gm; u32x2 w; w.x = cvtpk(y.x, y.y); w.y = cvtpk(y.z, y.w); *(u32x2*)(XG + (size_t)u.pm * 256 * DM + off) = w; } }
            }
#pragma unroll
        for (int ai = 0; ai < 2; ++ai)
#pragma unroll
            for (int m = 0; m < 4; ++m) { float s = ss[ai][m]; s += __shfl_xor(s, 16); s += __shfl_xor(s, 32);
                if (fq == 0) atomicAdd(rowss + u.pm * 256 + ai * 128 + wr * 64 + m * 16 + fr, s); }
    }
};
struct EpiRelu2 {
    static constexpr bool PERM = true;
    bf16_t* U; const float* rowss; const float* sW;
    __device__ __forceinline__ void operator()(const f32x4 (&acc)[2][2][4][2], const pg8::Unit& u, int wr, int wc, int fr, int fq) const {
        const int row0 = u.pm * 256 + wr * 64 + fr, col0 = u.pn * 256 + wc * 32 + 8 * fq;
        const int cv = u.pm < 16 ? 0 : 1 + ((u.pm - 16) >> 2);
        f32x4 sw[2][2];
#pragma unroll
        for (int bj = 0; bj < 2; ++bj)
#pragma unroll
            for (int n = 0; n < 2; ++n) sw[bj][n] = *(const f32x4*)(sW + (size_t)cv * DFF + col0 + bj * 128 + 4 * n);
#pragma unroll
        for (int ai = 0; ai < 2; ++ai)
#pragma unroll
            for (int m = 0; m < 4; ++m) { const int row = row0 + ai * 128 + m * 16; bf16_t* rowp = U + (size_t)row * DFF + col0;
                const float rs = rsqrtf(rowss[row] * (1.f / DM) + EPS);
#pragma unroll
                for (int bj = 0; bj < 2; ++bj) { f32x4 v0 = acc[ai][bj][m][0] * rs + sw[bj][0], v1 = acc[ai][bj][m][1] * rs + sw[bj][1];
#pragma unroll
                    for (int e = 0; e < 4; ++e) { const float a = fmaxf(v0[e], 0.f), b = fmaxf(v1[e], 0.f); v0[e] = a * a; v1[e] = b * b; }
                    u32x4 w; w.x = cvtpk(v0[0], v0[1]); w.y = cvtpk(v0[2], v0[3]); w.z = cvtpk(v1[0], v1[1]); w.w = cvtpk(v1[2], v1[3]);
                    *(u32x4*)(rowp + bj * 128) = w; } }
    }
};

__device__ __forceinline__ void p0_transpose_item(const float* W, int K, int N, bf16_t* WT, int row_off, LAS float* scr, int item, int lane, const float* shp = nullptr, float* sWp = nullptr) {
    const int nblk = N / 32, kb = item / nblk, nb = item % nblk, k0 = 64 * kb, n0 = 32 * nb;
#pragma unroll 8
    for (int i = 0; i < 32; ++i) { const int kk = 2 * i + (lane >> 5); scr[kk * 33 + (lane & 31)] = W[(size_t)(k0 + kk) * N + n0 + (lane & 31)]; }
    LDS_WAIT(); asm volatile("" ::: "memory");
    if (shp) {
        const float h0 = shp[k0 + lane], h1 = shp[2 * NMODC + k0 + lane], h2 = shp[4 * NMODC + k0 + lane];
        float s0 = 0.f, s1 = 0.f, s2 = 0.f; const int n = lane & 31;
#pragma unroll 4
        for (int k = 0; k < 64; ++k) { const float w = scr[k * 33 + n];
            s0 += w * __builtin_bit_cast(float, __builtin_amdgcn_readlane(__builtin_bit_cast(int, h0), k));
            s1 += w * __builtin_bit_cast(float, __builtin_amdgcn_readlane(__builtin_bit_cast(int, h1), k));
            s2 += w * __builtin_bit_cast(float, __builtin_amdgcn_readlane(__builtin_bit_cast(int, h2), k)); }
        if (lane < 32) { atomicAdd(sWp + n0 + n, s0); atomicAdd(sWp + DFF + n0 + n, s1); atomicAdd(sWp + 2 * DFF + n0 + n, s2); }
    }
    const int c = lane & 7;
#pragma unroll
    for (int j = 0; j < 4; ++j) { const int n = (lane >> 3) + 8 * j; const LAS float* s = scr + (8 * c) * 33 + n;
        u32x4 o; o.x = cvtpk(s[0 * 33], s[1 * 33]); o.y = cvtpk(s[2 * 33], s[3 * 33]); o.z = cvtpk(s[4 * 33], s[5 * 33]); o.w = cvtpk(s[6 * 33], s[7 * 33]);
        *(u32x4*)(WT + (size_t)(row_off + n0 + n) * K + k0 + 8 * c) = o; }
    LDS_WAIT(); asm volatile("" ::: "memory");
}
__device__ __forceinline__ void p0_ada_item(const Args& a, LAS unsigned char* lds, int wi, int tid) {
    LAS float* sc = (LAS float*)lds;
    LAS float* red = (LAS float*)(lds + 24576);
    const int l = wi >> 7, col0 = 96 * (wi & 127);
    for (int i = tid; i < 3 * 2048; i += 512) { const int v = i >> 11, k = i & 2047; const float x = v == 0 ? a.in[7][k] : a.in[6][(v - 1) * 2048 + k]; sc[i] = siluf(x); }
    __syncthreads();
    const int c4 = tid % 24, r = tid / 24;
    if (r < 21) {
        f32x4 a0 = {0.f, 0.f, 0.f, 0.f}, a1 = a0, a2 = a0;
        const float* wp = a.in[8] + (size_t)l * 2048 * NMODC + col0 + 4 * c4;
#pragma unroll 4
        for (int k = r; k < 2048; k += 21) { const f32x4 w = *(const f32x4*)(wp + (size_t)k * NMODC); a0 += w * sc[k]; a1 += w * sc[2048 + k]; a2 += w * sc[4096 + k]; }
        LAS float* rp = red + (r * 24 + c4) * 12;
        *(LAS f32x4*)rp = a0; *(LAS f32x4*)(rp + 4) = a1; *(LAS f32x4*)(rp + 8) = a2;
    }
    __syncthreads();
    if (tid < 288) { const int v = tid / 96, c = tid % 96; float s = 0.f;
        for (int rr = 0; rr < 21; ++rr) s += red[(rr * 24 + (c >> 2)) * 12 + v * 4 + (c & 3)];
        float* mod = (float*)(a.ws + WS_MOD);
        mod[(size_t)v * 2 * NMODC + l * NMODC + col0 + c] = s + a.in[9][l * NMODC + col0 + c]; }
    __syncthreads();
}

constexpr int I_IN = 32 * 208, I_OUT = 32 * 64, I_POOL = 8 * 16, I_M1 = 32 * 256, I_M2 = 128 * 64;
constexpr int R_IN = 0, R_OUT = R_IN + I_IN, R_M1_0 = R_OUT + I_OUT, R_M2_0 = R_M1_0 + I_M1, R_POOL = R_M2_0 + I_M2, R_M1_1 = R_POOL + 4 * I_POOL, R_M2_1 = R_M1_1 + I_M1, R_END = R_M2_1 + I_M2;
__device__ __forceinline__ void transpose_dispatch(const Args& a, int it, LAS float* scr, int lane) {
    unsigned char* ws = a.ws;
    const float* MOD = (const float*)(ws + WS_MOD); float* SW = (float*)(ws + WS_SW);
    if (it < R_OUT) { p0_transpose_item(a.in[12], 2048, IN_AB, (bf16_t*)(ws + WS_WIN), 0, scr, it - R_IN, lane); return; }
    if (it < R_M1_0) { p0_transpose_item(a.in[13], 2048, 2048, (bf16_t*)(ws + WS_WOUT), 0, scr, it - R_OUT, lane); return; }
    if (it < R_M2_0) { p0_transpose_item(a.in[20], 2048, DFF, (bf16_t*)(ws + WS_WM1), 0, scr, it - R_M1_0, lane, MOD + 3 * 2048, SW); return; }
    if (it < R_POOL) { p0_transpose_item(a.in[21], DFF, 2048, (bf16_t*)(ws + WS_WM2), 0, scr, it - R_M2_0, lane); return; }
    if (it < R_M1_1) { const int r = it - R_POOL, g = r / I_POOL; p0_transpose_item(a.in[18] + (size_t)g * 512 * 512, 512, 512, (bf16_t*)(ws + WS_WPOOL), g * 512, scr, r % I_POOL, lane); return; }
    if (it < R_M2_1) { p0_transpose_item(a.in[20] + (size_t)2048 * DFF, 2048, DFF, (bf16_t*)(ws + WS_WM1) + (size_t)DFF * 2048, 0, scr, it - R_M1_1, lane, MOD + NMODC + 3 * 2048, SW + 3 * DFF); return; }
    p0_transpose_item(a.in[21] + (size_t)DFF * 2048, DFF, 2048, (bf16_t*)(ws + WS_WM2) + (size_t)2048 * DFF, 0, scr, it - R_M2_1, lane);
}
__device__ __forceinline__ void bg_transposes(const Args& a, LAS unsigned char* lds, int lo, int hi, int w, int nw, int wave, int lane) {
    LAS float* scr = (LAS float*)(lds + wave * 16384);
    for (int it = lo + w; it < hi; it += nw) transpose_dispatch(a, it, scr, lane);
}

__device__ __forceinline__ void norm_rows_bf16(const Args& a, const float* xa  , const float* gain, int layer, int soff, bf16_t* H, int gw, int ngw, int lane) {
    const float* mod = (const float*)(a.ws + WS_MOD);
    for (int row = gw; row < NTOK; row += ngw) {
        const float* xr = xa ? xa + (size_t)row * DM : xin_row(a, row);
        const float* mp = mod + (size_t)cvec_of_row(row) * 2 * NMODC + layer * NMODC + soff;
        f32x4 v[8]; float ss = 0.f;
#pragma unroll
        for (int j = 0; j < 8; ++j) { v[j] = *(const f32x4*)(xr + 4 * (lane + 64 * j)); ss += v[j].x * v[j].x + v[j].y * v[j].y + v[j].z * v[j].z + v[j].w * v[j].w; }
        const float rstd = rsqrtf(wave_sum(ss) * (1.f / DM) + EPS);
#pragma unroll
        for (int j = 0; j < 8; ++j) { const int c = 4 * (lane + 64 * j);
            const f32x4 g = *(const f32x4*)(gain + c), sh = *(const f32x4*)(mp + c), sc = *(const f32x4*)(mp + 2048 + c);
            const f32x4 y = v[j] * rstd * g * (sc + 1.f) + sh;
            u32x2 w; w.x = cvtpk(y.x, y.y); w.y = cvtpk(y.z, y.w);
            *(u32x2*)(H + (size_t)row * DM + c) = w; }
    }
}
__device__ __forceinline__ void norm_rows_f32(const Args& a, const float* xa, const float* gain, int layer, int soff  , float* O, int gw, int ngw, int lane) {
    const float* mod = (const float*)(a.ws + WS_MOD);
    for (int row = gw; row < NTOK; row += ngw) {
        const float* xr = xa + (size_t)row * DM;
        const float* mp = mod + (size_t)cvec_of_row(row) * 2 * NMODC + layer * NMODC + (soff < 0 ? 0 : soff);
        f32x4 v[8]; float ss = 0.f;
#pragma unroll
        for (int j = 0; j < 8; ++j) { v[j] = *(const f32x4*)(xr + 4 * (lane + 64 * j)); ss += v[j].x * v[j].x + v[j].y * v[j].y + v[j].z * v[j].z + v[j].w * v[j].w; }
        const float rstd = rsqrtf(wave_sum(ss) * (1.f / DM) + EPS);
#pragma unroll
        for (int j = 0; j < 8; ++j) { const int c = 4 * (lane + 64 * j);
            const f32x4 g = *(const f32x4*)(gain + c);
            f32x4 y = v[j] * rstd * g;
            if (soff >= 0) { const f32x4 sh = *(const f32x4*)(mp + c), sc = *(const f32x4*)(mp + 2048 + c); y = y * (sc + 1.f) + sh; }
            *(f32x4*)(O + (size_t)row * DM + c) = y; }
    }
}
template <int HW> __device__ __forceinline__ void pool_out(const LAS float* T, bf16_t* P, int row0, int t0, int Tseq, int cb, int tid) {
    const int cq = tid & 63, tgp = tid >> 6;
#pragma unroll
    for (int j = 0; j < 8; ++j) { const int tl = tgp * 8 + j, t = t0 + tl;
        f32x4 s = {0.f, 0.f, 0.f, 0.f};
#pragma unroll
        for (int d = -HW; d < HW; ++d) { const int u = t + d; const f32x4 v = *(const LAS f32x4*)(T + (tl + 8 + d) * 256 + cq * 4); if (u >= 0 && u < Tseq) s += v; }
        const int lo = max(t - HW, 0), hi = min(t + HW, Tseq);
        const f32x4 x = *(const LAS f32x4*)(T + (tl + 8) * 256 + cq * 4);
        const f32x4 y = s * (1.f / (float)(hi - lo)) - x;
        u32x2 w; w.x = cvtpk(y.x, y.y); w.y = cvtpk(y.z, y.w);
        *(u32x2*)(P + (size_t)(row0 + tl) * DM + cb * 256 + cq * 4) = w; }
}
__device__ __forceinline__ void pool_phase(const Args& a, LAS unsigned char* lds, const float* XA, const float* rowss, bf16_t* P, int bx, int G, int tid) {
    LAS float* T = (LAS float*)lds;
    const float* MOD = (const float*)(a.ws + WS_MOD);
    const int lane = tid & 63, wave = tid >> 6;
    for (int item = bx; item < 768; item += G) {
        const int tt = item >> 3, cb = item & 7, g = cb >> 1, row0 = tt * 64;
        int s0, Tseq;
        if (row0 < NTOK_P) { s0 = row0 & ~255; Tseq = SEQ_P; } else { s0 = NTOK_P + ((row0 - NTOK_P) & ~1023); Tseq = SEQ_S; }
        const int t0 = row0 - s0, c = cb * 256 + lane * 4;
        const float* mp = MOD + (size_t)cvec_of_row(row0) * 2 * NMODC + NMODC;
        const f32x4 gmul = *(const f32x4*)(a.in[10] + 2048 + c) * (*(const f32x4*)(mp + 2048 + c) + 1.f), sh = *(const f32x4*)(mp + c);
        for (int rr = wave; rr < 80; rr += 8) { const int t = t0 - 8 + rr;
            if (t >= 0 && t < Tseq) { const int row = s0 + t; const float rstd = rsqrtf(rowss[row] * (1.f / DM) + EPS);
                const f32x4 x = *(const f32x4*)(XA + (size_t)row * DM + c);
                *(LAS f32x4*)(T + rr * 256 + lane * 4) = x * rstd * gmul + sh; } }
        __syncthreads();
        switch (g) { case 0: pool_out<1>(T, P, row0, t0, Tseq, cb, tid); break; case 1: pool_out<2>(T, P, row0, t0, Tseq, cb, tid); break;
                     case 2: pool_out<4>(T, P, row0, t0, Tseq, cb, tid); break; default: pool_out<8>(T, P, row0, t0, Tseq, cb, tid); break; }
        __syncthreads();
    }
}
__device__ __forceinline__ void final_rows(const float* XA, const float* rowss, const float* gain, float* O, int gw, int ngw, int lane) {
    for (int row = gw; row < NTOK; row += ngw) { const float rstd = rsqrtf(rowss[row] * (1.f / DM) + EPS);
#pragma unroll
        for (int j = 0; j < 8; ++j) { const int c = 4 * (lane + 64 * j);
            *(f32x4*)(O + (size_t)row * DM + c) = *(const f32x4*)(XA + (size_t)row * DM + c) * rstd * *(const f32x4*)(gain + c); } }
}

__device__ __forceinline__ void post_token(const Args& a, int row, int lane) {
    const bf16_t* ZB = (const bf16_t*)(a.ws + WS_ZB);
    bf16_t* QN = (bf16_t*)(a.ws + WS_QN);
    const bool samp = row >= NTOK_P;
    const int bb = samp ? (row - NTOK_P) >> 10 : row >> 8, t = samp ? (row - NTOK_P) & 1023 : row & 255;
    const int e0 = (lane & 31) * 4, hsel = lane >> 5;
    const int sect = e0 >> 5;
    float cs[4], sn[4];
    if (samp) {
        const float pos = (float)((sect < 2) ? (t >> 6) : (t & 63));
#pragma unroll
        for (int i = 0; i < 4; ++i) { const int j = (e0 + i) & 31; const float inv = exp2f(-(float)j * 0.41524101186092033f); const float ang = pos * inv; cs[i] = __cosf(ang); sn[i] = __sinf(ang); }
    }
#pragma unroll
    for (int p = 0; p < 6; ++p) {
        const int col = p * 256 + lane * 4;
        const u32x2 raw = *(const u32x2*)(ZB + (size_t)row * IN_AB + col);
        float y[4] = {bflo(raw.x), bfhi(raw.x), bflo(raw.y), bfhi(raw.y)};
        if (p < 5) {
            const float ss = half_sum(y[0] * y[0] + y[1] * y[1] + y[2] * y[2] + y[3] * y[3]);
            const float rstd = rsqrtf(ss * (1.f / 128.f) + EPS);
            const f32x4 g = *(const f32x4*)((p < 4 ? a.in[14] : a.in[15]) + e0);
            y[0] *= rstd * g.x; y[1] *= rstd * g.y; y[2] *= rstd * g.z; y[3] *= rstd * g.w;
        }
        if (!samp && p >= 4) {
            float* o = a.out + (p == 4 ? 12582912 : 13631488) + (size_t)row * 256 + lane * 4;
            *(f32x4*)o = (f32x4){y[0], y[1], y[2], y[3]};
        }
        if (samp && p < 5) {
#pragma unroll
            for (int i = 0; i < 4; ++i) { const float py = __shfl_xor(y[i], 8); const float rot = (sect & 1) ? py : -py; y[i] = y[i] * cs[i] + rot * sn[i]; }
        }
        u32x2 w; w.x = cvtpk(y[0], y[1]); w.y = cvtpk(y[2], y[3]);
        if (p < 4) *(u32x2*)(QN + (size_t)row * 1024 + col) = w;
        else {
            bf16_t* dst;
            if (samp) dst = (bf16_t*)(a.ws + (p == 4 ? WS_KS : WS_VS)) + ((size_t)(bb * 2 + hsel) * 1280 + t) * 128 + e0;
            else      dst = (bf16_t*)(a.ws + (p == 4 ? WS_KP : WS_VP)) + ((size_t)(bb * 2 + hsel) * 256 + t) * 128 + e0;
            *(u32x2*)dst = w;
        }
    }
}
__device__ __forceinline__ void cache_item(const Args& a, int item, int lane) {
    const int which = item >> 9, b = (item >> 8) & 1, t = item & 255, hsel = lane >> 5, e0 = (lane & 31) * 4;
    const f32x4 v = *(const f32x4*)(a.in[2 + which] + ((size_t)(b * 256 + t) * 2 + hsel) * 128 + e0);
    bf16_t* dst = (bf16_t*)(a.ws + (which == 0 ? WS_KS : WS_VS)) + ((size_t)(b * 2 + hsel) * 1280 + 1024 + t) * 128 + e0;
    u32x2 w; w.x = cvtpk(v.x, v.y); w.y = cvtpk(v.z, v.w);
    *(u32x2*)dst = w;
}
__device__ __forceinline__ void combine_token(const Args& a, int row, int lane) {
    const float* OF = (const float*)(a.ws + WS_OF); const float* OB = (const float*)(a.ws + WS_OB);
    const bf16_t* ZB = (const bf16_t*)(a.ws + WS_ZB); bf16_t* A2 = (bf16_t*)(a.ws + WS_A2);
    const int e0 = (lane & 31) * 4;
    const f32x4 g = *(const f32x4*)(a.in[16] + e0);
#pragma unroll
    for (int p = 0; p < 4; ++p) {
        const int col = p * 256 + lane * 4;
        const f32x4 o = *(const f32x4*)(OF + (size_t)row * 1024 + col) + *(const f32x4*)(OB + (size_t)row * 1024 + col);
        const float ss = half_sum(o.x * o.x + o.y * o.y + o.z * o.z + o.w * o.w);
        const float rstd = rsqrtf(ss * (1.f / 128.f) + EPS);
        const u32x2 raw = *(const u32x2*)(ZB + (size_t)row * IN_AB + C_HG + col);
        const f32x4 y = o * rstd * g * (f32x4){bflo(raw.x), bfhi(raw.x), bflo(raw.y), bfhi(raw.y)};
        u32x2 w; w.x = cvtpk(y.x, y.y); w.y = cvtpk(y.z, y.w);
        *(u32x2*)(A2 + (size_t)row * DM + 1024 + col) = w;
    }
}

constexpr int HG_ROW = 136, HG_TROW = 40;
constexpr int HG_QI = 0, HG_KI = 32 * HG_ROW * 2, HG_QS = 2 * 32 * HG_ROW * 2, HG_KST = 3 * 32 * HG_ROW * 2, HG_IT = HG_KST + 128 * HG_TROW * 2, HG_A = HG_IT + 128 * HG_TROW * 2, HG_GT = HG_A + 512, HG_SEQ_BYTES = HG_GT + 4096;
static_assert(HG_SEQ_BYTES % 16 == 0 && 2 * HG_SEQ_BYTES <= RING_BYTES, "hgrn lds");
__device__ __forceinline__ int crow(int r, int hi) { return (r & 3) + 8 * (r >> 2) + 4 * hi; }
__device__ __forceinline__ int kpos(int k) { const int kp = k & 15; return (k & 16) + (((kp >> 2) & 1) << 3) + ((kp >> 3) << 2) + (kp & 3); }
#define MFMA32(a, b, c) __builtin_amdgcn_mfma_f32_32x32x16_bf16((a), (b), (c), 0, 0, 0)
__device__ __forceinline__ bf16x8 pack8(const f32x16& x, int s) {
    u32x4 p; p.x = cvtpk(x[8 * s], x[8 * s + 1]); p.y = cvtpk(x[8 * s + 2], x[8 * s + 3]); p.z = cvtpk(x[8 * s + 4], x[8 * s + 5]); p.w = cvtpk(x[8 * s + 6], x[8 * s + 7]);
    return __builtin_bit_cast(bf16x8, p);
}
__device__ __forceinline__ void hgrn_task(const Args& a, LAS unsigned char* lds0, int task, int tid) {
    const bool samp = task < 16;
    const int bb = samp ? task >> 3 : (task - 16) >> 3, hh = task & 7;
    const int rowbase = samp ? NTOK_P + bb * SEQ_S : bb * SEQ_P, NCH = samp ? SEQ_S / 32 : SEQ_P / 32;
    const int dir = tid >> 8, tl = tid & 255, lane = tid & 63, wq = (tid >> 6) & 3, r32 = lane & 31, hi = lane >> 5;
    LAS unsigned char* L = lds0 + dir * HG_SEQ_BYTES;
    const bf16_t* ZB = (const bf16_t*)(a.ws + WS_ZB); const float* LF = (const float*)(a.ws + WS_LF);
    float* OUT = (float*)(a.ws + (dir == 0 ? WS_OF : WS_OB));
    const int cg = tl & 31, tg = tl >> 5, e0 = 32 * wq;
    f32x16 S[4];
    if (samp) { const float* s0 = a.in[4 + dir] + (size_t)(bb * 8 + hh) * 16384;
#pragma unroll
        for (int db = 0; db < 4; ++db)
#pragma unroll
            for (int i = 0; i < 16; ++i) S[db][i] = s0[(size_t)(32 * db + crow(i, hi)) * 128 + e0 + r32];
    } else {
#pragma unroll
        for (int db = 0; db < 4; ++db)
#pragma unroll
            for (int i = 0; i < 16; ++i) S[db][i] = 0.f;
    }
    f32x4 lf[4]; u32x2 qv[4], iv[4];
#define HG_LOAD(ch) do { _Pragma("unroll") for (int jj = 0; jj < 4; ++jj) { const int j = 4 * tg + jj; \
        const int row = rowbase + (dir == 0 ? 32 * (ch) + j : 32 * (NCH - 1 - (ch)) + 31 - j); \
        lf[jj] = *(const f32x4*)(LF + (size_t)row * 2048 + dir * 1024 + hh * 128 + 4 * cg); \
        qv[jj] = *(const u32x2*)(ZB + (size_t)row * IN_AB + C_HQ + hh * 128 + 4 * cg); \
        iv[jj] = *(const u32x2*)(ZB + (size_t)row * IN_AB + C_HI + hh * 128 + 4 * cg); } } while (0)
    HG_LOAD(0);
    for (int ch = 0; ch < NCH; ++ch) {
        f32x4 cb[4]; cb[0] = lf[0]; cb[1] = cb[0] + lf[1]; cb[2] = cb[1] + lf[2]; cb[3] = cb[2] + lf[3];
        *(LAS f32x4*)(L + HG_GT + (tg * 128 + 4 * cg) * 4) = cb[3];
        __syncthreads();
        f32x4 off = {0.f, 0.f, 0.f, 0.f}, bm = off, bl = off;
#pragma unroll
        for (int g = 0; g < 8; ++g) { const f32x4 t4 = *(const LAS f32x4*)(L + HG_GT + (g * 128 + 4 * cg) * 4); if (g < tg) off += t4; if (g < 4) bm += t4; bl += t4; }
        f32x4 em, elm;
#pragma unroll
        for (int c = 0; c < 4; ++c) { em[c] = __expf(bm[c]); elm[c] = __expf(bl[c] - bm[c]); }
        if (tg == 0) { f32x4 av;
#pragma unroll
            for (int c = 0; c < 4; ++c) av[c] = __expf(bl[c]);
            *(LAS f32x4*)(L + HG_A + 16 * cg) = av; }
        float kI_[4][4], kS_[4][4], iv_[4][4];
#pragma unroll
        for (int jj = 0; jj < 4; ++jj) {
            const int j = 4 * tg + jj;
            const float q4[4] = {bflo(qv[jj].x), bfhi(qv[jj].x), bflo(qv[jj].y), bfhi(qv[jj].y)};
            iv_[jj][0] = bflo(iv[jj].x); iv_[jj][1] = bfhi(iv[jj].x); iv_[jj][2] = bflo(iv[jj].y); iv_[jj][3] = bfhi(iv[jj].y);
            float qI[4], qS[4];
#pragma unroll
            for (int c = 0; c < 4; ++c) {
                const float b = off[c] + cb[jj][c];
                const float E1 = __expf(fminf(fmaxf(b - bm[c], -80.f), 80.f)), R1 = 1.f / E1;
                const float kk = 1.f - __expf(lf[jj][c]);
                qI[c] = q4[c] * E1; qS[c] = qI[c] * em[c];
                kI_[jj][c] = kk * R1; kS_[jj][c] = kI_[jj][c] * elm[c];
            }
            u32x2 w; w.x = cvtpk(qI[0], qI[1]); w.y = cvtpk(qI[2], qI[3]);
            *(LAS u32x2*)(L + HG_QI + (j * HG_ROW + 4 * cg) * 2) = w;
            w.x = cvtpk(kI_[jj][0], kI_[jj][1]); w.y = cvtpk(kI_[jj][2], kI_[jj][3]);
            *(LAS u32x2*)(L + HG_KI + (j * HG_ROW + 4 * cg) * 2) = w;
            w.x = cvtpk(qS[0], qS[1]); w.y = cvtpk(qS[2], qS[3]);
            *(LAS u32x2*)(L + HG_QS + (j * HG_ROW + (4 * cg & ~31) + kpos(4 * cg & 31)) * 2) = w;
        }
        {
            const int p0 = kpos(4 * tg);
#pragma unroll
            for (int c = 0; c < 4; ++c) { u32x2 w; w.x = cvtpk(kS_[0][c], kS_[1][c]); w.y = cvtpk(kS_[2][c], kS_[3][c]);
                *(LAS u32x2*)(L + HG_KST + ((4 * cg + c) * HG_TROW + p0) * 2) = w;
                w.x = cvtpk(iv_[0][c], iv_[1][c]); w.y = cvtpk(iv_[2][c], iv_[3][c]);
                *(LAS u32x2*)(L + HG_IT + ((4 * cg + c) * HG_TROW + p0) * 2) = w; }
        }
        if (ch + 1 < NCH) HG_LOAD(ch + 1);
        __syncthreads();
        f32x16 x;
#pragma unroll
        for (int i = 0; i < 16; ++i) x[i] = 0.f;
#pragma unroll
        for (int ks = 0; ks < 8; ++ks) {
            const bf16x8 fa = *(const LAS bf16x8*)(L + HG_KI + (r32 * HG_ROW + 16 * ks + 8 * hi) * 2);
            const bf16x8 fb = *(const LAS bf16x8*)(L + HG_QI + (r32 * HG_ROW + 16 * ks + 8 * hi) * 2);
            x = MFMA32(fa, fb, x);
        }
#pragma unroll
        for (int i = 0; i < 16; ++i) x[i] = (crow(i, hi) <= r32) ? x[i] : 0.f;
        f32x16 y;
#pragma unroll
        for (int i = 0; i < 16; ++i) y[i] = 0.f;
        bf16x8 fi[2];
#pragma unroll
        for (int ks = 0; ks < 2; ++ks) {
            fi[ks] = *(const LAS bf16x8*)(L + HG_IT + ((e0 + r32) * HG_TROW + 16 * ks + 8 * hi) * 2);
            y = MFMA32(fi[ks], pack8(x, ks), y);
        }
#pragma unroll
        for (int db = 0; db < 4; ++db)
#pragma unroll
            for (int ks = 0; ks < 2; ++ks) {
                const bf16x8 fq_ = *(const LAS bf16x8*)(L + HG_QS + (r32 * HG_ROW + 32 * db + 16 * ks + 8 * hi) * 2);
                y = MFMA32(pack8(S[db], ks), fq_, y);
            }
        {
            const int row = rowbase + (dir == 0 ? 32 * ch + r32 : 32 * (NCH - 1 - ch) + 31 - r32);
            float* op = OUT + (size_t)row * 1024 + hh * 128 + e0 + 4 * hi;
#pragma unroll
            for (int g4 = 0; g4 < 4; ++g4) *(f32x4*)(op + 8 * g4) = (f32x4){y[4 * g4], y[4 * g4 + 1], y[4 * g4 + 2], y[4 * g4 + 3]};
        }
#pragma unroll
        for (int db = 0; db < 4; ++db) {
#pragma unroll
            for (int g4 = 0; g4 < 4; ++g4) { const f32x4 a4 = *(const LAS f32x4*)(L + HG_A + (32 * db + 8 * g4 + 4 * hi) * 4);
#pragma unroll
                for (int c = 0; c < 4; ++c) S[db][4 * g4 + c] *= a4[c]; }
#pragma unroll
            for (int ks = 0; ks < 2; ++ks) {
                const bf16x8 fk = *(const LAS bf16x8*)(L + HG_KST + ((32 * db + r32) * HG_TROW + 16 * ks + 8 * hi) * 2);
                S[db] = MFMA32(fk, fi[ks], S[db]);
            }
        }
    }
#undef HG_LOAD
    if (!samp) { float* so = a.out + (dir == 0 ? 14680064 : 16777216) + (size_t)(bb * 8 + hh) * 16384;
#pragma unroll
        for (int db = 0; db < 4; ++db)
#pragma unroll
            for (int i = 0; i < 16; ++i) so[(size_t)(32 * db + crow(i, hi)) * 128 + e0 + r32] = S[db][i];
    }
    __syncthreads();
}

namespace att {
constexpr int D = 128, NW = 8, QBLK = 32, KVBLK = 64;
constexpr float SCALE = 0.088388347648318440f;
constexpr float THR = 0.f;
constexpr int LDQ = 1024, LDK = 128, LDO = 2048;
constexpr int SHM_V = KVBLK * D * 2, SHM_K = KVBLK * D * 2, SHM_ATTN = 2 * SHM_V + 2 * SHM_K + NW * 64 * 4;
#define KSWZ(row, colB) ((row) * 256 + ((colB) ^ (((row) & 7) << 4)))
#define SBAR() __builtin_amdgcn_sched_barrier(0)
__device__ __forceinline__ unsigned cvtpk_a(float lo, float hi) { unsigned r; asm volatile("v_cvt_pk_bf16_f32 %0, %1, %2" : "=v"(r) : "v"(lo), "v"(hi)); return r; }
__device__ __forceinline__ void partialSM(f32x16& p0, f32x16& p1, float& m_reg, float& mn, float& alpha) {
  constexpr float C = SCALE * 1.4426950408889634f;
  float pmax = p0[0]; for (int r = 1; r < 16; ++r) pmax = fmaxf(pmax, p0[r]); for (int r = 0; r < 16; ++r) pmax = fmaxf(pmax, p1[r]);
  { auto rr = __builtin_amdgcn_permlane32_swap(__float_as_uint(pmax), __float_as_uint(pmax), false, false);
    pmax = fmaxf(__uint_as_float(rr[0]), __uint_as_float(rr[1])); }
  if (__builtin_expect(__all(pmax - m_reg <= THR / SCALE), 1)) { mn = m_reg; alpha = 1.f; }
  else { mn = fmaxf(m_reg, pmax); alpha = __builtin_amdgcn_exp2f((m_reg - mn) * C); m_reg = mn; }
  float mnC = -mn * C;
  for (int r = 0; r < 16; ++r) p0[r] = fmaf(p0[r], C, mnC); for (int r = 0; r < 16; ++r) p1[r] = fmaf(p1[r], C, mnC);
  for (int r = 0; r < 16; ++r) p0[r] = __builtin_amdgcn_exp2f(p0[r]);
}
__device__ __forceinline__ void finishSM(f32x16& p0, f32x16& p1, float alpha, float& l_reg, bf16x8& pa0, bf16x8& pa1, bf16x8& pa2, bf16x8& pa3) {
  for (int r = 0; r < 16; ++r) p1[r] = __builtin_amdgcn_exp2f(p1[r]);
  float ps = 0; for (int r = 0; r < 16; ++r) ps += p0[r]; for (int r = 0; r < 16; ++r) ps += p1[r];
  { auto rr = __builtin_amdgcn_permlane32_swap(__float_as_uint(ps), __float_as_uint(ps), false, false);
    ps = __uint_as_float(rr[0]) + __uint_as_float(rr[1]); }
  l_reg = l_reg * alpha + ps;
#define PK4(P, BASE, OUT) do { unsigned a0 = cvtpk_a(P[BASE + 0], P[BASE + 1]), a1 = cvtpk_a(P[BASE + 2], P[BASE + 3]);   \
    unsigned b0 = cvtpk_a(P[BASE + 4], P[BASE + 5]), b1 = cvtpk_a(P[BASE + 6], P[BASE + 7]);                              \
    auto r0 = __builtin_amdgcn_permlane32_swap(a0, b0, false, false); auto r1 = __builtin_amdgcn_permlane32_swap(a1, b1, false, false); \
    u32x4 w = {r0[0], r1[0], r0[1], r1[1]}; OUT = *reinterpret_cast<bf16x8*>(&w); } while (0)
  PK4(p0, 0, pa0); PK4(p0, 8, pa1); PK4(p1, 0, pa2); PK4(p1, 8, pa3);
#undef PK4
}
__device__ __forceinline__ void qkt(f32x16& p0, f32x16& p1, const bf16_t* Ks, const bf16x8* qr, int r32, int hi) {
  p0 = f32x16{}; p1 = f32x16{};
  for (int d0 = 0; d0 < 8; ++d0) { int cb = (d0 * 16 + hi * 8) * 2;
    bf16x8 b0 = *reinterpret_cast<const bf16x8*>((const char*)Ks + KSWZ(r32, cb));
    bf16x8 b1 = *reinterpret_cast<const bf16x8*>((const char*)Ks + KSWZ(32 + r32, cb));
    p0 = __builtin_amdgcn_mfma_f32_32x32x16_bf16(b0, qr[d0], p0, 0, 0, 0);
    p1 = __builtin_amdgcn_mfma_f32_32x32x16_bf16(b1, qr[d0], p1, 0, 0, 0); }
}
__device__ __forceinline__ int v_st(int k, int c) { const int kk = (k & ~0xC) | ((k & 4) << 1) | ((k & 8) >> 1); return ((kk >> 3) * 4 + (c >> 5)) * 512 + ((kk & 7) * 32 + (c & 31)) * 2; }
__device__ __forceinline__ int v_rd_base(int lane) { return ((lane & 3) << 3) | (((lane >> 2) & 3) << 6) | (((lane >> 4) & 1) << 5) | (((lane >> 5) & 1) << 8); }
constexpr int v_rd_off(int d0, int ks, int half) { return d0 * 512 + ks * 4096 + half * 2048; }
template <int OFF> __device__ __forceinline__ s16x4 tr_read(int vb) {
  s16x4 r; asm volatile("ds_read_b64_tr_b16 %0, %1 offset:%2" : "=&v"(r) : "v"(vb), "i"(OFF) : "memory"); return r;
}
template <int D0> __device__ __forceinline__ void pv_one(f32x16& od, int vb, bf16x8 pa0, bf16x8 pa1, bf16x8 pa2, bf16x8 pa3) {
  const s16x4 l0 = tr_read<v_rd_off(D0, 0, 0)>(vb), h0 = tr_read<v_rd_off(D0, 0, 1)>(vb), l1 = tr_read<v_rd_off(D0, 1, 0)>(vb), h1 = tr_read<v_rd_off(D0, 1, 1)>(vb);
  const s16x4 l2 = tr_read<v_rd_off(D0, 2, 0)>(vb), h2 = tr_read<v_rd_off(D0, 2, 1)>(vb), l3 = tr_read<v_rd_off(D0, 3, 0)>(vb), h3 = tr_read<v_rd_off(D0, 3, 1)>(vb);
  asm volatile("s_waitcnt lgkmcnt(0)" ::: "memory"); SBAR();
#define PK(L, H) (bf16x8){L[0], L[1], L[2], L[3], H[0], H[1], H[2], H[3]}
  od = __builtin_amdgcn_mfma_f32_32x32x16_bf16(pa0, PK(l0, h0), od, 0, 0, 0);
  od = __builtin_amdgcn_mfma_f32_32x32x16_bf16(pa1, PK(l1, h1), od, 0, 0, 0);
  od = __builtin_amdgcn_mfma_f32_32x32x16_bf16(pa2, PK(l2, h2), od, 0, 0, 0);
  od = __builtin_amdgcn_mfma_f32_32x32x16_bf16(pa3, PK(l3, h3), od, 0, 0, 0);
#undef PK
}
__device__ __forceinline__ void pv_d0(f32x16* o, int vb, bf16x8 pa0, bf16x8 pa1, bf16x8 pa2, bf16x8 pa3) {
  pv_one<0>(o[0], vb, pa0, pa1, pa2, pa3); pv_one<1>(o[1], vb, pa0, pa1, pa2, pa3); pv_one<2>(o[2], vb, pa0, pa1, pa2, pa3); pv_one<3>(o[3], vb, pa0, pa1, pa2, pa3);
}
__device__ __forceinline__ void attn_dense_body(const bf16_t* __restrict__ Qb, const bf16_t* __restrict__ Kh, const bf16_t* __restrict__ Vh,
                                                bf16_t* __restrict__ Ob, int seq, char* lds) {
  const int tid = threadIdx.x, wid = tid >> 6, lane = tid & 63, r32 = lane & 31, hi = lane >> 5;
  bf16_t* V_lds = (bf16_t*)lds; bf16_t* K_lds = (bf16_t*)(lds + 2 * SHM_V);
  float* ws = (float*)(lds + 2 * SHM_V + 2 * SHM_K) + wid * 64; float* li_l = ws; float* al_l = ws + 32;
  float m_reg = -1e30f, l_reg = 0; f32x16 o[4] = {}; bf16x8 qr[8];
  const bf16_t* Qw = Qb + (long)(wid * QBLK + r32) * LDQ + hi * 8;
#pragma unroll
  for (int d0 = 0; d0 < 8; ++d0) qr[d0] = *reinterpret_cast<const bf16x8*>(Qw + d0 * 16);
  const int sr = tid >> 4, sc = (tid & 15) * 8, vst0 = v_st(sr, sc), vst1 = v_st(32 + sr, sc);
  const int vb0 = (int)(uintptr_t)V_lds + v_rd_base(lane);
  struct { bf16x8 vs0, vs1, ks0, ks1; } sr_[2];
#define LD8(p) (*reinterpret_cast<const bf16x8*>(p))
#define SLOAD(i, k0) do { sr_[i].vs0 = LD8(&Vh[(long)((k0) + sr) * LDK + sc]); sr_[i].vs1 = LD8(&Vh[(long)((k0) + 32 + sr) * LDK + sc]); \
    sr_[i].ks0 = LD8(&Kh[(long)((k0) + sr) * LDK + sc]); sr_[i].ks1 = LD8(&Kh[(long)((k0) + 32 + sr) * LDK + sc]); } while (0)
#define SWRITE(b, i) do { *(bf16x8*)((char*)V_lds + (b) * SHM_V + vst0) = sr_[i].vs0;          \
    *(bf16x8*)((char*)V_lds + (b) * SHM_V + vst1) = sr_[i].vs1; int kc = sc * 2;               \
    *(bf16x8*)((char*)K_lds + (b) * SHM_K + KSWZ(sr, kc)) = sr_[i].ks0;                       \
    *(bf16x8*)((char*)K_lds + (b) * SHM_K + KSWZ(32 + sr, kc)) = sr_[i].ks1; } while (0)
#define SWAIT() asm volatile("s_waitcnt vmcnt(4)" ::: "memory")
#define RESC(a) do { if (__any((a) < 1.f)) { if (hi == 0) al_l[r32] = (a); asm volatile("s_waitcnt lgkmcnt(0)" ::: "memory"); \
    for (int d = 0; d < 4; ++d) for (int r = 0; r < 16; ++r) o[d][r] *= al_l[crow(r, hi)]; } } while (0)
  f32x16 pA0, pA1, pB0, pB1; float mnA, mnB, alA, alB; bf16x8 pa0, pa1, pa2, pa3; const int NT = seq / KVBLK;
  constexpr int SE = 0, SO = 1;
  SLOAD(SE, 0); asm volatile("s_waitcnt vmcnt(0)" ::: "memory"); SWRITE(0, SE); __syncthreads();
  qkt(pA0, pA1, K_lds, qr, r32, hi); partialSM(pA0, pA1, m_reg, mnA, alA);
  SLOAD(SO, KVBLK); if (2 < NT) SLOAD(SE, 2 * KVBLK);
  SWAIT(); SWRITE(1, SO); __syncthreads();
  for (int j = 1; j + 1 < NT; j += 2) {
    SBAR(); qkt(pB0, pB1, (bf16_t*)((char*)K_lds + SHM_K), qr, r32, hi);
    finishSM(pA0, pA1, alA, l_reg, pa0, pa1, pa2, pa3); SBAR();
    SLOAD(SO, (j + 2) * KVBLK); SBAR();
    pv_d0(o, vb0, pa0, pa1, pa2, pa3); partialSM(pB0, pB1, m_reg, mnB, alB);
    __syncthreads(); SWAIT(); SWRITE(0, SE);
    RESC(alB); __syncthreads();
    SBAR(); qkt(pA0, pA1, K_lds, qr, r32, hi);
    finishSM(pB0, pB1, alB, l_reg, pa0, pa1, pa2, pa3); SBAR();
    if (j + 3 < NT) SLOAD(SE, (j + 3) * KVBLK); SBAR();
    pv_d0(o, vb0 + (int)SHM_V, pa0, pa1, pa2, pa3); partialSM(pA0, pA1, m_reg, mnA, alA);
    __syncthreads(); SWAIT(); SWRITE(1, SO);
    RESC(alA); __syncthreads();
  }
  SBAR(); qkt(pB0, pB1, (bf16_t*)((char*)K_lds + SHM_K), qr, r32, hi);
  finishSM(pA0, pA1, alA, l_reg, pa0, pa1, pa2, pa3); SBAR();
  pv_d0(o, vb0, pa0, pa1, pa2, pa3); partialSM(pB0, pB1, m_reg, mnB, alB);
  __syncthreads(); RESC(alB);
  finishSM(pB0, pB1, alB, l_reg, pa0, pa1, pa2, pa3); SBAR();
  pv_d0(o, vb0 + (int)SHM_V, pa0, pa1, pa2, pa3);
  if (hi == 0) li_l[r32] = l_reg; asm volatile("s_waitcnt lgkmcnt(0)" ::: "memory");
  float rli[16];
#pragma unroll
  for (int r = 0; r < 16; ++r) rli[r] = __builtin_amdgcn_rcpf(li_l[crow(r, hi)]);
  bf16_t* Ow = Ob + (long)(wid * QBLK) * LDO;
#pragma unroll
  for (int r = 0; r < 16; ++r) { int orow = crow(r, hi);
    for (int d0 = 0; d0 < 4; ++d0) { const float v = o[d0][r] * rli[r]; Ow[(long)orow * LDO + d0 * 32 + r32] = (bf16_t)(cvtpk(v, v) & 0xffffu); } }
  __syncthreads();
#undef LD8
#undef SLOAD
#undef SWRITE
#undef SWAIT
#undef RESC
}
#undef SBAR
}

constexpr int N_PHASES = 13;
__global__ void __launch_bounds__(NWAVES * 64, 2) fwd_kernel(Args args) {
    extern __shared__ __attribute__((aligned(16))) unsigned char lds_raw[];
    LAS unsigned char* lds = (LAS unsigned char*)lds_raw;
    volatile LAS unsigned* MISC = (volatile LAS unsigned*)(lds + MISC_OFF);
    const int tid = threadIdx.x, lane = tid & 63, wave = __builtin_amdgcn_readfirstlane(tid >> 6);
    const int G = gridDim.x, bx = blockIdx.x;
    const int gw = bx * NWAVES + wave, NGW = G * NWAVES;
    gu32* ctl = (gu32*)(args.ws + WS_CTL);
    for (int u = tid; u < (LDS_BYTES - LDSCTL_OFF) / 4; u += NWAVES * 64) ((LAS unsigned*)(lds + LDSCTL_OFF))[u] = 0u;
    __syncthreads();
    XcdBarrier bar; bar.bar = (unsigned*)(ctl + CW_BAR); bar.x = 0; bar.st = nullptr;
    if (!MK_PER_PHASE) bar = xcd_barrier_post((unsigned*)(ctl + CW_BAR), MISC + 8);
    const int lo = args.ph_lo, hi = args.ph_hi;
#define IN(k) (lo <= (k) && (k) < hi)
#define SEAM(k) do { if (IN(k) && IN((k) + 1)) xcd_barrier(bar); } while (0)
#define W_IN ((bf16_t*)(args.ws + WS_WIN))
#define W_OUT ((bf16_t*)(args.ws + WS_WOUT))
#define W_POOL ((bf16_t*)(args.ws + WS_WPOOL))
#define W_M1 ((bf16_t*)(args.ws + WS_WM1))
#define W_M2 ((bf16_t*)(args.ws + WS_WM2))
#define Hb ((bf16_t*)(args.ws + WS_H))
#define ZB ((bf16_t*)(args.ws + WS_ZB))
#define LFb ((float*)(args.ws + WS_LF))
#define A2 ((bf16_t*)(args.ws + WS_A2))
#define XA ((float*)(args.ws + WS_XA))
#define Ub ((bf16_t*)(args.ws + WS_U))
#define MOD ((const float*)(args.ws + WS_MOD))
#define ROWSS ((float*)(args.ws + WS_ROWSS))
#define SW ((float*)(args.ws + WS_SW))
#define IDLE_FIRST(nwg) (((nwg) % G) ? ((nwg) % G) : 0)

    if (IN(0)) {
        const int hG = G / 2;
        if (bx < hG) { for (int wi = bx; wi < 128; wi += hG) p0_ada_item(args, lds, wi, tid); }
        else bg_transposes(args, lds, R_IN, R_OUT, (bx - hG) * NWAVES + wave, (G - hG) * NWAVES, wave, lane);
    }
    SEAM(0);
    if (IN(1)) norm_rows_bf16(args, nullptr, args.in[10], 0, 0, Hb, gw, NGW, lane);
    SEAM(1);
    if (IN(2)) { pg8::Gemm g{Hb, W_IN, NTOK, IN_AB, 2048, 2048, 2048, 0, 0}; pg8::StaticOrder S; S.init(NTOK, IN_AB, G, bx);
        EpiIn E{ZB, LFb, args.in[17]}; pg8::gemm_phase<EpiIn>(lds, g, S, E);
        const int f = IDLE_FIRST(624); if (bx >= f) bg_transposes(args, lds, R_OUT, R_M2_0, (bx - f) * NWAVES + wave, (G - f) * NWAVES, wave, lane); }
    SEAM(2);
    if (IN(3)) {
        for (int row = gw; row < NTOK; row += NGW) post_token(args, row, lane);
        for (int it = gw; it < 1024; it += NGW) cache_item(args, it, lane);
        __syncthreads();
        for (int task = bx; task < 144; task += G) hgrn_task(args, lds, task, tid);
        if (G > 144) { if (bx >= 144) bg_transposes(args, lds, R_M2_0, R_POOL, (bx - 144) * NWAVES + wave, (G - 144) * NWAVES, wave, lane); }
        else bg_transposes(args, lds, R_M2_0, R_POOL, gw, NGW, wave, lane);
    }
    SEAM(3);
    if (IN(4)) {
        for (int u = bx; u < 192; u += G) {
            const bf16_t *Q, *K, *V; bf16_t* O; int seq;
            if (u < 64) { const int b = u >> 5, h = (u >> 2) & 7, qb = u & 3; const size_t row0 = NTOK_P + b * SEQ_S + qb * 256;
                Q = (const bf16_t*)(args.ws + WS_QN) + row0 * 1024 + h * 128; O = A2 + row0 * DM + h * 128;
                K = (const bf16_t*)(args.ws + WS_KS) + (size_t)(b * 2 + (h >> 2)) * 1280 * 128; V = (const bf16_t*)(args.ws + WS_VS) + (size_t)(b * 2 + (h >> 2)) * 1280 * 128; seq = 1280; }
            else { const int v = u - 64, b = v >> 3, h = v & 7; const size_t row0 = b * 256;
                Q = (const bf16_t*)(args.ws + WS_QN) + row0 * 1024 + h * 128; O = A2 + row0 * DM + h * 128;
                K = (const bf16_t*)(args.ws + WS_KP) + (size_t)(b * 2 + (h >> 2)) * 256 * 128; V = (const bf16_t*)(args.ws + WS_VP) + (size_t)(b * 2 + (h >> 2)) * 256 * 128; seq = 256; }
            att::attn_dense_body(Q, K, V, O, seq, (char*)lds_raw);
        }
        {
            const int nfree = G > 192 ? G - 192 : G, fb = G > 192 ? bx - 192 : bx;
            if (fb >= 0) for (int row = fb * NWAVES + wave; row < NTOK; row += nfree * NWAVES) combine_token(args, row, lane);
        }
    }
    SEAM(4);
    if (IN(5)) { pg8::Gemm g{A2, W_OUT, NTOK, DM, 2048, 2048, 2048, 0, 0}; pg8::StaticOrder S; S.init(NTOK, DM, G, bx);
        EpiRes E{args.in[0], args.in[1], XA, MOD + 2 * 2048, nullptr, Hb, args.in[11], MOD + 4 * 2048, ROWSS}; pg8::gemm_phase<EpiRes>(lds, g, S, E);
        const int f = IDLE_FIRST(192); if (bx >= f) for (int wi = 128 + (bx - f); wi < 256; wi += G - f) p0_ada_item(args, lds, wi, tid); }
    SEAM(5);
    if (IN(6)) { pg8::Gemm g{Hb, W_M1, NTOK, DFF, 2048, 2048, 2048, 0, 0}; pg8::StaticOrder S; S.init(NTOK, DFF, G, bx);
        EpiRelu2 E{Ub, ROWSS, SW}; pg8::gemm_phase<EpiRelu2>(lds, g, S, E); }
    SEAM(6);
    if (IN(7)) { pg8::Gemm g{Ub, W_M2, NTOK, DM, DFF, DFF, DFF, 0, 0}; pg8::StaticOrder S; S.init(NTOK, DM, G, bx);
        EpiRes E{XA, XA + (size_t)NTOK_P * DM, XA, MOD + 5 * 2048, nullptr, nullptr, nullptr, nullptr, ROWSS + NTOK}; pg8::gemm_phase<EpiRes>(lds, g, S, E);
        const int f = IDLE_FIRST(192); if (bx >= f) bg_transposes(args, lds, R_POOL, R_END, (bx - f) * NWAVES + wave, (G - f) * NWAVES, wave, lane); }
    SEAM(7);
    if (IN(8)) pool_phase(args, lds, XA, ROWSS + NTOK, Hb, bx, G, tid);
    SEAM(8);
    if (IN(9)) { pg8::Gemm g{Hb, W_POOL, NTOK, DM, 512, 2048, 512, 1, 512}; pg8::StaticOrder S; S.init(NTOK, DM, G, bx);
        EpiRes E{XA, XA + (size_t)NTOK_P * DM, XA, MOD + NMODC + 2 * 2048, args.in[19], A2, args.in[11] + 2048, MOD + NMODC + 4 * 2048, ROWSS + 2 * NTOK}; pg8::gemm_phase<EpiRes>(lds, g, S, E); }
    SEAM(9);
    if (IN(10)) { pg8::Gemm g{A2, W_M1 + (size_t)DFF * 2048, NTOK, DFF, 2048, 2048, 2048, 0, 0}; pg8::StaticOrder S; S.init(NTOK, DFF, G, bx);
        EpiRelu2 E{Ub, ROWSS + 2 * NTOK, SW + 3 * DFF}; pg8::gemm_phase<EpiRelu2>(lds, g, S, E); }
    SEAM(10);
    if (IN(11)) { pg8::Gemm g{Ub, W_M2 + (size_t)2048 * DFF, NTOK, DM, DFF, DFF, DFF, 0, 0}; pg8::StaticOrder S; S.init(NTOK, DM, G, bx);
        EpiRes E{XA, XA + (size_t)NTOK_P * DM, XA, MOD + NMODC + 5 * 2048, nullptr, nullptr, nullptr, nullptr, ROWSS + 3 * NTOK}; pg8::gemm_phase<EpiRes>(lds, g, S, E); }
    SEAM(11);
    if (IN(12)) final_rows(XA, ROWSS + 3 * NTOK, args.in[22], args.out, gw, NGW, lane);
#undef IN
#undef SEAM
#undef IDLE_FIRST
#undef W_IN
#undef W_OUT
#undef W_POOL
#undef W_M1
#undef W_M2
#undef Hb
#undef ZB
#undef LFb
#undef A2
#undef XA
#undef Ub
#undef MOD
#undef ROWSS
#undef SW
}

extern "C" void kernel_launch(void* const* d_in, const int* in_sizes, int n_in, void* d_out, int out_size, void* d_ws, size_t ws_size, hipStream_t stream) {
    static int grid = 0;
    if (grid == 0) {
        if (n_in != 23 || out_size != 18874368 || ws_size < WS_END) { fprintf(stderr, "kernel_launch: unexpected shapes (n_in %d out %d ws %zu)\n", n_in, out_size, ws_size); grid = -1; return; }
        int dev = 0, cus = 0;
        if (hipGetDevice(&dev) != hipSuccess || hipDeviceGetAttribute(&cus, hipDeviceAttributeMultiprocessorCount, dev) != hipSuccess) { grid = -1; return; }
        if (hipFuncSetAttribute((const void*)fwd_kernel, hipFuncAttributeMaxDynamicSharedMemorySize, LDS_BYTES) != hipSuccess) { fprintf(stderr, "kernel_launch: hipFuncSetAttribute failed\n"); grid = -1; return; }
        int per_cu = 0;
        if (hipOccupancyMaxActiveBlocksPerMultiprocessor(&per_cu, (const void*)fwd_kernel, NWAVES * 64, LDS_BYTES) != hipSuccess || per_cu < 1) fprintf(stderr, "kernel_launch: occupancy query says %d\n", per_cu);
        (void)hipGetLastError();
        grid = cus;
    }
    if (grid < 0) return;
    (void)hipMemsetAsync((char*)d_ws + WS_CTL, 0, CTL_ZERO_BYTES, stream);
    Args a{};
    for (int i = 0; i < 23; ++i) a.in[i] = (const float*)d_in[i];
    a.out = (float*)d_out; a.ws = (unsigned char*)d_ws;
#if MK_PER_PHASE
    for (int p = 0; p < N_PHASES; ++p) { a.ph_lo = p; a.ph_hi = p + 1; hipLaunchKernelGGL(fwd_kernel, dim3(grid), dim3(NWAVES * 64), LDS_BYTES, stream, a);
        if (p == REP_PHASE) hipLaunchKernelGGL(fwd_kernel, dim3(grid), dim3(NWAVES * 64), LDS_BYTES, stream, a); }
#else
    a.ph_lo = 0; a.ph_hi = N_PHASES;
    hipLaunchKernelGGL(fwd_kernel, dim3(grid), dim3(NWAVES * 64), LDS_BYTES, stream, a);
#endif
}
```

```cpp
#include <hip/hip_runtime.h>
#include <hip/hip_bf16.h>
#include <cstdio>
#include <cstdint>

#ifndef MK_PER_PHASE
#define MK_PER_PHASE 0
#endif

#ifndef REP_PHASE
#define REP_PHASE -1
#endif
constexpr int DM = 2048, NTOK_P = 4096, NTOK_S = 2048, NTOK = 6144, SEQ_P = 256, SEQ_S = 1024, NB_P = 16, NB_S = 2, PAST = 256;
constexpr int IN_AB = 6656, DFF = 8192, NMODC = 12288;
constexpr int C_Q = 0, C_K = 1024, C_V = 1280, C_HQ = 1536, C_ZF = 2560, C_ZB = 3584, C_HI = 4608, C_HG = 5632;
constexpr float EPS = 1e-6f;

#define GAS __attribute__((address_space(1)))
#define LAS __attribute__((address_space(3)))
typedef unsigned short bf16_t;
typedef short bf16x8 __attribute__((ext_vector_type(8)));
typedef short s16x4 __attribute__((ext_vector_type(4)));
typedef float f32x4 __attribute__((ext_vector_type(4)));
typedef float f32x2 __attribute__((ext_vector_type(2)));
typedef float f32x16 __attribute__((ext_vector_type(16)));
typedef unsigned u32x4 __attribute__((ext_vector_type(4)));
typedef unsigned u32x2 __attribute__((ext_vector_type(2)));
typedef __bf16 bf16x2_t __attribute__((ext_vector_type(2)));
typedef GAS unsigned gu32;

__device__ __forceinline__ unsigned cvtpk(float lo, float hi) { f32x2 v = {lo, hi}; bf16x2_t b = __builtin_convertvector(v, bf16x2_t); return __builtin_bit_cast(unsigned, b); }
__device__ __forceinline__ float bf2f(unsigned short u) { return __uint_as_float(((unsigned)u) << 16); }
__device__ __forceinline__ float bflo(unsigned u) { return __uint_as_float(u << 16); }
__device__ __forceinline__ float bfhi(unsigned u) { return __uint_as_float(u & 0xffff0000u); }
__device__ __forceinline__ float siluf(float x) { return x / (1.f + __expf(-x)); }
__device__ __forceinline__ int lane_id() { int l; asm volatile("v_mbcnt_lo_u32_b32 %0, -1, 0\n\tv_mbcnt_hi_u32_b32 %0, -1, %0" : "=v"(l)); return l; }
__device__ __forceinline__ float wave_sum(float v) {
#pragma unroll
    for (int o = 1; o < 64; o <<= 1) v += __shfl_xor(v, o);
    return v;
}
__device__ __forceinline__ float half_sum(float v) {
#pragma unroll
    for (int o = 1; o < 32; o <<= 1) v += __shfl_xor(v, o);
    return v;
}

namespace pg8 {
#define PG8_LAS __attribute__((address_space(3)))
constexpr int BM = 256, BK = 64, HALF = 128, HTB = HALF * BK * 2, STAGE_BYTES = 8 * HTB, NXCD = 8, WGM = 8;
__host__ __device__ __forceinline__ int lds_byte(int r, int c) { const int st = (r >> 4) * 2 + (c >> 5), rr = r & 15, cc = c & 31, ob = rr * 64 + cc * 2; return st * 1024 + (ob ^ (((ob >> 9) & 1) << 5)); }
__host__ __device__ __forceinline__ void stage_rc(int b, int& R, int& C) { const int st = b / 1024, sb = b % 1024, swz = sb ^ (((sb >> 9) & 1) << 5); R = (st >> 1) * 16 + swz / 64; C = (st & 1) * 32 + (swz % 64) / 2; }
__host__ __device__ __forceinline__ int perm32(int rho) { const int n = rho >> 4, i = rho & 15; return 8 * (i >> 2) + 4 * n + (i & 3); }

struct Unit { int pm, pn; };
struct Gemm { const bf16_t* A; const bf16_t* Bt; int M, N, K, lda, ldb, apn_shift, apn_mul; };

struct StaticOrder {
    int nM, nN, nwg, G, c;
    __host__ __device__ void init(int M, int N, int G_, int c_) { nM = M / BM; nN = N / BM; nwg = nM * nN; G = G_; c = c_; }
    __host__ __device__ bool next(int i, Unit& u) const {
        const long L = (long)i * G + c; if (L >= nwg) return false;
        int wgid = (int)L; { const int q = nwg / NXCD, r = nwg % NXCD, xcd = wgid % NXCD, off = wgid / NXCD; wgid = (xcd < r ? xcd * (q + 1) : r * (q + 1) + (xcd - r) * q) + off; }
        const int nig = WGM * nN, gid = wgid / nig, fm = gid * WGM, gsz = (nM - fm) < WGM ? (nM - fm) : WGM;
        u.pm = fm + ((wgid % nig) % gsz); u.pn = (wgid % nig) / gsz; return true;
    }
};

template <class Epi, bool ALIGN_EPI = true>
__device__ __forceinline__ void gemm_phase(PG8_LAS unsigned char* lds, const Gemm g, const StaticOrder& S, const Epi& E) {
    const int tid = threadIdx.x, wid = __builtin_amdgcn_readfirstlane(tid >> 6), lane = tid & 63, wr = wid >> 2, wc = wid & 3, fr = lane & 15, fq = lane >> 4;
    const int K = g.K, nt = K / BK;
    unsigned voffA[2], voffB[2];
#pragma unroll
    for (int i = 0; i < 2; ++i) { int R, C; stage_rc(tid * 16 + i * 8192, R, C); const int Rb = Epi::PERM ? ((R & ~31) + perm32(R & 31)) : R;
        voffA[i] = (unsigned)(R * g.lda + C) * 2u; voffB[i] = (unsigned)(Rb * g.ldb + C) * 2u; }
    const size_t kstep = (size_t)(BK * 2);
    const size_t hstepA = (size_t)HALF * g.lda * 2, hstepB = (size_t)HALF * g.ldb * 2;
    const size_t tstepA = 2 * hstepA, tstepB = 2 * hstepB;
    const unsigned ldsw = (unsigned)wid * 1024u;
    const int aoff = lds_byte(wr * 64 + fr, fq * 8), boff = lds_byte(wc * 32 + fr, fq * 8);
#define PG8_SA(b, h) (((b) * 2 + (h)) * HTB)
#define PG8_SB(b, h) ((4 + (b) * 2 + (h)) * HTB)
#define PG8_STAGE(bufoff, gbase, voff) do { _Pragma("unroll") for (int _i = 0; _i < 2; ++_i) \
        __builtin_amdgcn_global_load_lds((const unsigned*)((const char*)(gbase) + (voff)[_i]), (PG8_LAS unsigned*)(lds + (bufoff) + ldsw + _i * 8192), 16, 0, 0); } while (0)
#define PG8_LDA(dst, b, h) do { _Pragma("unroll") for (int m = 0; m < 4; ++m) _Pragma("unroll") for (int k = 0; k < 2; ++k) dst[m][k] = *(const PG8_LAS bf16x8*)(lds + PG8_SA(b, h) + aoff + m * 2048 + k * 1024); } while (0)
#define PG8_LDB(dst, b, h) do { _Pragma("unroll") for (int n = 0; n < 2; ++n) _Pragma("unroll") for (int k = 0; k < 2; ++k) dst[n][k] = *(const PG8_LAS bf16x8*)(lds + PG8_SB(b, h) + boff + n * 2048 + k * 1024); } while (0)
#define PG8_MMA(ai, bj, At, Bt) do { __builtin_amdgcn_s_setprio(1); _Pragma("unroll") for (int m = 0; m < 4; ++m) _Pragma("unroll") for (int n = 0; n < 2; ++n) _Pragma("unroll") for (int k = 0; k < 2; ++k) \
        acc[ai][bj][m][n] = __builtin_amdgcn_mfma_f32_16x16x32_bf16(Bt[n][k], At[m][k], acc[ai][bj][m][n], 0, 0, 0); __builtin_amdgcn_s_setprio(0); } while (0)
#define PG8_WAIT_V(n) asm volatile("s_waitcnt vmcnt(" #n ")" ::: "memory")
#define PG8_WAIT_L(n) asm volatile("s_waitcnt lgkmcnt(" #n ")" ::: "memory")
#define PG8_BAR __builtin_amdgcn_s_barrier()
#define PG8_SCHED __builtin_amdgcn_sched_barrier(0)
#define PG8_AOFF(u) ((size_t)(((u).pn >> g.apn_shift) * g.apn_mul) * 2)
    Unit cur, nxt; int ui = 0;
    if (!S.next(0, cur)) return;
    f32x4 acc[2][2][4][2];
#pragma unroll
    for (int a = 0; a < 2; ++a)
#pragma unroll
        for (int b = 0; b < 2; ++b)
#pragma unroll
            for (int m = 0; m < 4; ++m)
#pragma unroll
                for (int n = 0; n < 2; ++n) acc[a][b][m][n] = (f32x4){0.f, 0.f, 0.f, 0.f};
    bf16x8 At[4][2], B0[2][2], B1[2][2];
    const char* cA = (const char*)g.A + (size_t)cur.pm * tstepA + PG8_AOFF(cur); const char* cB = (const char*)g.Bt + (size_t)cur.pn * tstepB;
    {
        PG8_STAGE(PG8_SB(0, 0), cB, voffB); PG8_STAGE(PG8_SB(0, 1), cB + hstepB, voffB); PG8_STAGE(PG8_SA(0, 0), cA, voffA); PG8_STAGE(PG8_SA(0, 1), cA + hstepA, voffA);
        if (wr == 1) PG8_BAR;
        PG8_WAIT_V(2); PG8_BAR;
        PG8_STAGE(PG8_SB(1, 0), cB + kstep, voffB); PG8_STAGE(PG8_SA(1, 0), cA + kstep, voffA); PG8_STAGE(PG8_SB(1, 1), cB + hstepB + kstep, voffB);
        PG8_WAIT_V(6); PG8_BAR;
    }
    for (;;) {
        const bool has_next = S.next(ui + 1, nxt);
        const char* nA = has_next ? (const char*)g.A + (size_t)nxt.pm * tstepA + PG8_AOFF(nxt) : cA; const char* nB = has_next ? (const char*)g.Bt + (size_t)nxt.pn * tstepB : cB;
        for (int t = 0; t < nt; t += 2) {
            const bool last = (t == nt - 2);
            const char* a1 = cA + (size_t)(t + 1) * kstep;
            const char* a2 = last ? nA : cA + (size_t)(t + 2) * kstep; const char* b2 = last ? nB : cB + (size_t)(t + 2) * kstep;
            const char* a3 = a2 + kstep; const char* b3 = b2 + kstep;
            PG8_LDB(B0, 0, 0); PG8_LDB(B1, 0, 1); PG8_SCHED; PG8_LDA(At, 0, 0); PG8_STAGE(PG8_SA(1, 1), a1 + hstepA, voffA);
            PG8_WAIT_V(8); PG8_WAIT_L(0); PG8_BAR; PG8_MMA(0, 0, At, B0); PG8_MMA(0, 1, At, B1); PG8_BAR; PG8_SCHED;
            PG8_LDA(At, 0, 1); PG8_STAGE(PG8_SB(0, 0), b2, voffB); PG8_STAGE(PG8_SB(0, 1), b2 + hstepB, voffB); PG8_STAGE(PG8_SA(0, 0), a2, voffA);
            PG8_WAIT_V(8); PG8_WAIT_L(0); PG8_BAR; PG8_MMA(1, 0, At, B0); PG8_MMA(1, 1, At, B1); PG8_BAR; PG8_SCHED;
            PG8_LDB(B0, 1, 0); PG8_LDB(B1, 1, 1); PG8_SCHED; PG8_LDA(At, 1, 0); PG8_STAGE(PG8_SA(0, 1), a2 + hstepA, voffA);
            PG8_WAIT_V(8); PG8_WAIT_L(0); PG8_BAR; PG8_MMA(0, 0, At, B0); PG8_MMA(0, 1, At, B1); PG8_BAR; PG8_SCHED;
            PG8_LDA(At, 1, 1); PG8_STAGE(PG8_SB(1, 0), b3, voffB); PG8_STAGE(PG8_SB(1, 1), b3 + hstepB, voffB); PG8_STAGE(PG8_SA(1, 0), a3, voffA);
            PG8_WAIT_V(8); PG8_WAIT_L(0); PG8_BAR; PG8_MMA(1, 0, At, B0); PG8_MMA(1, 1, At, B1); PG8_BAR; PG8_SCHED;
        }
        if constexpr (ALIGN_EPI) { if (wr == 0) PG8_BAR; }
        E(acc, cur, wr, wc, fr, fq);
        if (!has_next) break;
#pragma unroll
        for (int a = 0; a < 2; ++a)
#pragma unroll
            for (int b = 0; b < 2; ++b)
#pragma unroll
                for (int m = 0; m < 4; ++m)
#pragma unroll
                    for (int n = 0; n < 2; ++n) acc[a][b][m][n] = (f32x4){0.f, 0.f, 0.f, 0.f};
        cur = nxt; cA = nA; cB = nB; ++ui;
        if constexpr (ALIGN_EPI) { if (wr == 1) PG8_BAR; }
    }
    PG8_WAIT_V(0);
    if constexpr (!ALIGN_EPI) { if (wr == 0) PG8_BAR; }
    PG8_BAR;
#undef PG8_SA
#undef PG8_SB
#undef PG8_STAGE
#undef PG8_LDA
#undef PG8_LDB
#undef PG8_MMA
#undef PG8_WAIT_V
#undef PG8_WAIT_L
#undef PG8_BAR
#undef PG8_SCHED
#undef PG8_AOFF
}
}

constexpr size_t MiB = 1u << 20;
constexpr size_t WS_CTL = 0, CTL_ZERO_BYTES = 384 * 1024;
constexpr size_t WS_ROWSS = 64 * 1024;
constexpr size_t WS_SW = 160 * 1024;
constexpr size_t WS_MOD = 1 * MiB;
constexpr size_t WS_WIN = 2 * MiB;
constexpr size_t WS_WOUT = 28 * MiB;
constexpr size_t WS_WPOOL = 36 * MiB;
constexpr size_t WS_WM1 = 38 * MiB;
constexpr size_t WS_WM2 = 102 * MiB;
constexpr size_t WS_H = 166 * MiB;
constexpr size_t WS_ZB = 190 * MiB;
constexpr size_t WS_LF = 268 * MiB;
constexpr size_t WS_QN = 316 * MiB;
constexpr size_t WS_KP = 328 * MiB;
constexpr size_t WS_VP = 330 * MiB;
constexpr size_t WS_KS = 332 * MiB;
constexpr size_t WS_VS = 334 * MiB;
constexpr size_t WS_OF = 336 * MiB;
constexpr size_t WS_OB = 360 * MiB;
constexpr size_t WS_A2 = 384 * MiB;
constexpr size_t WS_XA = 408 * MiB;
constexpr size_t WS_U = 456 * MiB;
constexpr size_t WS_SEND = 552 * MiB;
constexpr size_t WS_LSEG = 560 * MiB;
constexpr size_t WS_END = 561 * MiB;
constexpr int CW_BAR = 1024;

constexpr int RING_BYTES = 131072, LDSCTL_OFF = RING_BYTES, MISC_OFF = LDSCTL_OFF + 320, LDS_BYTES = 147456;
constexpr int NWAVES = 8;

#define RLX_AGENT __ATOMIC_RELAXED, __HIP_MEMORY_SCOPE_AGENT
#define LDS_WAIT() asm volatile("s_waitcnt lgkmcnt(0)" ::: "memory")
#define VM_WAIT() asm volatile("s_waitcnt vmcnt(0)" ::: "memory")

#define XB_TMO      128
#define XB_XCNT(j)  (256  + 64 * (j))
#define XB_XSUB(j)  (1280 + 64 * (j))
#define XB_XGEN(j)  (2304 + 64 * (j))
#define XB_TOP      3328
#define XB_TOPGEN   3392
#define XCD_BAR_WORDS 3456
#define XB_SPIN_CAP (1u << 18)
__device__ __forceinline__ unsigned xb_ld(unsigned* p)              { return __hip_atomic_load(p, __ATOMIC_RELAXED, __HIP_MEMORY_SCOPE_AGENT); }
__device__ __forceinline__ unsigned xb_add(unsigned* p, unsigned v) { return __hip_atomic_fetch_add(p, v, __ATOMIC_RELAXED, __HIP_MEMORY_SCOPE_AGENT); }
__device__ __forceinline__ unsigned xb_xcc_id() { return (unsigned)__builtin_amdgcn_s_getreg((3 << 11) | 20) & 0xFu; }
#define XB_SPIN(cond, bar) do { unsigned _sp = 0; while (cond) { __builtin_amdgcn_s_sleep(1); \
    if ((++_sp & 255u) == 0u) { if (xb_ld(&(bar)[XB_TMO])) break; if (_sp > XB_SPIN_CAP) { atomicAdd(&(bar)[XB_TMO], 1u); break; } } } } while (0)
struct XcdBarrier { unsigned* bar; unsigned x; volatile LAS unsigned* st; };
__device__ __forceinline__ XcdBarrier xcd_barrier_post(unsigned* bar, volatile LAS unsigned* st) {
    XcdBarrier b; b.bar = bar; b.x = xb_xcc_id(); b.st = st;
    if (threadIdx.x == 0) (void)xb_add(&bar[XB_XCNT(b.x)], 1u);
    return b;
}
__device__ __forceinline__ void xcd_barrier_complete(unsigned* bar, unsigned x, unsigned& nloc, unsigned& nx) {
    const unsigned G = gridDim.x * gridDim.y * gridDim.z;
    unsigned sum, cnt, mine, sp = 0u;
    for (;;) {
        sum = 0u; cnt = 0u; mine = 0u;
#pragma unroll
        for (unsigned j = 0; j < 16; ++j) { const unsigned c = xb_ld(&bar[XB_XCNT(j)]); sum += c; cnt += (c > 0u) ? 1u : 0u; mine = (j == x) ? c : mine; }
        if (sum == G) break;
        __builtin_amdgcn_s_sleep(1);
        if ((++sp & 255u) == 0u) { if (xb_ld(&bar[XB_TMO])) break; if (sp > XB_SPIN_CAP) { atomicAdd(&bar[XB_TMO], 1u); break; } }
    }
    nloc = mine > 0u ? mine : 1u; nx = cnt > 0u ? cnt : 1u;
}
__device__ __forceinline__ void xcd_barrier(const XcdBarrier& b) {
    asm volatile("s_waitcnt vmcnt(0)" ::: "memory");
    __syncthreads();
    if (threadIdx.x == 0) {
        unsigned* bar = b.bar;
        __builtin_amdgcn_s_waitcnt(0);
        unsigned nloc = b.st[0], nx = b.st[1];
        if (nloc == 0u) { xcd_barrier_complete(bar, b.x, nloc, nx); b.st[0] = nloc; b.st[1] = nx; }
        const unsigned old = xb_add(&bar[XB_XSUB(b.x)], 1u);
        const unsigned gen = old / nloc;
        if (old + 1u == (gen + 1u) * nloc) {
            __builtin_amdgcn_fence(__ATOMIC_RELEASE, "agent");
            asm volatile("s_waitcnt vmcnt(0)" ::: "memory");
            const unsigned og = xb_add(&bar[XB_TOP], 1u);
            const unsigned tg = og / nx;
            if (og + 1u == (tg + 1u) * nx) xb_add(&bar[XB_TOPGEN], 1u);
            else XB_SPIN(xb_ld(&bar[XB_TOPGEN]) == tg, bar);
            __builtin_amdgcn_fence(__ATOMIC_ACQUIRE, "agent");
            xb_add(&bar[XB_XGEN(b.x)], 1u);
            asm volatile("s_waitcnt vmcnt(0)" ::: "memory");
        } else {
            XB_SPIN(xb_ld(&bar[XB_XGEN(b.x)]) == gen, bar);
            __builtin_amdgcn_fence(__ATOMIC_ACQUIRE, "agent");
            asm volatile("s_waitcnt vmcnt(0)" ::: "memory");
        }
    }
    __syncthreads();
}

struct Args { const float* in[23]; float* out; unsigned char* ws; int ph_lo, ph_hi; };

__device__ __forceinline__ int cvec_of_row(int row) { return row < NTOK_P ? 0 : 1 + ((row - NTOK_P) >> 10); }
__device__ __forceinline__ const float* xin_row(const Args& a, int row) { return row < NTOK_P ? a.in[0] + (size_t)row * DM : a.in[1] + (size_t)(row - NTOK_P) * DM; }

struct EpiIn {
    static constexpr bool PERM = true;
    bf16_t* ZB; float* LF; const float* lb_raw;
    __device__ __forceinline__ void operator()(const f32x4 (&acc)[2][2][4][2], const pg8::Unit& u, int wr, int wc, int fr, int fq) const {
        const int row0 = u.pm * 256 + wr * 64 + fr, colt = u.pn * 256, cl = wc * 32 + 8 * fq;
        if (colt >= C_ZF && colt < C_HI) {
#pragma unroll
            for (int bj = 0; bj < 2; ++bj) {
                const int c2 = colt + bj * 128 + cl - C_ZF, dir = c2 >> 10, ch = c2 & 1023;
                float lb[8];
#pragma unroll
                for (int e = 0; e < 8; ++e) { const float x0 = lb_raw[dir * 3072 + ch + e], x1 = lb_raw[dir * 3072 + 1024 + ch + e], x2 = lb_raw[dir * 3072 + 2048 + ch + e];
                    lb[e] = 1.f / (1.f + __expf(x1 - x0) + __expf(x2 - x0)); }
#pragma unroll
                for (int ai = 0; ai < 2; ++ai)
#pragma unroll
                    for (int m = 0; m < 4; ++m) {
                        float* dst = LF + (size_t)(row0 + ai * 128 + m * 16) * 2048 + c2;
                        f32x4 o[2];
#pragma unroll
                        for (int n = 0; n < 2; ++n)
#pragma unroll
                            for (int e = 0; e < 4; ++e) { const float z = acc[ai][bj][m][n][e], sg = 1.f / (1.f + __expf(-z)), l = lb[n * 4 + e]; o[n][e] = __logf(l + (1.f - l) * sg); }
                        *(f32x4*)dst = o[0]; *(f32x4*)(dst + 4) = o[1];
                    }
            }
        } else {
            const bool act = (colt >= C_HQ && colt < C_ZF) || colt >= C_HG;
#pragma unroll
            for (int ai = 0; ai < 2; ++ai)
#pragma unroll
                for (int m = 0; m < 4; ++m) {
                    bf16_t* rowp = ZB + (size_t)(row0 + ai * 128 + m * 16) * IN_AB + colt + cl;
#pragma unroll
                    for (int bj = 0; bj < 2; ++bj) { f32x4 v0 = acc[ai][bj][m][0], v1 = acc[ai][bj][m][1];
                        if (act) {
#pragma unroll
                            for (int e = 0; e < 4; ++e) { v0[e] = siluf(v0[e]); v1[e] = siluf(v1[e]); } }
                        u32x4 w; w.x = cvtpk(v0[0], v0[1]); w.y = cvtpk(v0[2], v0[3]); w.z = cvtpk(v1[0], v1[1]); w.w = cvtpk(v1[2], v1[3]);
                        *(u32x4*)(rowp + bj * 128) = w; }
                }
        }
    }
};
struct EpiRes {
    static constexpr bool PERM = false;
    const float* baseP; const float* baseS; float* out; const float* gate; const float* pscale;
    bf16_t* XG; const float* ngain; const float* nsc;
    float* rowss;
    __device__ __forceinline__ void operator()(const f32x4 (&acc)[2][2][4][2], const pg8::Unit& u, int wr, int wc, int fr, int fq) const {
        const int col0 = u.pn * 256 + wc * 32 + 4 * fq;
        const int cv = u.pm < 16 ? 0 : 1 + ((u.pm - 16) >> 2);
        const float* gp = gate + (size_t)cv * 2 * NMODC;
        const float* bp = u.pm < 16 ? baseP + (size_t)u.pm * 256 * DM : baseS + (size_t)(u.pm - 16) * 256 * DM;
        float* op = out + (size_t)u.pm * 256 * DM;
        float ss[2][4];
#pragma unroll
        for (int ai = 0; ai < 2; ++ai)
#pragma unroll
            for (int m = 0; m < 4; ++m) ss[ai][m] = 0.f;
#pragma unroll
        for (int bj = 0; bj < 2; ++bj)
#pragma unroll
            for (int n = 0; n < 2; ++n) {
                const int col = col0 + bj * 128 + n * 16;
                f32x4 g4 = *(const f32x4*)(gp + col);
                if (pscale) g4 = g4 * *(const f32x4*)(pscale + col);
                f32x4 gm = {0.f, 0.f, 0.f, 0.f};
                if (XG) gm = *(const f32x4*)(ngain + col) * (*(const f32x4*)(nsc + (size_t)cv * 2 * NMODC + col) + 1.f);
#pragma unroll
                for (int ai = 0; ai < 2; ++ai)
#pragma unroll
                    for (int m = 0; m < 4; ++m) { const size_t off = (size_t)(ai * 128 + wr * 64 + m * 16 + fr) * DM + col;
                        const f32x4 b = *(const f32x4*)(bp + off); const f32x4 x = b + g4 * acc[ai][bj][m][n]; *(f32x4*)(op + off) = x;
                        ss[ai][m] += (x.x * x.x + x.y * x.y) + (x.z * x.z + x.w * x.w);
                        if (XG) { const f32x4 y = x * gm; u32x2 w; w.x = cvtpk(y.x, y.y); w.y = cvtpk(y.z, y.w); *(u32x2*)(XG + (size_t)u.pm * 256 * DM + off) = w; } }
            }
#pragma unroll
        for (int ai = 0; ai < 2; ++ai)
#pragma unroll
            for (int m = 0; m < 4; ++m) { float s = ss[ai][m]; s += __shfl_xor(s, 16); s += __shfl_xor(s, 32);
                if (fq == 0) atomicAdd(rowss + u.pm * 256 + ai * 128 + wr * 64 + m * 16 + fr, s); }
    }
};
struct EpiRelu2 {
    static constexpr bool PERM = true;
    bf16_t* U; const float* rowss; const float* sW;
    __device__ __forceinline__ void operator()(const f32x4 (&acc)[2][2][4][2], const pg8::Unit& u, int wr, int wc, int fr, int fq) const {
        const int row0 = u.pm * 256 + wr * 64 + fr, col0 = u.pn * 256 + wc * 32 + 8 * fq;
        const int cv = u.pm < 16 ? 0 : 1 + ((u.pm - 16) >> 2);
        f32x4 sw[2][2];
#pragma unroll
        for (int bj = 0; bj < 2; ++bj)
#pragma unroll
            for (int n = 0; n < 2; ++n) sw[bj][n] = *(const f32x4*)(sW + (size_t)cv * DFF + col0 + bj * 128 + 4 * n);
#pragma unroll
        for (int ai = 0; ai < 2; ++ai)
#pragma unroll
            for (int m = 0; m < 4; ++m) { const int row = row0 + ai * 128 + m * 16; bf16_t* rowp = U + (size_t)row * DFF + col0;
                const float rs = rsqrtf(rowss[row] * (1.f / DM) + EPS);
#pragma unroll
                for (int bj = 0; bj < 2; ++bj) { f32x4 v0 = acc[ai][bj][m][0] * rs + sw[bj][0], v1 = acc[ai][bj][m][1] * rs + sw[bj][1];
#pragma unroll
                    for (int e = 0; e < 4; ++e) { const float a = fmaxf(v0[e], 0.f), b = fmaxf(v1[e], 0.f); v0[e] = a * a; v1[e] = b * b; }
                    u32x4 w; w.x = cvtpk(v0[0], v0[1]); w.y = cvtpk(v0[2], v0[3]); w.z = cvtpk(v1[0], v1[1]); w.w = cvtpk(v1[2], v1[3]);
                    *(u32x4*)(rowp + bj * 128) = w; } }
    }
};

__device__ __forceinline__ void p0_transpose_item(const float* W, int K, int N, bf16_t* WT, int row_off, LAS float* scr, int item, int lane, const float* shp = nullptr, float* sWp = nullptr) {
    const int nblk = N / 32, kb = item / nblk, nb = item % nblk, k0 = 64 * kb, n0 = 32 * nb;
#pragma unroll 8
    for (int i = 0; i < 32; ++i) { const int kk = 2 * i + (lane >> 5); scr[kk * 33 + (lane & 31)] = W[(size_t)(k0 + kk) * N + n0 + (lane & 31)]; }
    LDS_WAIT(); asm volatile("" ::: "memory");
    if (shp) {
        const float h0 = shp[k0 + lane], h1 = shp[2 * NMODC + k0 + lane], h2 = shp[4 * NMODC + k0 + lane];
        float s0 = 0.f, s1 = 0.f, s2 = 0.f; const int n = lane & 31;
#pragma unroll 4
        for (int k = 0; k < 64; ++k) { const float w = scr[k * 33 + n];
            s0 += w * __builtin_bit_cast(float, __builtin_amdgcn_readlane(__builtin_bit_cast(int, h0), k));
            s1 += w * __builtin_bit_cast(float, __builtin_amdgcn_readlane(__builtin_bit_cast(int, h1), k));
            s2 += w * __builtin_bit_cast(float, __builtin_amdgcn_readlane(__builtin_bit_cast(int, h2), k)); }
        if (lane < 32) { atomicAdd(sWp + n0 + n, s0); atomicAdd(sWp + DFF + n0 + n, s1); atomicAdd(sWp + 2 * DFF + n0 + n, s2); }
    }
    const int c = lane & 7;
#pragma unroll
    for (int j = 0; j < 4; ++j) { const int n = (lane >> 3) + 8 * j; const LAS float* s = scr + (8 * c) * 33 + n;
        u32x4 o; o.x = cvtpk(s[0 * 33], s[1 * 33]); o.y = cvtpk(s[2 * 33], s[3 * 33]); o.z = cvtpk(s[4 * 33], s[5 * 33]); o.w = cvtpk(s[6 * 33], s[7 * 33]);
        *(u32x4*)(WT + (size_t)(row_off + n0 + n) * K + k0 + 8 * c) = o; }
    LDS_WAIT(); asm volatile("" ::: "memory");
}
__device__ __forceinline__ void p0_ada_item(const Args& a, LAS unsigned char* lds, int wi, int tid) {
    LAS float* sc = (LAS float*)lds;
    LAS float* red = (LAS float*)(lds + 24576);
    const int l = wi >> 7, col0 = 96 * (wi & 127);
    for (int i = tid; i < 3 * 2048; i += 512) { const int v = i >> 11, k = i & 2047; const float x = v == 0 ? a.in[7][k] : a.in[6][(v - 1) * 2048 + k]; sc[i] = siluf(x); }
    __syncthreads();
    const int c4 = tid % 24, r = tid / 24;
    if (r < 21) {
        f32x4 a0 = {0.f, 0.f, 0.f, 0.f}, a1 = a0, a2 = a0;
        const float* wp = a.in[8] + (size_t)l * 2048 * NMODC + col0 + 4 * c4;
#pragma unroll 4
        for (int k = r; k < 2048; k += 21) { const f32x4 w = *(const f32x4*)(wp + (size_t)k * NMODC); a0 += w * sc[k]; a1 += w * sc[2048 + k]; a2 += w * sc[4096 + k]; }
        LAS float* rp = red + (r * 24 + c4) * 12;
        *(LAS f32x4*)rp = a0; *(LAS f32x4*)(rp + 4) = a1; *(LAS f32x4*)(rp + 8) = a2;
    }
    __syncthreads();
    if (tid < 288) { const int v = tid / 96, c = tid % 96; float s = 0.f;
        for (int rr = 0; rr < 21; ++rr) s += red[(rr * 24 + (c >> 2)) * 12 + v * 4 + (c & 3)];
        float* mod = (float*)(a.ws + WS_MOD);
        mod[(size_t)v * 2 * NMODC + l * NMODC + col0 + c] = s + a.in[9][l * NMODC + col0 + c]; }
    __syncthreads();
}

constexpr int I_IN = 32 * 208, I_OUT = 32 * 64, I_POOL = 8 * 16, I_M1 = 32 * 256, I_M2 = 128 * 64;
constexpr int R_IN = 0, R_OUT = R_IN + I_IN, R_M1_0 = R_OUT + I_OUT, R_M2_0 = R_M1_0 + I_M1, R_POOL = R_M2_0 + I_M2, R_M1_1 = R_POOL + 4 * I_POOL, R_M2_1 = R_M1_1 + I_M1, R_END = R_M2_1 + I_M2;
__device__ __forceinline__ void transpose_dispatch(const Args& a, int it, LAS float* scr, int lane) {
    unsigned char* ws = a.ws;
    const float* MOD = (const float*)(ws + WS_MOD); float* SW = (float*)(ws + WS_SW);
    if (it < R_OUT) { p0_transpose_item(a.in[12], 2048, IN_AB, (bf16_t*)(ws + WS_WIN), 0, scr, it - R_IN, lane); return; }
    if (it < R_M1_0) { p0_transpose_item(a.in[13], 2048, 2048, (bf16_t*)(ws + WS_WOUT), 0, scr, it - R_OUT, lane); return; }
    if (it < R_M2_0) { p0_transpose_item(a.in[20], 2048, DFF, (bf16_t*)(ws + WS_WM1), 0, scr, it - R_M1_0, lane, MOD + 3 * 2048, SW); return; }
    if (it < R_POOL) { p0_transpose_item(a.in[21], DFF, 2048, (bf16_t*)(ws + WS_WM2), 0, scr, it - R_M2_0, lane); return; }
    if (it < R_M1_1) { const int r = it - R_POOL, g = r / I_POOL; p0_transpose_item(a.in[18] + (size_t)g * 512 * 512, 512, 512, (bf16_t*)(ws + WS_WPOOL), g * 512, scr, r % I_POOL, lane); return; }
    if (it < R_M2_1) { p0_transpose_item(a.in[20] + (size_t)2048 * DFF, 2048, DFF, (bf16_t*)(ws + WS_WM1) + (size_t)DFF * 2048, 0, scr, it - R_M1_1, lane, MOD + NMODC + 3 * 2048, SW + 3 * DFF); return; }
    p0_transpose_item(a.in[21] + (size_t)DFF * 2048, DFF, 2048, (bf16_t*)(ws + WS_WM2) + (size_t)2048 * DFF, 0, scr, it - R_M2_1, lane);
}
__device__ __forceinline__ void bg_transposes(const Args& a, LAS unsigned char* lds, int lo, int hi, int w, int nw, int wave, int lane) {
    LAS float* scr = (LAS float*)(lds + wave * 16384);
    for (int it = lo + w; it < hi; it += nw) transpose_dispatch(a, it, scr, lane);
}

__device__ __forceinline__ void norm_rows_bf16(const Args& a, const float* xa  , const float* gain, int layer, int soff, bf16_t* H, int gw, int ngw, int lane) {
    const float* mod = (const float*)(a.ws + WS_MOD);
    for (int row = gw; row < NTOK; row += ngw) {
        const float* xr = xa ? xa + (size_t)row * DM : xin_row(a, row);
        const float* mp = mod + (size_t)cvec_of_row(row) * 2 * NMODC + layer * NMODC + soff;
        f32x4 v[8]; float ss = 0.f;
#pragma unroll
        for (int j = 0; j < 8; ++j) { v[j] = *(const f32x4*)(xr + 4 * (lane + 64 * j)); ss += v[j].x * v[j].x + v[j].y * v[j].y + v[j].z * v[j].z + v[j].w * v[j].w; }
        const float rstd = rsqrtf(wave_sum(ss) * (1.f / DM) + EPS);
#pragma unroll
        for (int j = 0; j < 8; ++j) { const int c = 4 * (lane + 64 * j);
            const f32x4 g = *(const f32x4*)(gain + c), sh = *(const f32x4*)(mp + c), sc = *(const f32x4*)(mp + 2048 + c);
            const f32x4 y = v[j] * rstd * g * (sc + 1.f) + sh;
            u32x2 w; w.x = cvtpk(y.x, y.y); w.y = cvtpk(y.z, y.w);
            *(u32x2*)(H + (size_t)row * DM + c) = w; }
    }
}
__device__ __forceinline__ void norm_rows_f32(const Args& a, const float* xa, const float* gain, int layer, int soff  , float* O, int gw, int ngw, int lane) {
    const float* mod = (const float*)(a.ws + WS_MOD);
    for (int row = gw; row < NTOK; row += ngw) {
        const float* xr = xa + (size_t)row * DM;
        const float* mp = mod + (size_t)cvec_of_row(row) * 2 * NMODC + layer * NMODC + (soff < 0 ? 0 : soff);
        f32x4 v[8]; float ss = 0.f;
#pragma unroll
        for (int j = 0; j < 8; ++j) { v[j] = *(const f32x4*)(xr + 4 * (lane + 64 * j)); ss += v[j].x * v[j].x + v[j].y * v[j].y + v[j].z * v[j].z + v[j].w * v[j].w; }
        const float rstd = rsqrtf(wave_sum(ss) * (1.f / DM) + EPS);
#pragma unroll
        for (int j = 0; j < 8; ++j) { const int c = 4 * (lane + 64 * j);
            const f32x4 g = *(const f32x4*)(gain + c);
            f32x4 y = v[j] * rstd * g;
            if (soff >= 0) { const f32x4 sh = *(const f32x4*)(mp + c), sc = *(const f32x4*)(mp + 2048 + c); y = y * (sc + 1.f) + sh; }
            *(f32x4*)(O + (size_t)row * DM + c) = y; }
    }
}
template <int HW> __device__ __forceinline__ void pool_out(const LAS float* T, bf16_t* P, int row0, int t0, int Tseq, int cb, int tid) {
    const int cq = tid & 63, tgp = tid >> 6;
#pragma unroll
    for (int j = 0; j < 8; ++j) { const int tl = tgp * 8 + j, t = t0 + tl;
        f32x4 s = {0.f, 0.f, 0.f, 0.f};
#pragma unroll
        for (int d = -HW; d < HW; ++d) { const int u = t + d; const f32x4 v = *(const LAS f32x4*)(T + (tl + 8 + d) * 256 + cq * 4); if (u >= 0 && u < Tseq) s += v; }
        const int lo = max(t - HW, 0), hi = min(t + HW, Tseq);
        const f32x4 x = *(const LAS f32x4*)(T + (tl + 8) * 256 + cq * 4);
        const f32x4 y = s * (1.f / (float)(hi - lo)) - x;
        u32x2 w; w.x = cvtpk(y.x, y.y); w.y = cvtpk(y.z, y.w);
        *(u32x2*)(P + (size_t)(row0 + tl) * DM + cb * 256 + cq * 4) = w; }
}
__device__ __forceinline__ void pool_phase(const Args& a, LAS unsigned char* lds, const float* XA, const float* rowss, bf16_t* P, int bx, int G, int tid) {
    LAS float* T = (LAS float*)lds;
    const float* MOD = (const float*)(a.ws + WS_MOD);
    const int lane = tid & 63, wave = tid >> 6;
    for (int item = bx; item < 768; item += G) {
        const int tt = item >> 3, cb = item & 7, g = cb >> 1, row0 = tt * 64;
        int s0, Tseq;
        if (row0 < NTOK_P) { s0 = row0 & ~255; Tseq = SEQ_P; } else { s0 = NTOK_P + ((row0 - NTOK_P) & ~1023); Tseq = SEQ_S; }
        const int t0 = row0 - s0, c = cb * 256 + lane * 4;
        const float* mp = MOD + (size_t)cvec_of_row(row0) * 2 * NMODC + NMODC;
        const f32x4 gmul = *(const f32x4*)(a.in[10] + 2048 + c) * (*(const f32x4*)(mp + 2048 + c) + 1.f), sh = *(const f32x4*)(mp + c);
        for (int rr = wave; rr < 80; rr += 8) { const int t = t0 - 8 + rr;
            if (t >= 0 && t < Tseq) { const int row = s0 + t; const float rstd = rsqrtf(rowss[row] * (1.f / DM) + EPS);
                const f32x4 x = *(const f32x4*)(XA + (size_t)row * DM + c);
                *(LAS f32x4*)(T + rr * 256 + lane * 4) = x * rstd * gmul + sh; } }
        __syncthreads();
        switch (g) { case 0: pool_out<1>(T, P, row0, t0, Tseq, cb, tid); break; case 1: pool_out<2>(T, P, row0, t0, Tseq, cb, tid); break;
                     case 2: pool_out<4>(T, P, row0, t0, Tseq, cb, tid); break; default: pool_out<8>(T, P, row0, t0, Tseq, cb, tid); break; }
        __syncthreads();
    }
}
__device__ __forceinline__ void final_rows(const float* XA, const float* rowss, const float* gain, float* O, int gw, int ngw, int lane) {
    for (int row = gw; row < NTOK; row += ngw) { const float rstd = rsqrtf(rowss[row] * (1.f / DM) + EPS);
#pragma unroll
        for (int j = 0; j < 8; ++j) { const int c = 4 * (lane + 64 * j);
            *(f32x4*)(O + (size_t)row * DM + c) = *(const f32x4*)(XA + (size_t)row * DM + c) * rstd * *(const f32x4*)(gain + c); } }
}

__device__ __forceinline__ void post_token(const Args& a, int row, int lane) {
    const bf16_t* ZB = (const bf16_t*)(a.ws + WS_ZB);
    bf16_t* QN = (bf16_t*)(a.ws + WS_QN);
    const bool samp = row >= NTOK_P;
    const int bb = samp ? (row - NTOK_P) >> 10 : row >> 8, t = samp ? (row - NTOK_P) & 1023 : row & 255;
    const int e0 = (lane & 31) * 4, hsel = lane >> 5;
    const int sect = e0 >> 5;
    float cs[4], sn[4];
    if (samp) {
        const float pos = (float)((sect < 2) ? (t >> 6) : (t & 63));
#pragma unroll
        for (int i = 0; i < 4; ++i) { const int j = (e0 + i) & 31; const float inv = exp2f(-(float)j * 0.41524101186092033f); const float ang = pos * inv; cs[i] = __cosf(ang); sn[i] = __sinf(ang); }
    }
#pragma unroll
    for (int p = 0; p < 6; ++p) {
        const int col = p * 256 + lane * 4;
        const u32x2 raw = *(const u32x2*)(ZB + (size_t)row * IN_AB + col);
        float y[4] = {bflo(raw.x), bfhi(raw.x), bflo(raw.y), bfhi(raw.y)};
        if (p < 5) {
            const float ss = half_sum(y[0] * y[0] + y[1] * y[1] + y[2] * y[2] + y[3] * y[3]);
            const float rstd = rsqrtf(ss * (1.f / 128.f) + EPS);
            const f32x4 g = *(const f32x4*)((p < 4 ? a.in[14] : a.in[15]) + e0);
            y[0] *= rstd * g.x; y[1] *= rstd * g.y; y[2] *= rstd * g.z; y[3] *= rstd * g.w;
        }
        if (!samp && p >= 4) {
            float* o = a.out + (p == 4 ? 12582912 : 13631488) + (size_t)row * 256 + lane * 4;
            *(f32x4*)o = (f32x4){y[0], y[1], y[2], y[3]};
        }
        if (samp && p < 5) {
#pragma unroll
            for (int i = 0; i < 4; ++i) { const float py = __shfl_xor(y[i], 8); const float rot = (sect & 1) ? py : -py; y[i] = y[i] * cs[i] + rot * sn[i]; }
        }
        u32x2 w; w.x = cvtpk(y[0], y[1]); w.y = cvtpk(y[2], y[3]);
        if (p < 4) *(u32x2*)(QN + (size_t)row * 1024 + col) = w;
        else {
            bf16_t* dst;
            if (samp) dst = (bf16_t*)(a.ws + (p == 4 ? WS_KS : WS_VS)) + ((size_t)(bb * 2 + hsel) * 1280 + t) * 128 + e0;
            else      dst = (bf16_t*)(a.ws + (p == 4 ? WS_KP : WS_VP)) + ((size_t)(bb * 2 + hsel) * 256 + t) * 128 + e0;
            *(u32x2*)dst = w;
        }
    }
}
__device__ __forceinline__ void cache_item(const Args& a, int item, int lane) {
    const int which = item >> 9, b = (item >> 8) & 1, t = item & 255, hsel = lane >> 5, e0 = (lane & 31) * 4;
    const f32x4 v = *(const f32x4*)(a.in[2 + which] + ((size_t)(b * 256 + t) * 2 + hsel) * 128 + e0);
    bf16_t* dst = (bf16_t*)(a.ws + (which == 0 ? WS_KS : WS_VS)) + ((size_t)(b * 2 + hsel) * 1280 + 1024 + t) * 128 + e0;
    u32x2 w; w.x = cvtpk(v.x, v.y); w.y = cvtpk(v.z, v.w);
    *(u32x2*)dst = w;
}
__device__ __forceinline__ void combine_token(const Args& a, int row, int lane) {
    const float* OF = (const float*)(a.ws + WS_OF); const float* OB = (const float*)(a.ws + WS_OB);
    const bf16_t* ZB = (const bf16_t*)(a.ws + WS_ZB); bf16_t* A2 = (bf16_t*)(a.ws + WS_A2);
    const int e0 = (lane & 31) * 4;
    const f32x4 g = *(const f32x4*)(a.in[16] + e0);
#pragma unroll
    for (int p = 0; p < 4; ++p) {
        const int col = p * 256 + lane * 4;
        const f32x4 o = *(const f32x4*)(OF + (size_t)row * 1024 + col) + *(const f32x4*)(OB + (size_t)row * 1024 + col);
        const float ss = half_sum(o.x * o.x + o.y * o.y + o.z * o.z + o.w * o.w);
        const float rstd = rsqrtf(ss * (1.f / 128.f) + EPS);
        const u32x2 raw = *(const u32x2*)(ZB + (size_t)row * IN_AB + C_HG + col);
        const f32x4 y = o * rstd * g * (f32x4){bflo(raw.x), bfhi(raw.x), bflo(raw.y), bfhi(raw.y)};
        u32x2 w; w.x = cvtpk(y.x, y.y); w.y = cvtpk(y.z, y.w);
        *(u32x2*)(A2 + (size_t)row * DM + 1024 + col) = w;
    }
}

constexpr int HG_ROW = 136, HG_TROW = 40;
constexpr int HG_QI = 0, HG_KI = 32 * HG_ROW * 2, HG_QS = 2 * 32 * HG_ROW * 2, HG_KST = 3 * 32 * HG_ROW * 2, HG_IT = HG_KST + 128 * HG_TROW * 2, HG_A = HG_IT + 128 * HG_TROW * 2, HG_GT = HG_A + 512, HG_SEQ_BYTES = HG_GT + 4096;
static_assert(HG_SEQ_BYTES % 16 == 0 && 2 * HG_SEQ_BYTES <= RING_BYTES, "hgrn lds");
__device__ __forceinline__ int crow(int r, int hi) { return (r & 3) + 8 * (r >> 2) + 4 * hi; }
__device__ __forceinline__ int kpos(int k) { const int kp = k & 15; return (k & 16) + (((kp >> 2) & 1) << 3) + ((kp >> 3) << 2) + (kp & 3); }
#define MFMA32(a, b, c) __builtin_amdgcn_mfma_f32_32x32x16_bf16((a), (b), (c), 0, 0, 0)
__device__ __forceinline__ bf16x8 pack8(const f32x16& x, int s) {
    u32x4 p; p.x = cvtpk(x[8 * s], x[8 * s + 1]); p.y = cvtpk(x[8 * s + 2], x[8 * s + 3]); p.z = cvtpk(x[8 * s + 4], x[8 * s + 5]); p.w = cvtpk(x[8 * s + 6], x[8 * s + 7]);
    return __builtin_bit_cast(bf16x8, p);
}
struct HgRegs { f32x4 lf[4]; u32x2 qv[4], iv[4]; };
__device__ __forceinline__ void hg_load(HgRegs& R, const float* LF, const bf16_t* ZB, int rowbase, int dir, int hh, int cg, int tg, int ch) {
#pragma unroll
    for (int jj = 0; jj < 4; ++jj) { const int j = 4 * tg + jj;
        const int row = rowbase + (dir == 0 ? 32 * ch + j : 32 * (7 - ch) + 31 - j);
        R.lf[jj] = *(const f32x4*)(LF + (size_t)row * 2048 + dir * 1024 + hh * 128 + 4 * cg);
        R.qv[jj] = *(const u32x2*)(ZB + (size_t)row * IN_AB + C_HQ + hh * 128 + 4 * cg);
        R.iv[jj] = *(const u32x2*)(ZB + (size_t)row * IN_AB + C_HI + hh * 128 + 4 * cg); }
}
__device__ __forceinline__ void hg_chunk(const HgRegs& R, f32x16 (&S)[4], f32x4& ltot, LAS unsigned char* L, float* OUT, int rowbase, int dir, int hh, int ch,
                                         int cg, int tg, int r32, int hi, int e0) {
    f32x4 cb[4]; cb[0] = R.lf[0]; cb[1] = cb[0] + R.lf[1]; cb[2] = cb[1] + R.lf[2]; cb[3] = cb[2] + R.lf[3];
    *(LAS f32x4*)(L + HG_GT + (tg * 128 + 4 * cg) * 4) = cb[3];
    __syncthreads();
    f32x4 off = {0.f, 0.f, 0.f, 0.f}, bm = off, bl = off;
#pragma unroll
    for (int g = 0; g < 8; ++g) { const f32x4 t4 = *(const LAS f32x4*)(L + HG_GT + (g * 128 + 4 * cg) * 4); if (g < tg) off += t4; if (g < 4) bm += t4; bl += t4; }
    ltot += bl;
    f32x4 em, elm;
#pragma unroll
    for (int c = 0; c < 4; ++c) { em[c] = __expf(bm[c]); elm[c] = __expf(bl[c] - bm[c]); }
    if (tg == 0) { f32x4 av;
#pragma unroll
        for (int c = 0; c < 4; ++c) av[c] = __expf(bl[c]);
        *(LAS f32x4*)(L + HG_A + 16 * cg) = av; }
    float kS_[4][4], iv_[4][4];
#pragma unroll
    for (int jj = 0; jj < 4; ++jj) {
        const int j = 4 * tg + jj;
        const float q4[4] = {bflo(R.qv[jj].x), bfhi(R.qv[jj].x), bflo(R.qv[jj].y), bfhi(R.qv[jj].y)};
        iv_[jj][0] = bflo(R.iv[jj].x); iv_[jj][1] = bfhi(R.iv[jj].x); iv_[jj][2] = bflo(R.iv[jj].y); iv_[jj][3] = bfhi(R.iv[jj].y);
        float qI[4], qS[4], kI[4];
#pragma unroll
        for (int c = 0; c < 4; ++c) {
            const float b = off[c] + cb[jj][c];
            const float E1 = __expf(fminf(fmaxf(b - bm[c], -80.f), 80.f)), R1 = 1.f / E1;
            const float kk = 1.f - __expf(R.lf[jj][c]);
            qI[c] = q4[c] * E1; qS[c] = qI[c] * em[c];
            kI[c] = kk * R1; kS_[jj][c] = kI[c] * elm[c];
        }
        u32x2 w; w.x = cvtpk(qI[0], qI[1]); w.y = cvtpk(qI[2], qI[3]);
        *(LAS u32x2*)(L + HG_QI + (j * HG_ROW + 4 * cg) * 2) = w;
        w.x = cvtpk(kI[0], kI[1]); w.y = cvtpk(kI[2], kI[3]);
        *(LAS u32x2*)(L + HG_KI + (j * HG_ROW + 4 * cg) * 2) = w;
        w.x = cvtpk(qS[0], qS[1]); w.y = cvtpk(qS[2], qS[3]);
        *(LAS u32x2*)(L + HG_QS + (j * HG_ROW + (4 * cg & ~31) + kpos(4 * cg & 31)) * 2) = w;
    }
    {
        const int p0 = kpos(4 * tg);
#pragma unroll
        for (int c = 0; c < 4; ++c) { u32x2 w; w.x = cvtpk(kS_[0][c], kS_[1][c]); w.y = cvtpk(kS_[2][c], kS_[3][c]);
            *(LAS u32x2*)(L + HG_KST + ((4 * cg + c) * HG_TROW + p0) * 2) = w;
            w.x = cvtpk(iv_[0][c], iv_[1][c]); w.y = cvtpk(iv_[2][c], iv_[3][c]);
            *(LAS u32x2*)(L + HG_IT + ((4 * cg + c) * HG_TROW + p0) * 2) = w; }
    }
    __syncthreads();
    f32x16 x;
#pragma unroll
    for (int i = 0; i < 16; ++i) x[i] = 0.f;
#pragma unroll
    for (int ks = 0; ks < 8; ++ks) {
        const bf16x8 fa = *(const LAS bf16x8*)(L + HG_KI + (r32 * HG_ROW + 16 * ks + 8 * hi) * 2);
        const bf16x8 fb = *(const LAS bf16x8*)(L + HG_QI + (r32 * HG_ROW + 16 * ks + 8 * hi) * 2);
        x = MFMA32(fa, fb, x);
    }
#pragma unroll
    for (int i = 0; i < 16; ++i) x[i] = (crow(i, hi) <= r32) ? x[i] : 0.f;
    f32x16 y;
#pragma unroll
    for (int i = 0; i < 16; ++i) y[i] = 0.f;
    bf16x8 fi[2];
#pragma unroll
    for (int ks = 0; ks < 2; ++ks) {
        fi[ks] = *(const LAS bf16x8*)(L + HG_IT + ((e0 + r32) * HG_TROW + 16 * ks + 8 * hi) * 2);
        y = MFMA32(fi[ks], pack8(x, ks), y);
    }
#pragma unroll
    for (int db = 0; db < 4; ++db)
#pragma unroll
        for (int ks = 0; ks < 2; ++ks) {
            const bf16x8 fq_ = *(const LAS bf16x8*)(L + HG_QS + (r32 * HG_ROW + 32 * db + 16 * ks + 8 * hi) * 2);
            y = MFMA32(pack8(S[db], ks), fq_, y);
        }
    {
        const int row = rowbase + (dir == 0 ? 32 * ch + r32 : 32 * (7 - ch) + 31 - r32);
        float* op = OUT + (size_t)row * 1024 + hh * 128 + e0 + 4 * hi;
#pragma unroll
        for (int g4 = 0; g4 < 4; ++g4) *(f32x4*)(op + 8 * g4) = (f32x4){y[4 * g4], y[4 * g4 + 1], y[4 * g4 + 2], y[4 * g4 + 3]};
    }
#pragma unroll
    for (int db = 0; db < 4; ++db) {
#pragma unroll
        for (int g4 = 0; g4 < 4; ++g4) { const f32x4 a4 = *(const LAS f32x4*)(L + HG_A + (32 * db + 8 * g4 + 4 * hi) * 4);
#pragma unroll
            for (int c = 0; c < 4; ++c) S[db][4 * g4 + c] *= a4[c]; }
#pragma unroll
        for (int ks = 0; ks < 2; ++ks) {
            const bf16x8 fk = *(const LAS bf16x8*)(L + HG_KST + ((32 * db + r32) * HG_TROW + 16 * ks + 8 * hi) * 2);
            S[db] = MFMA32(fk, fi[ks], S[db]);
        }
    }
}
__device__ __forceinline__ void hgrn_task(const Args& a, LAS unsigned char* lds0, int task, int tid) {
    const bool samp = task < 64;
    const int bb = samp ? task >> 5 : (task - 64) >> 3, hh = samp ? (task >> 2) & 7 : task & 7, seg = task & 3;
    const int rowbase = samp ? NTOK_P + bb * SEQ_S + seg * 256 : bb * SEQ_P;
    const int dir = tid >> 8, tl = tid & 255, lane = tid & 63, wq = (tid >> 6) & 3, r32 = lane & 31, hi = lane >> 5;
    LAS unsigned char* L = lds0 + dir * HG_SEQ_BYTES;
    const bf16_t* ZB = (const bf16_t*)(a.ws + WS_ZB); const float* LF = (const float*)(a.ws + WS_LF);
    float* OUT = (float*)(a.ws + (dir == 0 ? WS_OF : WS_OB));
    const int cg = tl & 31, tg = tl >> 5, e0 = 32 * wq;
    f32x16 S[4];
    const bool has_init = samp && (dir == 0 ? seg == 0 : seg == 3);
    if (has_init) { const float* s0 = a.in[4 + dir] + (size_t)(bb * 8 + hh) * 16384;
#pragma unroll
        for (int db = 0; db < 4; ++db)
#pragma unroll
            for (int i = 0; i < 16; ++i) S[db][i] = s0[(size_t)(32 * db + crow(i, hi)) * 128 + e0 + r32];
    } else {
#pragma unroll
        for (int db = 0; db < 4; ++db)
#pragma unroll
            for (int i = 0; i < 16; ++i) S[db][i] = 0.f;
    }
    f32x4 ltot = {0.f, 0.f, 0.f, 0.f};
    HgRegs RA, RB;
    hg_load(RA, LF, ZB, rowbase, dir, hh, cg, tg, 0);
    hg_load(RB, LF, ZB, rowbase, dir, hh, cg, tg, 1);
#pragma unroll 1
    for (int ch = 0; ch < 8; ch += 2) {
        hg_chunk(RA, S, ltot, L, OUT, rowbase, dir, hh, ch, cg, tg, r32, hi, e0);
        if (ch + 2 < 8) hg_load(RA, LF, ZB, rowbase, dir, hh, cg, tg, ch + 2);
        hg_chunk(RB, S, ltot, L, OUT, rowbase, dir, hh, ch + 1, cg, tg, r32, hi, e0);
        if (ch + 3 < 8) hg_load(RB, LF, ZB, rowbase, dir, hh, cg, tg, ch + 3);
    }
    if (!samp) { float* so = a.out + (dir == 0 ? 14680064 : 16777216) + (size_t)(bb * 8 + hh) * 16384;
#pragma unroll
        for (int db = 0; db < 4; ++db)
#pragma unroll
            for (int i = 0; i < 16; ++i) so[(size_t)(32 * db + crow(i, hi)) * 128 + e0 + r32] = S[db][i];
    } else {
        const size_t sidx = (size_t)(((bb * 8 + hh) * 2 + dir) * 4 + seg);
        float* so = (float*)(a.ws + WS_SEND) + sidx * 16384;
#pragma unroll
        for (int db = 0; db < 4; ++db)
#pragma unroll
            for (int i = 0; i < 16; ++i) so[(size_t)(32 * db + crow(i, hi)) * 128 + e0 + r32] = S[db][i];
        if (tg == 0) *(f32x4*)((float*)(a.ws + WS_LSEG) + sidx * 128 + 4 * cg) = ltot;
    }
    __syncthreads();
}
constexpr int FX_QS = 0, FX_GT = 32 * HG_ROW * 2, FX_DIR_BYTES = FX_GT + 4096, FX_Z = 2 * FX_DIR_BYTES, FX_ZROW = 132, FX_RED = FX_Z + 32 * FX_ZROW * 4, FX_BYTES = FX_RED + 512;
__device__ __forceinline__ void hgfix_task(const Args& a, LAS unsigned char* lds0, int task, int tid) {
    const int bb = task >> 5, hh = (task >> 2) & 7, seg = task & 3;
    const int rowbase = NTOK_P + bb * SEQ_S + seg * 256;
    const int dir = tid >> 8, tl = tid & 255, lane = tid & 63, wq = (tid >> 6) & 3, r32 = lane & 31, hi = lane >> 5;
    LAS unsigned char* L = lds0 + dir * FX_DIR_BYTES;
    const bf16_t* ZB = (const bf16_t*)(a.ws + WS_ZB); const float* LF = (const float*)(a.ws + WS_LF);
    const float* OIN = (const float*)(a.ws + (dir == 0 ? WS_OF : WS_OB));
    bf16_t* A2 = (bf16_t*)(a.ws + WS_A2);
    const int cg = tl & 31, tg = tl >> 5, e0 = 32 * wq;
    const size_t sbase = (size_t)((bb * 8 + hh) * 2 + dir) * 4;
    const float* SEND = (const float*)(a.ws + WS_SEND); const float* LSEG = (const float*)(a.ws + WS_LSEG);
    f32x16 S[4];
#pragma unroll
    for (int db = 0; db < 4; ++db)
#pragma unroll
        for (int i = 0; i < 16; ++i) S[db][i] = 0.f;
    const int nfold = dir == 0 ? seg : 3 - seg;
    for (int f = 0; f < nfold; ++f) { const int j = dir == 0 ? f : 3 - f;
        const float* sp = SEND + (sbase + j) * 16384; const float* lp = LSEG + (sbase + j) * 128;
#pragma unroll
        for (int db = 0; db < 4; ++db)
#pragma unroll
            for (int g4 = 0; g4 < 4; ++g4) { const f32x4 l4 = *(const f32x4*)(lp + 32 * db + 8 * g4 + 4 * hi);
#pragma unroll
                for (int c = 0; c < 4; ++c) { const int i = 4 * g4 + c; S[db][i] = S[db][i] * __expf(l4[c]) + sp[(size_t)(32 * db + crow(i, hi)) * 128 + e0 + r32]; } }
    }
    bf16x8 sf[4][2];
#pragma unroll
    for (int db = 0; db < 4; ++db)
#pragma unroll
        for (int ks = 0; ks < 2; ++ks) sf[db][ks] = pack8(S[db], ks);
    f32x4 run = {0.f, 0.f, 0.f, 0.f}, ltot = {0.f, 0.f, 0.f, 0.f};
    if (dir == 1) ltot = *(const f32x4*)(LSEG + (sbase + seg) * 128 + 4 * cg);
    const f32x4 gn0 = *(const f32x4*)(a.in[16] + e0 + 4 * hi), gn1 = *(const f32x4*)(a.in[16] + e0 + 4 * hi + 8), gn2 = *(const f32x4*)(a.in[16] + e0 + 4 * hi + 16), gn3 = *(const f32x4*)(a.in[16] + e0 + 4 * hi + 24);
#pragma unroll 1
    for (int ch = 0; ch < 8; ++ch) {
        f32x4 lf[4]; u32x2 qv[4];
#pragma unroll
        for (int jj = 0; jj < 4; ++jj) { const int row = rowbase + 32 * ch + 4 * tg + jj;
            lf[jj] = *(const f32x4*)(LF + (size_t)row * 2048 + dir * 1024 + hh * 128 + 4 * cg);
            qv[jj] = *(const u32x2*)(ZB + (size_t)row * IN_AB + C_HQ + hh * 128 + 4 * cg); }
        f32x4 cb[4]; cb[0] = lf[0]; cb[1] = cb[0] + lf[1]; cb[2] = cb[1] + lf[2]; cb[3] = cb[2] + lf[3];
        *(LAS f32x4*)(L + FX_GT + (tg * 128 + 4 * cg) * 4) = cb[3];
        __syncthreads();
        f32x4 off = {0.f, 0.f, 0.f, 0.f}, bl = off;
#pragma unroll
        for (int g = 0; g < 8; ++g) { const f32x4 t4 = *(const LAS f32x4*)(L + FX_GT + (g * 128 + 4 * cg) * 4); if (g < tg) off += t4; bl += t4; }
#pragma unroll
        for (int jj = 0; jj < 4; ++jj) { const int j = 4 * tg + jj;
            const float q4[4] = {bflo(qv[jj].x), bfhi(qv[jj].x), bflo(qv[jj].y), bfhi(qv[jj].y)};
            float qB[4];
#pragma unroll
            for (int c = 0; c < 4; ++c) { const float incl = run[c] + off[c] + cb[jj][c];
                const float B = dir == 0 ? incl : ltot[c] - (incl - lf[jj][c]);
                qB[c] = q4[c] * __expf(B); }
            u32x2 w; w.x = cvtpk(qB[0], qB[1]); w.y = cvtpk(qB[2], qB[3]);
            *(LAS u32x2*)(L + FX_QS + (j * HG_ROW + (4 * cg & ~31) + kpos(4 * cg & 31)) * 2) = w; }
        run += bl;
        __syncthreads();
        f32x16 y;
#pragma unroll
        for (int i = 0; i < 16; ++i) y[i] = 0.f;
        if (nfold > 0) {
#pragma unroll
            for (int db = 0; db < 4; ++db)
#pragma unroll
                for (int ks = 0; ks < 2; ++ks) { const bf16x8 fq_ = *(const LAS bf16x8*)(L + FX_QS + (r32 * HG_ROW + 32 * db + 16 * ks + 8 * hi) * 2); y = MFMA32(sf[db][ks], fq_, y); }
        }
        const int row = rowbase + 32 * ch + r32;
        const float* ip = OIN + (size_t)row * 1024 + hh * 128 + e0 + 4 * hi;
        f32x4 z[4];
#pragma unroll
        for (int g4 = 0; g4 < 4; ++g4) z[g4] = *(const f32x4*)(ip + 8 * g4) + (f32x4){y[4 * g4], y[4 * g4 + 1], y[4 * g4 + 2], y[4 * g4 + 3]};
        LAS float* Z = (LAS float*)(lds0 + FX_Z);
        if (dir == 1) {
#pragma unroll
            for (int g4 = 0; g4 < 4; ++g4) *(LAS f32x4*)(Z + r32 * FX_ZROW + e0 + 4 * hi + 8 * g4) = z[g4]; }
        __syncthreads();
        float ssq = 0.f;
        if (dir == 0) {
#pragma unroll
            for (int g4 = 0; g4 < 4; ++g4) { z[g4] += *(const LAS f32x4*)(Z + r32 * FX_ZROW + e0 + 4 * hi + 8 * g4); ssq += (z[g4].x * z[g4].x + z[g4].y * z[g4].y) + (z[g4].z * z[g4].z + z[g4].w * z[g4].w); }
            ssq += __shfl_xor(ssq, 32);
            if (hi == 0) ((LAS float*)(lds0 + FX_RED))[wq * 32 + r32] = ssq;
        }
        __syncthreads();
        if (dir == 0) {
            const LAS float* red = (const LAS float*)(lds0 + FX_RED);
            const float tot = (red[r32] + red[32 + r32]) + (red[64 + r32] + red[96 + r32]);
            const float rstd = rsqrtf(tot * (1.f / 128.f) + EPS);
            const bf16_t* hgp = ZB + (size_t)row * IN_AB + C_HG + hh * 128 + e0 + 4 * hi;
            bf16_t* op = A2 + (size_t)row * DM + 1024 + hh * 128 + e0 + 4 * hi;
            const f32x4 gn[4] = {gn0, gn1, gn2, gn3};
#pragma unroll
            for (int g4 = 0; g4 < 4; ++g4) { const u32x2 raw = *(const u32x2*)(hgp + 8 * g4);
                const f32x4 o = z[g4] * rstd * gn[g4] * (f32x4){bflo(raw.x), bfhi(raw.x), bflo(raw.y), bfhi(raw.y)};
                u32x2 w; w.x = cvtpk(o.x, o.y); w.y = cvtpk(o.z, o.w); *(u32x2*)(op + 8 * g4) = w; }
        }
    }
    __syncthreads();
}

namespace att {
constexpr int D = 128, NW = 8, QBLK = 32, KVBLK = 64;
constexpr float SCALE = 0.088388347648318440f;
constexpr float THR = 0.f;
constexpr int LDQ = 1024, LDK = 128, LDO = 2048;
constexpr int SHM_V = KVBLK * D * 2, SHM_K = KVBLK * D * 2, SHM_ATTN = 2 * SHM_V + 2 * SHM_K + NW * 64 * 4;
#define KSWZ(row, colB) ((row) * 256 + ((colB) ^ (((row) & 7) << 4)))
#define SBAR() __builtin_amdgcn_sched_barrier(0)
__device__ __forceinline__ unsigned cvtpk_a(float lo, float hi) { unsigned r; asm volatile("v_cvt_pk_bf16_f32 %0, %1, %2" : "=v"(r) : "v"(lo), "v"(hi)); return r; }
__device__ __forceinline__ void partialSM(f32x16& p0, f32x16& p1, float& m_reg, float& mn, float& alpha) {
  constexpr float C = SCALE * 1.4426950408889634f;
  float pmax = p0[0]; for (int r = 1; r < 16; ++r) pmax = fmaxf(pmax, p0[r]); for (int r = 0; r < 16; ++r) pmax = fmaxf(pmax, p1[r]);
  { auto rr = __builtin_amdgcn_permlane32_swap(__float_as_uint(pmax), __float_as_uint(pmax), false, false);
    pmax = fmaxf(__uint_as_float(rr[0]), __uint_as_float(rr[1])); }
  if (__builtin_expect(__all(pmax - m_reg <= THR / SCALE), 1)) { mn = m_reg; alpha = 1.f; }
  else { mn = fmaxf(m_reg, pmax); alpha = __builtin_amdgcn_exp2f((m_reg - mn) * C); m_reg = mn; }
  float mnC = -mn * C;
  for (int r = 0; r < 16; ++r) p0[r] = fmaf(p0[r], C, mnC); for (int r = 0; r < 16; ++r) p1[r] = fmaf(p1[r], C, mnC);
  for (int r = 0; r < 16; ++r) p0[r] = __builtin_amdgcn_exp2f(p0[r]);
}
__device__ __forceinline__ void finishSM(f32x16& p0, f32x16& p1, float alpha, float& l_reg, bf16x8& pa0, bf16x8& pa1, bf16x8& pa2, bf16x8& pa3) {
  for (int r = 0; r < 16; ++r) p1[r] = __builtin_amdgcn_exp2f(p1[r]);
  float ps = 0; for (int r = 0; r < 16; ++r) ps += p0[r]; for (int r = 0; r < 16; ++r) ps += p1[r];
  { auto rr = __builtin_amdgcn_permlane32_swap(__float_as_uint(ps), __float_as_uint(ps), false, false);
    ps = __uint_as_float(rr[0]) + __uint_as_float(rr[1]); }
  l_reg = l_reg * alpha + ps;
#define PK4(P, BASE, OUT) do { unsigned a0 = cvtpk_a(P[BASE + 0], P[BASE + 1]), a1 = cvtpk_a(P[BASE + 2], P[BASE + 3]);   \
    unsigned b0 = cvtpk_a(P[BASE + 4], P[BASE + 5]), b1 = cvtpk_a(P[BASE + 6], P[BASE + 7]);                              \
    auto r0 = __builtin_amdgcn_permlane32_swap(a0, b0, false, false); auto r1 = __builtin_amdgcn_permlane32_swap(a1, b1, false, false); \
    u32x4 w = {r0[0], r1[0], r0[1], r1[1]}; OUT = *reinterpret_cast<bf16x8*>(&w); } while (0)
  PK4(p0, 0, pa0); PK4(p0, 8, pa1); PK4(p1, 0, pa2); PK4(p1, 8, pa3);
#undef PK4
}
__device__ __forceinline__ void qkt(f32x16& p0, f32x16& p1, const bf16_t* Ks, const bf16x8* qr, int r32, int hi) {
  p0 = f32x16{}; p1 = f32x16{};
  for (int d0 = 0; d0 < 8; ++d0) { int cb = (d0 * 16 + hi * 8) * 2;
    bf16x8 b0 = *reinterpret_cast<const bf16x8*>((const char*)Ks + KSWZ(r32, cb));
    bf16x8 b1 = *reinterpret_cast<const bf16x8*>((const char*)Ks + KSWZ(32 + r32, cb));
    p0 = __builtin_amdgcn_mfma_f32_32x32x16_bf16(b0, qr[d0], p0, 0, 0, 0);
    p1 = __builtin_amdgcn_mfma_f32_32x32x16_bf16(b1, qr[d0], p1, 0, 0, 0); }
}
__device__ __forceinline__ int v_st(int k, int c) { const int kk = (k & ~0xC) | ((k & 4) << 1) | ((k & 8) >> 1); return ((kk >> 3) * 4 + (c >> 5)) * 512 + ((kk & 7) * 32 + (c & 31)) * 2; }
__device__ __forceinline__ int v_rd_base(int lane) { return ((lane & 3) << 3) | (((lane >> 2) & 3) << 6) | (((lane >> 4) & 1) << 5) | (((lane >> 5) & 1) << 8); }
constexpr int v_rd_off(int d0, int ks, int half) { return d0 * 512 + ks * 4096 + half * 2048; }
template <int OFF> __device__ __forceinline__ s16x4 tr_read(int vb) {
  s16x4 r; asm volatile("ds_read_b64_tr_b16 %0, %1 offset:%2" : "=&v"(r) : "v"(vb), "i"(OFF) : "memory"); return r;
}
template <int D0> __device__ __forceinline__ void pv_one(f32x16& od, int vb, bf16x8 pa0, bf16x8 pa1, bf16x8 pa2, bf16x8 pa3) {
  const s16x4 l0 = tr_read<v_rd_off(D0, 0, 0)>(vb), h0 = tr_read<v_rd_off(D0, 0, 1)>(vb), l1 = tr_read<v_rd_off(D0, 1, 0)>(vb), h1 = tr_read<v_rd_off(D0, 1, 1)>(vb);
  const s16x4 l2 = tr_read<v_rd_off(D0, 2, 0)>(vb), h2 = tr_read<v_rd_off(D0, 2, 1)>(vb), l3 = tr_read<v_rd_off(D0, 3, 0)>(vb), h3 = tr_read<v_rd_off(D0, 3, 1)>(vb);
  asm volatile("s_waitcnt lgkmcnt(0)" ::: "memory"); SBAR();
#define PK(L, H) (bf16x8){L[0], L[1], L[2], L[3], H[0], H[1], H[2], H[3]}
  od = __builtin_amdgcn_mfma_f32_32x32x16_bf16(pa0, PK(l0, h0), od, 0, 0, 0);
  od = __builtin_amdgcn_mfma_f32_32x32x16_bf16(pa1, PK(l1, h1), od, 0, 0, 0);
  od = __builtin_amdgcn_mfma_f32_32x32x16_bf16(pa2, PK(l2, h2), od, 0, 0, 0);
  od = __builtin_amdgcn_mfma_f32_32x32x16_bf16(pa3, PK(l3, h3), od, 0, 0, 0);
#undef PK
}
__device__ __forceinline__ void pv_d0(f32x16* o, int vb, bf16x8 pa0, bf16x8 pa1, bf16x8 pa2, bf16x8 pa3) {
  pv_one<0>(o[0], vb, pa0, pa1, pa2, pa3); pv_one<1>(o[1], vb, pa0, pa1, pa2, pa3); pv_one<2>(o[2], vb, pa0, pa1, pa2, pa3); pv_one<3>(o[3], vb, pa0, pa1, pa2, pa3);
}
__device__ __forceinline__ void attn_dense_body(const bf16_t* __restrict__ Qb, const bf16_t* __restrict__ Kh, const bf16_t* __restrict__ Vh,
                                                bf16_t* __restrict__ Ob, int seq, char* lds) {
  const int tid = threadIdx.x, wid = tid >> 6, lane = tid & 63, r32 = lane & 31, hi = lane >> 5;
  bf16_t* V_lds = (bf16_t*)lds; bf16_t* K_lds = (bf16_t*)(lds + 2 * SHM_V);
  float* ws = (float*)(lds + 2 * SHM_V + 2 * SHM_K) + wid * 64; float* li_l = ws; float* al_l = ws + 32;
  float m_reg = -1e30f, l_reg = 0; f32x16 o[4] = {}; bf16x8 qr[8];
  const bf16_t* Qw = Qb + (long)(wid * QBLK + r32) * LDQ + hi * 8;
#pragma unroll
  for (int d0 = 0; d0 < 8; ++d0) qr[d0] = *reinterpret_cast<const bf16x8*>(Qw + d0 * 16);
  const int sr = tid >> 4, sc = (tid & 15) * 8, vst0 = v_st(sr, sc), vst1 = v_st(32 + sr, sc);
  const int vb0 = (int)(uintptr_t)V_lds + v_rd_base(lane);
  struct { bf16x8 vs0, vs1, ks0, ks1; } sr_[2];
#define LD8(p) (*reinterpret_cast<const bf16x8*>(p))
#define SLOAD(i, k0) do { sr_[i].vs0 = LD8(&Vh[(long)((k0) + sr) * LDK + sc]); sr_[i].vs1 = LD8(&Vh[(long)((k0) + 32 + sr) * LDK + sc]); \
    sr_[i].ks0 = LD8(&Kh[(long)((k0) + sr) * LDK + sc]); sr_[i].ks1 = LD8(&Kh[(long)((k0) + 32 + sr) * LDK + sc]); } while (0)
#define SWRITE(b, i) do { *(bf16x8*)((char*)V_lds + (b) * SHM_V + vst0) = sr_[i].vs0;          \
    *(bf16x8*)((char*)V_lds + (b) * SHM_V + vst1) = sr_[i].vs1; int kc = sc * 2;               \
    *(bf16x8*)((char*)K_lds + (b) * SHM_K + KSWZ(sr, kc)) = sr_[i].ks0;                       \
    *(bf16x8*)((char*)K_lds + (b) * SHM_K + KSWZ(32 + sr, kc)) = sr_[i].ks1; } while (0)
#define SWAIT() asm volatile("s_waitcnt vmcnt(4)" ::: "memory")
#define RESC(a) do { if (__any((a) < 1.f)) { if (hi == 0) al_l[r32] = (a); asm volatile("s_waitcnt lgkmcnt(0)" ::: "memory"); \
    for (int d = 0; d < 4; ++d) for (int r = 0; r < 16; ++r) o[d][r] *= al_l[crow(r, hi)]; } } while (0)
  f32x16 pA0, pA1, pB0, pB1; float mnA, mnB, alA, alB; bf16x8 pa0, pa1, pa2, pa3; const int NT = seq / KVBLK;
  constexpr int SE = 0, SO = 1;
  SLOAD(SE, 0); asm volatile("s_waitcnt vmcnt(0)" ::: "memory"); SWRITE(0, SE); __syncthreads();
  qkt(pA0, pA1, K_lds, qr, r32, hi); partialSM(pA0, pA1, m_reg, mnA, alA);
  SLOAD(SO, KVBLK); if (2 < NT) SLOAD(SE, 2 * KVBLK);
  SWAIT(); SWRITE(1, SO); __syncthreads();
  for (int j = 1; j + 1 < NT; j += 2) {
    SBAR(); qkt(pB0, pB1, (bf16_t*)((char*)K_lds + SHM_K), qr, r32, hi);
    finishSM(pA0, pA1, alA, l_reg, pa0, pa1, pa2, pa3); SBAR();
    SLOAD(SO, (j + 2) * KVBLK); SBAR();
    pv_d0(o, vb0, pa0, pa1, pa2, pa3); partialSM(pB0, pB1, m_reg, mnB, alB);
    __syncthreads(); SWAIT(); SWRITE(0, SE);
    RESC(alB); __syncthreads();
    SBAR(); qkt(pA0, pA1, K_lds, qr, r32, hi);
    finishSM(pB0, pB1, alB, l_reg, pa0, pa1, pa2, pa3); SBAR();
    if (j + 3 < NT) SLOAD(SE, (j + 3) * KVBLK); SBAR();
    pv_d0(o, vb0 + (int)SHM_V, pa0, pa1, pa2, pa3); partialSM(pA0, pA1, m_reg, mnA, alA);
    __syncthreads(); SWAIT(); SWRITE(1, SO);
    RESC(alA); __syncthreads();
  }
  SBAR(); qkt(pB0, pB1, (bf16_t*)((char*)K_lds + SHM_K), qr, r32, hi);
  finishSM(pA0, pA1, alA, l_reg, pa0, pa1, pa2, pa3); SBAR();
  pv_d0(o, vb0, pa0, pa1, pa2, pa3); partialSM(pB0, pB1, m_reg, mnB, alB);
  __syncthreads(); RESC(alB);
  finishSM(pB0, pB1, alB, l_reg, pa0, pa1, pa2, pa3); SBAR();
  pv_d0(o, vb0 + (int)SHM_V, pa0, pa1, pa2, pa3);
  if (hi == 0) li_l[r32] = l_reg; asm volatile("s_waitcnt lgkmcnt(0)" ::: "memory");
  float rli[16];
#pragma unroll
  for (int r = 0; r < 16; ++r) rli[r] = __builtin_amdgcn_rcpf(li_l[crow(r, hi)]);
  bf16_t* Ow = Ob + (long)(wid * QBLK) * LDO;
#pragma unroll
  for (int r = 0; r < 16; ++r) { int orow = crow(r, hi);
    for (int d0 = 0; d0 < 4; ++d0) { const float v = o[d0][r] * rli[r]; Ow[(long)orow * LDO + d0 * 32 + r32] = (bf16_t)(cvtpk(v, v) & 0xffffu); } }
  __syncthreads();
#undef LD8
#undef SLOAD
#undef SWRITE
#undef SWAIT
#undef RESC
}
#undef SBAR
}

constexpr int N_PHASES = 13;
__global__ void __launch_bounds__(NWAVES * 64, 2) fwd_kernel(Args args) {
    extern __shared__ __attribute__((aligned(16))) unsigned char lds_raw[];
    LAS unsigned char* lds = (LAS unsigned char*)lds_raw;
    volatile LAS unsigned* MISC = (volatile LAS unsigned*)(lds + MISC_OFF);
    const int tid = threadIdx.x, wave = __builtin_amdgcn_readfirstlane(tid >> 6);
    const int G = gridDim.x, bx = blockIdx.x;
    const int gw = bx * NWAVES + wave, NGW = G * NWAVES;
#define lane lane_id()
    gu32* ctl = (gu32*)(args.ws + WS_CTL);
    for (int u = tid; u < (LDS_BYTES - LDSCTL_OFF) / 4; u += NWAVES * 64) ((LAS unsigned*)(lds + LDSCTL_OFF))[u] = 0u;
    __syncthreads();
    XcdBarrier bar; bar.bar = (unsigned*)(ctl + CW_BAR); bar.x = 0; bar.st = nullptr;
    if (!MK_PER_PHASE) bar = xcd_barrier_post((unsigned*)(ctl + CW_BAR), MISC + 8);
    const int lo = args.ph_lo, hi = args.ph_hi;
#define IN(k) (lo <= (k) && (k) < hi)
#define SEAM(k) do { if (IN(k) && IN((k) + 1)) xcd_barrier(bar); } while (0)
#define W_IN ((bf16_t*)(args.ws + WS_WIN))
#define W_OUT ((bf16_t*)(args.ws + WS_WOUT))
#define W_POOL ((bf16_t*)(args.ws + WS_WPOOL))
#define W_M1 ((bf16_t*)(args.ws + WS_WM1))
#define W_M2 ((bf16_t*)(args.ws + WS_WM2))
#define Hb ((bf16_t*)(args.ws + WS_H))
#define ZB ((bf16_t*)(args.ws + WS_ZB))
#define LFb ((float*)(args.ws + WS_LF))
#define A2 ((bf16_t*)(args.ws + WS_A2))
#define XA ((float*)(args.ws + WS_XA))
#define Ub ((bf16_t*)(args.ws + WS_U))
#define MOD ((const float*)(args.ws + WS_MOD))
#define ROWSS ((float*)(args.ws + WS_ROWSS))
#define SW ((float*)(args.ws + WS_SW))
#define IDLE_FIRST(nwg) (((nwg) % G) ? ((nwg) % G) : 0)

    if (IN(0)) {
        const int hG = G / 2;
        if (bx < hG) { for (int wi = bx; wi < 128; wi += hG) p0_ada_item(args, lds, wi, tid); }
        else bg_transposes(args, lds, R_IN, R_OUT, (bx - hG) * NWAVES + wave, (G - hG) * NWAVES, wave, lane);
    }
    SEAM(0);
    if (IN(1)) norm_rows_bf16(args, nullptr, args.in[10], 0, 0, Hb, gw, NGW, lane);
    SEAM(1);
    if (IN(2)) { pg8::Gemm g{Hb, W_IN, NTOK, IN_AB, 2048, 2048, 2048, 0, 0}; pg8::StaticOrder S; S.init(NTOK, IN_AB, G, bx);
        EpiIn E{ZB, LFb, args.in[17]}; pg8::gemm_phase<EpiIn>(lds, g, S, E);
        const int f = IDLE_FIRST(624); if (bx >= f) bg_transposes(args, lds, R_OUT, R_M2_0, (bx - f) * NWAVES + wave, (G - f) * NWAVES, wave, lane); }
    SEAM(2);
    if (IN(3)) {
        if (bx < 192) hgrn_task(args, lds, bx, tid);
        else { const int w = (bx - 192) * NWAVES + wave, nw = (G - 192) * NWAVES;
            for (int row = w; row < NTOK; row += nw) post_token(args, row, lane);
            for (int it = w; it < 1024; it += nw) cache_item(args, it, lane); }
    }
    SEAM(3);
    if (IN(4)) {
        if (bx < 192) { const int u = bx;
            const bf16_t *Q, *K, *V; bf16_t* O; int seq;
            if (u < 64) { const int b = u >> 5, h = (u >> 2) & 7, qb = u & 3; const size_t row0 = NTOK_P + b * SEQ_S + qb * 256;
                Q = (const bf16_t*)(args.ws + WS_QN) + row0 * 1024 + h * 128; O = A2 + row0 * DM + h * 128;
                K = (const bf16_t*)(args.ws + WS_KS) + (size_t)(b * 2 + (h >> 2)) * 1280 * 128; V = (const bf16_t*)(args.ws + WS_VS) + (size_t)(b * 2 + (h >> 2)) * 1280 * 128; seq = 1280; }
            else { const int v = u - 64, b = v >> 3, h = v & 7; const size_t row0 = b * 256;
                Q = (const bf16_t*)(args.ws + WS_QN) + row0 * 1024 + h * 128; O = A2 + row0 * DM + h * 128;
                K = (const bf16_t*)(args.ws + WS_KP) + (size_t)(b * 2 + (h >> 2)) * 256 * 128; V = (const bf16_t*)(args.ws + WS_VP) + (size_t)(b * 2 + (h >> 2)) * 256 * 128; seq = 256; }
            att::attn_dense_body(Q, K, V, O, seq, (char*)lds_raw);
        }
        if (bx >= 192) { for (int t = bx - 192; t < 64; t += G - 192) hgfix_task(args, lds, t, tid);
            for (int row = (bx - 192) * NWAVES + wave; row < NTOK_P; row += (G - 192) * NWAVES) combine_token(args, row, lane); }
        else if (bx >= 64) bg_transposes(args, lds, R_M2_0, R_POOL, (bx - 64) * NWAVES + wave, 128 * NWAVES, wave, lane);
    }
    SEAM(4);
    if (IN(5)) { pg8::Gemm g{A2, W_OUT, NTOK, DM, 2048, 2048, 2048, 0, 0}; pg8::StaticOrder S; S.init(NTOK, DM, G, bx);
        EpiRes E{args.in[0], args.in[1], XA, MOD + 2 * 2048, nullptr, Hb, args.in[11], MOD + 4 * 2048, ROWSS}; pg8::gemm_phase<EpiRes>(lds, g, S, E);
        const int f = IDLE_FIRST(192); if (bx >= f) for (int wi = 128 + (bx - f); wi < 256; wi += G - f) p0_ada_item(args, lds, wi, tid); }
    SEAM(5);
    if (IN(6)) { pg8::Gemm g{Hb, W_M1, NTOK, DFF, 2048, 2048, 2048, 0, 0}; pg8::StaticOrder S; S.init(NTOK, DFF, G, bx);
        EpiRelu2 E{Ub, ROWSS, SW}; pg8::gemm_phase<EpiRelu2>(lds, g, S, E); }
    SEAM(6);
    if (IN(7)) { pg8::Gemm g{Ub, W_M2, NTOK, DM, DFF, DFF, DFF, 0, 0}; pg8::StaticOrder S; S.init(NTOK, DM, G, bx);
        EpiRes E{XA, XA + (size_t)NTOK_P * DM, XA, MOD + 5 * 2048, nullptr, nullptr, nullptr, nullptr, ROWSS + NTOK}; pg8::gemm_phase<EpiRes>(lds, g, S, E);
        const int f = IDLE_FIRST(192); if (bx >= f) bg_transposes(args, lds, R_POOL, R_END, (bx - f) * NWAVES + wave, (G - f) * NWAVES, wave, lane); }
    SEAM(7);
    if (IN(8)) pool_phase(args, lds, XA, ROWSS + NTOK, Hb, bx, G, tid);
    SEAM(8);
    if (IN(9)) { pg8::Gemm g{Hb, W_POOL, NTOK, DM, 512, 2048, 512, 1, 512}; pg8::StaticOrder S; S.init(NTOK, DM, G, bx);
        EpiRes E{XA, XA + (size_t)NTOK_P * DM, XA, MOD + NMODC + 2 * 2048, args.in[19], A2, args.in[11] + 2048, MOD + NMODC + 4 * 2048, ROWSS + 2 * NTOK}; pg8::gemm_phase<EpiRes>(lds, g, S, E); }
    SEAM(9);
    if (IN(10)) { pg8::Gemm g{A2, W_M1 + (size_t)DFF * 2048, NTOK, DFF, 2048, 2048, 2048, 0, 0}; pg8::StaticOrder S; S.init(NTOK, DFF, G, bx);
        EpiRelu2 E{Ub, ROWSS + 2 * NTOK, SW + 3 * DFF}; pg8::gemm_phase<EpiRelu2>(lds, g, S, E); }
    SEAM(10);
    if (IN(11)) { pg8::Gemm g{Ub, W_M2 + (size_t)2048 * DFF, NTOK, DM, DFF, DFF, DFF, 0, 0}; pg8::StaticOrder S; S.init(NTOK, DM, G, bx);
        EpiRes E{XA, XA + (size_t)NTOK_P * DM, XA, MOD + NMODC + 5 * 2048, nullptr, nullptr, nullptr, nullptr, ROWSS + 3 * NTOK}; pg8::gemm_phase<EpiRes>(lds, g, S, E); }
    SEAM(11);
    if (IN(12)) final_rows(XA, ROWSS + 3 * NTOK, args.in[22], args.out, gw, NGW, lane);
#undef IN
#undef SEAM
#undef IDLE_FIRST
#undef lane
#undef W_IN
#undef W_OUT
#undef W_POOL
#undef W_M1
#undef W_M2
#undef Hb
#undef ZB
#undef LFb
#undef A2
#undef XA
#undef Ub
#undef MOD
#undef ROWSS
#undef SW
}

extern "C" void kernel_launch(void* const* d_in, const int* in_sizes, int n_in, void* d_out, int out_size, void* d_ws, size_t ws_size, hipStream_t stream) {
    static int grid = 0;
    if (grid == 0) {
        if (n_in != 23 || out_size != 18874368 || ws_size < WS_END) { fprintf(stderr, "kernel_launch: unexpected shapes (n_in %d out %d ws %zu)\n", n_in, out_size, ws_size); grid = -1; return; }
        int dev = 0, cus = 0;
        if (hipGetDevice(&dev) != hipSuccess || hipDeviceGetAttribute(&cus, hipDeviceAttributeMultiprocessorCount, dev) != hipSuccess) { grid = -1; return; }
        if (hipFuncSetAttribute((const void*)fwd_kernel, hipFuncAttributeMaxDynamicSharedMemorySize, LDS_BYTES) != hipSuccess) { fprintf(stderr, "kernel_launch: hipFuncSetAttribute failed\n"); grid = -1; return; }
        int per_cu = 0;
        if (hipOccupancyMaxActiveBlocksPerMultiprocessor(&per_cu, (const void*)fwd_kernel, NWAVES * 64, LDS_BYTES) != hipSuccess || per_cu < 1) fprintf(stderr, "kernel_launch: occupancy query says %d\n", per_cu);
        (void)hipGetLastError();
        if (cus != 256) { fprintf(stderr, "kernel_launch: built for a 256-CU device, found %d CUs\n", cus); grid = -1; return; }
        grid = cus;
    }
    if (grid < 0) return;
    (void)hipMemsetAsync((char*)d_ws + WS_CTL, 0, CTL_ZERO_BYTES, stream);
    Args a{};
    for (int i = 0; i < 23; ++i) a.in[i] = (const float*)d_in[i];
    a.out = (float*)d_out; a.ws = (unsigned char*)d_ws;
#if MK_PER_PHASE
    for (int p = 0; p < N_PHASES; ++p) { a.ph_lo = p; a.ph_hi = p + 1; hipLaunchKernelGGL(fwd_kernel, dim3(grid), dim3(NWAVES * 64), LDS_BYTES, stream, a);
        if (p == REP_PHASE) hipLaunchKernelGGL(fwd_kernel, dim3(grid), dim3(NWAVES * 64), LDS_BYTES, stream, a); }
#else
    a.ph_lo = 0; a.ph_hi = N_PHASES;
    hipLaunchKernelGGL(fwd_kernel, dim3(grid), dim3(NWAVES * 64), LDS_BYTES, stream, a);
#endif
}
```

```cpp
#include <hip/hip_runtime.h>
#include <hip/hip_bf16.h>
#include <cstdio>
#include <cstdint>

#ifndef MK_PER_PHASE
#define MK_PER_PHASE 0
#endif

#ifndef REP_PHASE
#define REP_PHASE -1
#endif
constexpr int DM = 2048, NTOK_P = 4096, NTOK_S = 2048, NTOK = 6144, SEQ_P = 256, SEQ_S = 1024, NB_P = 16, NB_S = 2, PAST = 256;
constexpr int IN_AB = 6656, DFF = 8192, NMODC = 12288;
constexpr int C_Q = 0, C_K = 1024, C_V = 1280, C_HQ = 1536, C_ZF = 2560, C_ZB = 3584, C_HI = 4608, C_HG = 5632;
constexpr float EPS = 1e-6f;

#define GAS __attribute__((address_space(1)))
#define LAS __attribute__((address_space(3)))
typedef unsigned short bf16_t;
typedef short bf16x8 __attribute__((ext_vector_type(8)));
typedef short s16x4 __attribute__((ext_vector_type(4)));
typedef float f32x4 __attribute__((ext_vector_type(4)));
typedef float f32x2 __attribute__((ext_vector_type(2)));
typedef float f32x16 __attribute__((ext_vector_type(16)));
typedef unsigned u32x4 __attribute__((ext_vector_type(4)));
typedef unsigned u32x2 __attribute__((ext_vector_type(2)));
typedef __bf16 bf16x2_t __attribute__((ext_vector_type(2)));
typedef GAS unsigned gu32;

__device__ __forceinline__ unsigned cvtpk(float lo, float hi) { f32x2 v = {lo, hi}; bf16x2_t b = __builtin_convertvector(v, bf16x2_t); return __builtin_bit_cast(unsigned, b); }
__device__ __forceinline__ float bf2f(unsigned short u) { return __uint_as_float(((unsigned)u) << 16); }
__device__ __forceinline__ float bflo(unsigned u) { return __uint_as_float(u << 16); }
__device__ __forceinline__ float bfhi(unsigned u) { return __uint_as_float(u & 0xffff0000u); }
__device__ __forceinline__ float siluf(float x) { return x * __builtin_amdgcn_rcpf(1.f + __expf(-x)); }
__device__ __forceinline__ int lane_id() { int l; asm volatile("v_mbcnt_lo_u32_b32 %0, -1, 0\n\tv_mbcnt_hi_u32_b32 %0, -1, %0" : "=v"(l)); return l; }
__device__ __forceinline__ float wave_sum(float v) {
#pragma unroll
    for (int o = 1; o < 64; o <<= 1) v += __shfl_xor(v, o);
    return v;
}
__device__ __forceinline__ float half_sum(float v) {
#pragma unroll
    for (int o = 1; o < 32; o <<= 1) v += __shfl_xor(v, o);
    return v;
}

namespace pg8 {
#define PG8_LAS __attribute__((address_space(3)))
constexpr int BM = 256, BK = 64, HALF = 128, HTB = HALF * BK * 2, STAGE_BYTES = 8 * HTB, NXCD = 8, WGM = 8;
__host__ __device__ __forceinline__ int lds_byte(int r, int c) { const int st = (r >> 4) * 2 + (c >> 5), rr = r & 15, cc = c & 31, ob = rr * 64 + cc * 2; return st * 1024 + (ob ^ (((ob >> 9) & 1) << 5)); }
__host__ __device__ __forceinline__ void stage_rc(int b, int& R, int& C) { const int st = b / 1024, sb = b % 1024, swz = sb ^ (((sb >> 9) & 1) << 5); R = (st >> 1) * 16 + swz / 64; C = (st & 1) * 32 + (swz % 64) / 2; }
__host__ __device__ __forceinline__ int perm32(int rho) { const int n = rho >> 4, i = rho & 15; return 8 * (i >> 2) + 4 * n + (i & 3); }

struct Unit { int pm, pn, kt0, nkt, role, pidx; };
struct Gemm { const bf16_t* A; const bf16_t* Bt; int M, N, K, lda, ldb, apn_shift, apn_mul; };
struct PartCtx { float* part; unsigned* flags; unsigned epoch; };

struct StaticOrder {
    int nM, nN, nwg, G, c, nkt;
    __host__ __device__ void init(int M, int N, int K, int G_, int c_) { nM = M / BM; nN = N / BM; nwg = nM * nN; G = G_; c = c_; nkt = K / BK; }
    __host__ __device__ void unit_of(int L, Unit& u) const {
        int wgid = L; { const int q = nwg / NXCD, r = nwg % NXCD, xcd = wgid % NXCD, off = wgid / NXCD; wgid = (xcd < r ? xcd * (q + 1) : r * (q + 1) + (xcd - r) * q) + off; }
        const int nig = WGM * nN, gid = wgid / nig, fm = gid * WGM, gsz = (nM - fm) < WGM ? (nM - fm) : WGM;
        u.pm = fm + ((wgid % nig) % gsz); u.pn = (wgid % nig) / gsz;
    }
    __host__ __device__ bool next(int i, Unit& u) const {
        const long L = (long)i * G + c; if (L >= nwg) return false;
        unit_of((int)L, u); u.kt0 = 0; u.nkt = nkt; u.role = 0; u.pidx = 0; return true;
    }
};
struct SplitOrder {
    StaticOrder S;
    __host__ __device__ void init(int M, int N, int K, int G_, int c_) { S.init(M, N, K, G_, c_); }
    __host__ __device__ bool next(int i, Unit& u) const {
        const int q = S.nkt / 4;
        if (S.c < S.nwg) { if (i > 0) return false; S.unit_of(S.c, u); u.kt0 = 0; u.nkt = 3 * q; u.role = 1; u.pidx = S.c; return true; }
        if (i >= 3) return false;
        const int L = 3 * (S.c - S.nwg) + i; if (L >= S.nwg) return false;
        S.unit_of(L, u); u.kt0 = 3 * q; u.nkt = q; u.role = 2; u.pidx = L; return true;
    }
};
struct TailSplitOrder {
    StaticOrder S;
    __host__ __device__ void init(int M, int N, int K, int G_, int c_) { S.init(M, N, K, G_, c_); }
    __host__ __device__ bool next(int i, Unit& u) const {
        if (i < 2) return S.next(i, u);
        if (i > 2) return false;
        const int r = S.nwg - 2 * S.G, p = S.c >> 1; if (p >= r) return false;
        S.unit_of(2 * S.G + p, u); const int h = S.nkt / 2;
        if (S.c & 1) { u.kt0 = h; u.nkt = h; u.role = 2; } else { u.kt0 = 0; u.nkt = h; u.role = 1; }
        u.pidx = p; return true;
    }
};

template <class Epi, class Sched, bool ALIGN_EPI = true>
__device__ __forceinline__ void gemm_phase(PG8_LAS unsigned char* lds, const Gemm g, const Sched& S, const Epi& E, const PartCtx pc = PartCtx{nullptr, nullptr, 0u}) {
    const int tid = threadIdx.x, wid = __builtin_amdgcn_readfirstlane(tid >> 6), lane = tid & 63, wr = wid >> 2, wc = wid & 3, fr = lane & 15, fq = lane >> 4;
    unsigned voffA[2], voffB[2];
#pragma unroll
    for (int i = 0; i < 2; ++i) { int R, C; stage_rc(tid * 16 + i * 8192, R, C); const int Rb = Epi::PERM ? ((R & ~31) + perm32(R & 31)) : R;
        voffA[i] = (unsigned)(R * g.lda + C) * 2u; voffB[i] = (unsigned)(Rb * g.ldb + C) * 2u; }
    const size_t kstep = (size_t)(BK * 2);
    const size_t hstepA = (size_t)HALF * g.lda * 2, hstepB = (size_t)HALF * g.ldb * 2;
    const size_t tstepA = 2 * hstepA, tstepB = 2 * hstepB;
    const unsigned ldsw = (unsigned)wid * 1024u;
    const int aoff = lds_byte(wr * 64 + fr, fq * 8), boff = lds_byte(wc * 32 + fr, fq * 8);
#define PG8_SA(b, h) (((b) * 2 + (h)) * HTB)
#define PG8_SB(b, h) ((4 + (b) * 2 + (h)) * HTB)
#define PG8_STAGE(bufoff, gbase, voff) do { _Pragma("unroll") for (int _i = 0; _i < 2; ++_i) \
        __builtin_amdgcn_global_load_lds((const unsigned*)((const char*)(gbase) + (voff)[_i]), (PG8_LAS unsigned*)(lds + (bufoff) + ldsw + _i * 8192), 16, 0, 0); } while (0)
#define PG8_LDA(dst, b, h) do { _Pragma("unroll") for (int m = 0; m < 4; ++m) _Pragma("unroll") for (int k = 0; k < 2; ++k) dst[m][k] = *(const PG8_LAS bf16x8*)(lds + PG8_SA(b, h) + aoff + m * 2048 + k * 1024); } while (0)
#define PG8_LDB(dst, b, h) do { _Pragma("unroll") for (int n = 0; n < 2; ++n) _Pragma("unroll") for (int k = 0; k < 2; ++k) dst[n][k] = *(const PG8_LAS bf16x8*)(lds + PG8_SB(b, h) + boff + n * 2048 + k * 1024); } while (0)
#define PG8_MMA(ai, bj, At, Bt) do { __builtin_amdgcn_s_setprio(1); _Pragma("unroll") for (int m = 0; m < 4; ++m) _Pragma("unroll") for (int n = 0; n < 2; ++n) _Pragma("unroll") for (int k = 0; k < 2; ++k) \
        acc[ai][bj][m][n] = __builtin_amdgcn_mfma_f32_16x16x32_bf16(Bt[n][k], At[m][k], acc[ai][bj][m][n], 0, 0, 0); __builtin_amdgcn_s_setprio(0); } while (0)
#define PG8_WAIT_V(n) asm volatile("s_waitcnt vmcnt(" #n ")" ::: "memory")
#define PG8_WAIT_L(n) asm volatile("s_waitcnt lgkmcnt(" #n ")" ::: "memory")
#define PG8_BAR __builtin_amdgcn_s_barrier()
#define PG8_SCHED __builtin_amdgcn_sched_barrier(0)
#define PG8_AOFF(u) ((size_t)(((u).pn >> g.apn_shift) * g.apn_mul) * 2)
    Unit cur, nxt; int ui = 0;
    if (!S.next(0, cur)) return;
    f32x4 acc[2][2][4][2];
#pragma unroll
    for (int a = 0; a < 2; ++a)
#pragma unroll
        for (int b = 0; b < 2; ++b)
#pragma unroll
            for (int m = 0; m < 4; ++m)
#pragma unroll
                for (int n = 0; n < 2; ++n) acc[a][b][m][n] = (f32x4){0.f, 0.f, 0.f, 0.f};
    bf16x8 At[4][2], B0[2][2], B1[2][2];
    const char* cA = (const char*)g.A + (size_t)cur.pm * tstepA + PG8_AOFF(cur) + (size_t)cur.kt0 * kstep; const char* cB = (const char*)g.Bt + (size_t)cur.pn * tstepB + (size_t)cur.kt0 * kstep;
    {
        PG8_STAGE(PG8_SB(0, 0), cB, voffB); PG8_STAGE(PG8_SB(0, 1), cB + hstepB, voffB); PG8_STAGE(PG8_SA(0, 0), cA, voffA); PG8_STAGE(PG8_SA(0, 1), cA + hstepA, voffA);
        if (wr == 1) PG8_BAR;
        PG8_WAIT_V(2); PG8_BAR;
        PG8_STAGE(PG8_SB(1, 0), cB + kstep, voffB); PG8_STAGE(PG8_SA(1, 0), cA + kstep, voffA); PG8_STAGE(PG8_SB(1, 1), cB + hstepB + kstep, voffB);
        PG8_WAIT_V(6); PG8_BAR;
    }
    for (;;) {
        const bool has_next = S.next(ui + 1, nxt);
        const char* nA = has_next ? (const char*)g.A + (size_t)nxt.pm * tstepA + PG8_AOFF(nxt) + (size_t)nxt.kt0 * kstep : cA; const char* nB = has_next ? (const char*)g.Bt + (size_t)nxt.pn * tstepB + (size_t)nxt.kt0 * kstep : cB;
        const int nt = cur.nkt;
        for (int t = 0; t < nt; t += 2) {
            const bool last = (t == nt - 2);
            const char* a1 = cA + (size_t)(t + 1) * kstep;
            const char* a2 = last ? nA : cA + (size_t)(t + 2) * kstep; const char* b2 = last ? nB : cB + (size_t)(t + 2) * kstep;
            const char* a3 = a2 + kstep; const char* b3 = b2 + kstep;
            PG8_LDB(B0, 0, 0); PG8_LDB(B1, 0, 1); PG8_SCHED; PG8_LDA(At, 0, 0); PG8_STAGE(PG8_SA(1, 1), a1 + hstepA, voffA);
            PG8_WAIT_V(8); PG8_WAIT_L(0); PG8_BAR; PG8_MMA(0, 0, At, B0); PG8_MMA(0, 1, At, B1); PG8_BAR; PG8_SCHED;
            PG8_LDA(At, 0, 1); PG8_STAGE(PG8_SB(0, 0), b2, voffB); PG8_STAGE(PG8_SB(0, 1), b2 + hstepB, voffB); PG8_STAGE(PG8_SA(0, 0), a2, voffA);
            PG8_WAIT_V(8); PG8_WAIT_L(0); PG8_BAR; PG8_MMA(1, 0, At, B0); PG8_MMA(1, 1, At, B1); PG8_BAR; PG8_SCHED;
            PG8_LDB(B0, 1, 0); PG8_LDB(B1, 1, 1); PG8_SCHED; PG8_LDA(At, 1, 0); PG8_STAGE(PG8_SA(0, 1), a2 + hstepA, voffA);
            PG8_WAIT_V(8); PG8_WAIT_L(0); PG8_BAR; PG8_MMA(0, 0, At, B0); PG8_MMA(0, 1, At, B1); PG8_BAR; PG8_SCHED;
            PG8_LDA(At, 1, 1); PG8_STAGE(PG8_SB(1, 0), b3, voffB); PG8_STAGE(PG8_SB(1, 1), b3 + hstepB, voffB); PG8_STAGE(PG8_SA(1, 0), a3, voffA);
            PG8_WAIT_V(8); PG8_WAIT_L(0); PG8_BAR; PG8_MMA(1, 0, At, B0); PG8_MMA(1, 1, At, B1); PG8_BAR; PG8_SCHED;
        }
        if constexpr (ALIGN_EPI) { if (wr == 0) PG8_BAR; }
        if (cur.role == 2) {
            f32x4* ps = (f32x4*)(pc.part + (size_t)cur.pidx * 65536) + wid * 2048 + lane;
#pragma unroll
            for (int a = 0; a < 2; ++a)
#pragma unroll
                for (int b = 0; b < 2; ++b)
#pragma unroll
                    for (int m = 0; m < 4; ++m)
#pragma unroll
                        for (int n = 0; n < 2; ++n) ps[(((a * 2 + b) * 4 + m) * 2 + n) * 64] = acc[a][b][m][n];
            asm volatile("s_waitcnt vmcnt(0)" ::: "memory"); PG8_BAR;
            if (tid == 0) { __builtin_amdgcn_fence(__ATOMIC_RELEASE, "agent"); asm volatile("s_waitcnt vmcnt(0)" ::: "memory");
                __hip_atomic_store(pc.flags + 16 * cur.pidx, pc.epoch, __ATOMIC_RELAXED, __HIP_MEMORY_SCOPE_AGENT); }
        } else {
            if (cur.role == 1) {
                if (wid == 0) { unsigned sp = 0; while (__hip_atomic_load(pc.flags + 16 * cur.pidx, __ATOMIC_RELAXED, __HIP_MEMORY_SCOPE_AGENT) != pc.epoch) { __builtin_amdgcn_s_sleep(2); if (++sp > (1u << 22)) break; }
                    __builtin_amdgcn_fence(__ATOMIC_ACQUIRE, "agent"); asm volatile("s_waitcnt vmcnt(0)" ::: "memory"); }
                PG8_BAR; asm volatile("" ::: "memory");
                const f32x4* ps = (const f32x4*)(pc.part + (size_t)cur.pidx * 65536) + wid * 2048 + lane;
#pragma unroll
                for (int a = 0; a < 2; ++a)
#pragma unroll
                    for (int b = 0; b < 2; ++b)
#pragma unroll
                        for (int m = 0; m < 4; ++m)
#pragma unroll
                            for (int n = 0; n < 2; ++n) acc[a][b][m][n] += ps[(((a * 2 + b) * 4 + m) * 2 + n) * 64];
            }
            E(acc, cur, wr, wc, fr, fq);
        }
        if (!has_next) break;
#pragma unroll
        for (int a = 0; a < 2; ++a)
#pragma unroll
            for (int b = 0; b < 2; ++b)
#pragma unroll
                for (int m = 0; m < 4; ++m)
#pragma unroll
                    for (int n = 0; n < 2; ++n) acc[a][b][m][n] = (f32x4){0.f, 0.f, 0.f, 0.f};
        cur = nxt; cA = nA; cB = nB; ++ui;
        if constexpr (ALIGN_EPI) { if (wr == 1) PG8_BAR; }
    }
    PG8_WAIT_V(0);
    if constexpr (!ALIGN_EPI) { if (wr == 0) PG8_BAR; }
    PG8_BAR;
#undef PG8_SA
#undef PG8_SB
#undef PG8_STAGE
#undef PG8_LDA
#undef PG8_LDB
#undef PG8_MMA
#undef PG8_WAIT_V
#undef PG8_WAIT_L
#undef PG8_BAR
#undef PG8_SCHED
#undef PG8_AOFF
}
}

constexpr size_t MiB = 1u << 20;
constexpr size_t WS_CTL = 0, CTL_ZERO_BYTES = 384 * 1024;
constexpr size_t WS_ROWSS = 64 * 1024;
constexpr size_t WS_SW = 160 * 1024;
constexpr size_t WS_MOD = 1 * MiB;
constexpr size_t WS_WIN = 2 * MiB;
constexpr size_t WS_WOUT = 28 * MiB;
constexpr size_t WS_WPOOL = 36 * MiB;
constexpr size_t WS_WM1 = 38 * MiB;
constexpr size_t WS_WM2 = 102 * MiB;
constexpr size_t WS_H = 166 * MiB;
constexpr size_t WS_ZB = 190 * MiB;
constexpr size_t WS_LF = 268 * MiB;
constexpr size_t WS_QN = 316 * MiB;
constexpr size_t WS_KP = 328 * MiB;
constexpr size_t WS_VP = 330 * MiB;
constexpr size_t WS_KS = 332 * MiB;
constexpr size_t WS_VS = 334 * MiB;
constexpr size_t WS_OF = 336 * MiB;
constexpr size_t WS_OB = 360 * MiB;
constexpr size_t WS_A2 = 384 * MiB;
constexpr size_t WS_XA = 408 * MiB;
constexpr size_t WS_U = 456 * MiB;
constexpr size_t WS_SEND = 552 * MiB;
constexpr size_t WS_LSEG = 560 * MiB;
constexpr size_t WS_PART = 562 * MiB;
constexpr size_t WS_END = 610 * MiB;
constexpr int CW_BAR = 1024;
constexpr int CW_PFLAG = 8192;

constexpr int RING_BYTES = 131072, LDSCTL_OFF = RING_BYTES, MISC_OFF = LDSCTL_OFF + 320, LDS_BYTES = 147456;
constexpr int NWAVES = 8;

#define RLX_AGENT __ATOMIC_RELAXED, __HIP_MEMORY_SCOPE_AGENT
#define LDS_WAIT() asm volatile("s_waitcnt lgkmcnt(0)" ::: "memory")
#define VM_WAIT() asm volatile("s_waitcnt vmcnt(0)" ::: "memory")

#define XB_TMO      128
#define XB_XCNT(j)  (256  + 64 * (j))
#define XB_XSUB(j)  (1280 + 64 * (j))
#define XB_XGEN(j)  (2304 + 64 * (j))
#define XB_TOP      3328
#define XB_TOPGEN   3392
#define XCD_BAR_WORDS 3456
#define XB_SPIN_CAP (1u << 18)
__device__ __forceinline__ unsigned xb_ld(unsigned* p)              { return __hip_atomic_load(p, __ATOMIC_RELAXED, __HIP_MEMORY_SCOPE_AGENT); }
__device__ __forceinline__ unsigned xb_add(unsigned* p, unsigned v) { return __hip_atomic_fetch_add(p, v, __ATOMIC_RELAXED, __HIP_MEMORY_SCOPE_AGENT); }
__device__ __forceinline__ unsigned xb_xcc_id() { return (unsigned)__builtin_amdgcn_s_getreg((3 << 11) | 20) & 0xFu; }
#define XB_SPIN(cond, bar) do { unsigned _sp = 0; while (cond) { __builtin_amdgcn_s_sleep(1); \
    if ((++_sp & 255u) == 0u) { if (xb_ld(&(bar)[XB_TMO])) break; if (_sp > XB_SPIN_CAP) { atomicAdd(&(bar)[XB_TMO], 1u); break; } } } } while (0)
struct XcdBarrier { unsigned* bar; unsigned x; volatile LAS unsigned* st; };
__device__ __forceinline__ XcdBarrier xcd_barrier_post(unsigned* bar, volatile LAS unsigned* st) {
    XcdBarrier b; b.bar = bar; b.x = xb_xcc_id(); b.st = st;
    if (threadIdx.x == 0) (void)xb_add(&bar[XB_XCNT(b.x)], 1u);
    return b;
}
__device__ __forceinline__ void xcd_barrier_complete(unsigned* bar, unsigned x, unsigned& nloc, unsigned& nx) {
    const unsigned G = gridDim.x * gridDim.y * gridDim.z;
    unsigned sum, cnt, mine, sp = 0u;
    for (;;) {
        sum = 0u; cnt = 0u; mine = 0u;
#pragma unroll
        for (unsigned j = 0; j < 16; ++j) { const unsigned c = xb_ld(&bar[XB_XCNT(j)]); sum += c; cnt += (c > 0u) ? 1u : 0u; mine = (j == x) ? c : mine; }
        if (sum == G) break;
        __builtin_amdgcn_s_sleep(1);
        if ((++sp & 255u) == 0u) { if (xb_ld(&bar[XB_TMO])) break; if (sp > XB_SPIN_CAP) { atomicAdd(&bar[XB_TMO], 1u); break; } }
    }
    nloc = mine > 0u ? mine : 1u; nx = cnt > 0u ? cnt : 1u;
}
__device__ __forceinline__ void xcd_barrier(const XcdBarrier& b) {
    asm volatile("s_waitcnt vmcnt(0)" ::: "memory");
    __syncthreads();
    if (threadIdx.x == 0) {
        unsigned* bar = b.bar;
        __builtin_amdgcn_s_waitcnt(0);
        unsigned nloc = b.st[0], nx = b.st[1];
        if (nloc == 0u) { xcd_barrier_complete(bar, b.x, nloc, nx); b.st[0] = nloc; b.st[1] = nx; }
        const unsigned old = xb_add(&bar[XB_XSUB(b.x)], 1u);
        const unsigned gen = old / nloc;
        if (old + 1u == (gen + 1u) * nloc) {
            __builtin_amdgcn_fence(__ATOMIC_RELEASE, "agent");
            asm volatile("s_waitcnt vmcnt(0)" ::: "memory");
            const unsigned og = xb_add(&bar[XB_TOP], 1u);
            const unsigned tg = og / nx;
            if (og + 1u == (tg + 1u) * nx) xb_add(&bar[XB_TOPGEN], 1u);
            else XB_SPIN(xb_ld(&bar[XB_TOPGEN]) == tg, bar);
            __builtin_amdgcn_fence(__ATOMIC_ACQUIRE, "agent");
            xb_add(&bar[XB_XGEN(b.x)], 1u);
            asm volatile("s_waitcnt vmcnt(0)" ::: "memory");
        } else {
            XB_SPIN(xb_ld(&bar[XB_XGEN(b.x)]) == gen, bar);
            __builtin_amdgcn_fence(__ATOMIC_ACQUIRE, "agent");
            asm volatile("s_waitcnt vmcnt(0)" ::: "memory");
        }
    }
    __syncthreads();
}

struct Args { const float* in[23]; float* out; unsigned char* ws; int ph_lo, ph_hi; };

__device__ __forceinline__ int cvec_of_row(int row) { return row < NTOK_P ? 0 : 1 + ((row - NTOK_P) >> 10); }
__device__ __forceinline__ const float* xin_row(const Args& a, int row) { return row < NTOK_P ? a.in[0] + (size_t)row * DM : a.in[1] + (size_t)(row - NTOK_P) * DM; }

struct EpiIn {
    static constexpr bool PERM = true;
    bf16_t* ZB; float* LF; const float* lb_raw;
    __device__ __forceinline__ void operator()(const f32x4 (&acc)[2][2][4][2], const pg8::Unit& u, int wr, int wc, int fr, int fq) const {
        const int row0 = u.pm * 256 + wr * 64 + fr, colt = u.pn * 256, cl = wc * 32 + 8 * fq;
        if (colt >= C_ZF && colt < C_HI) {
#pragma unroll
            for (int bj = 0; bj < 2; ++bj) {
                const int c2 = colt + bj * 128 + cl - C_ZF, dir = c2 >> 10, ch = c2 & 1023;
                float lb[8];
#pragma unroll
                for (int e = 0; e < 8; ++e) { const float x0 = lb_raw[dir * 3072 + ch + e], x1 = lb_raw[dir * 3072 + 1024 + ch + e], x2 = lb_raw[dir * 3072 + 2048 + ch + e];
                    lb[e] = 1.f / (1.f + __expf(x1 - x0) + __expf(x2 - x0)); }
#pragma unroll
                for (int ai = 0; ai < 2; ++ai)
#pragma unroll
                    for (int m = 0; m < 4; ++m) {
                        float* dst = LF + (size_t)(row0 + ai * 128 + m * 16) * 2048 + c2;
                        f32x4 o[2];
#pragma unroll
                        for (int n = 0; n < 2; ++n)
#pragma unroll
                            for (int e = 0; e < 4; ++e) { const float z = acc[ai][bj][m][n][e], sg = __builtin_amdgcn_rcpf(1.f + __expf(-z)), l = lb[n * 4 + e]; o[n][e] = __logf(l + (1.f - l) * sg); }
                        *(f32x4*)dst = o[0]; *(f32x4*)(dst + 4) = o[1];
                    }
            }
        } else {
            const bool act = (colt >= C_HQ && colt < C_ZF) || colt >= C_HG;
#pragma unroll
            for (int ai = 0; ai < 2; ++ai)
#pragma unroll
                for (int m = 0; m < 4; ++m) {
                    bf16_t* rowp = ZB + (size_t)(row0 + ai * 128 + m * 16) * IN_AB + colt + cl;
#pragma unroll
                    for (int bj = 0; bj < 2; ++bj) { f32x4 v0 = acc[ai][bj][m][0], v1 = acc[ai][bj][m][1];
                        if (act) {
#pragma unroll
                            for (int e = 0; e < 4; ++e) { v0[e] = siluf(v0[e]); v1[e] = siluf(v1[e]); } }
                        u32x4 w; w.x = cvtpk(v0[0], v0[1]); w.y = cvtpk(v0[2], v0[3]); w.z = cvtpk(v1[0], v1[1]); w.w = cvtpk(v1[2], v1[3]);
                        *(u32x4*)(rowp + bj * 128) = w; }
                }
        }
    }
};
struct EpiRes {
    static constexpr bool PERM = false;
    const float* baseP; const float* baseS; float* out; const float* gate; const float* pscale;
    bf16_t* XG; const float* ngain; const float* nsc;
    float* rowss;
    __device__ __forceinline__ void operator()(const f32x4 (&acc)[2][2][4][2], const pg8::Unit& u, int wr, int wc, int fr, int fq) const {
        const int col0 = u.pn * 256 + wc * 32 + 4 * fq;
        const int cv = u.pm < 16 ? 0 : 1 + ((u.pm - 16) >> 2);
        const float* gp = gate + (size_t)cv * 2 * NMODC;
        const float* bp = u.pm < 16 ? baseP + (size_t)u.pm * 256 * DM : baseS + (size_t)(u.pm - 16) * 256 * DM;
        float* op = out + (size_t)u.pm * 256 * DM;
        float ss[2][4];
#pragma unroll
        for (int ai = 0; ai < 2; ++ai)
#pragma unroll
            for (int m = 0; m < 4; ++m) ss[ai][m] = 0.f;
#pragma unroll
        for (int bj = 0; bj < 2; ++bj)
#pragma unroll
            for (int n = 0; n < 2; ++n) {
                const int col = col0 + bj * 128 + n * 16;
                f32x4 g4 = *(const f32x4*)(gp + col);
                if (pscale) g4 = g4 * *(const f32x4*)(pscale + col);
                f32x4 gm = {0.f, 0.f, 0.f, 0.f};
                if (XG) gm = *(const f32x4*)(ngain + col) * (*(const f32x4*)(nsc + (size_t)cv * 2 * NMODC + col) + 1.f);
#pragma unroll
                for (int ai = 0; ai < 2; ++ai)
#pragma unroll
                    for (int m = 0; m < 4; ++m) { const size_t off = (size_t)(ai * 128 + wr * 64 + m * 16 + fr) * DM + col;
                        const f32x4 b = *(const f32x4*)(bp + off); const f32x4 x = b + g4 * acc[ai][bj][m][n]; *(f32x4*)(op + off) = x;
                        ss[ai][m] += (x.x * x.x + x.y * x.y) + (x.z * x.z + x.w * x.w);
                        if (XG) { const f32x4 y = x * gm; u32x2 w; w.x = cvtpk(y.x, y.y); w.y = cvtpk(y.z, y.w); *(u32x2*)(XG + (size_t)u.pm * 256 * DM + off) = w; } }
            }
#pragma unroll
        for (int ai = 0; ai < 2; ++ai)
#pragma unroll
            for (int m = 0; m < 4; ++m) { float s = ss[ai][m]; s += __shfl_xor(s, 16); s += __shfl_xor(s, 32);
                if (fq == 0) atomicAdd(rowss + u.pm * 256 + ai * 128 + wr * 64 + m * 16 + fr, s); }
    }
};
struct EpiRelu2 {
    static constexpr bool PERM = true;
    bf16_t* U; const float* rowss; const float* sW;
    __device__ __forceinline__ void operator()(const f32x4 (&acc)[2][2][4][2], const pg8::Unit& u, int wr, int wc, int fr, int fq) const {
        const int row0 = u.pm * 256 + wr * 64 + fr, col0 = u.pn * 256 + wc * 32 + 8 * fq;
        const int cv = u.pm < 16 ? 0 : 1 + ((u.pm - 16) >> 2);
        f32x4 sw[2][2];
#pragma unroll
        for (int bj = 0; bj < 2; ++bj)
#pragma unroll
            for (int n = 0; n < 2; ++n) sw[bj][n] = *(const f32x4*)(sW + (size_t)cv * DFF + col0 + bj * 128 + 4 * n);
#pragma unroll
        for (int ai = 0; ai < 2; ++ai)
#pragma unroll
            for (int m = 0; m < 4; ++m) { const int row = row0 + ai * 128 + m * 16; bf16_t* rowp = U + (size_t)row * DFF + col0;
                const float rs = rsqrtf(rowss[row] * (1.f / DM) + EPS);
#pragma unroll
                for (int bj = 0; bj < 2; ++bj) { f32x4 v0 = acc[ai][bj][m][0] * rs + sw[bj][0], v1 = acc[ai][bj][m][1] * rs + sw[bj][1];
#pragma unroll
                    for (int e = 0; e < 4; ++e) { const float a = fmaxf(v0[e], 0.f), b = fmaxf(v1[e], 0.f); v0[e] = a * a; v1[e] = b * b; }
                    u32x4 w; w.x = cvtpk(v0[0], v0[1]); w.y = cvtpk(v0[2], v0[3]); w.z = cvtpk(v1[0], v1[1]); w.w = cvtpk(v1[2], v1[3]);
                    *(u32x4*)(rowp + bj * 128) = w; } }
    }
};

__device__ __forceinline__ void p0_transpose_item(const float* W, int K, int N, bf16_t* WT, int row_off, LAS float* scr, int item, int lane, const float* shp = nullptr, float* sWp = nullptr) {
    const int nblk = N / 32, kb = item / nblk, nb = item % nblk, k0 = 64 * kb, n0 = 32 * nb;
#pragma unroll 8
    for (int i = 0; i < 32; ++i) { const int kk = 2 * i + (lane >> 5); scr[kk * 33 + (lane & 31)] = W[(size_t)(k0 + kk) * N + n0 + (lane & 31)]; }
    LDS_WAIT(); asm volatile("" ::: "memory");
    if (shp) {
        const float h0 = shp[k0 + lane], h1 = shp[2 * NMODC + k0 + lane], h2 = shp[4 * NMODC + k0 + lane];
        float s0 = 0.f, s1 = 0.f, s2 = 0.f; const int n = lane & 31;
#pragma unroll 4
        for (int k = 0; k < 64; ++k) { const float w = scr[k * 33 + n];
            s0 += w * __builtin_bit_cast(float, __builtin_amdgcn_readlane(__builtin_bit_cast(int, h0), k));
            s1 += w * __builtin_bit_cast(float, __builtin_amdgcn_readlane(__builtin_bit_cast(int, h1), k));
            s2 += w * __builtin_bit_cast(float, __builtin_amdgcn_readlane(__builtin_bit_cast(int, h2), k)); }
        if (lane < 32) { atomicAdd(sWp + n0 + n, s0); atomicAdd(sWp + DFF + n0 + n, s1); atomicAdd(sWp + 2 * DFF + n0 + n, s2); }
    }
    const int c = lane & 7;
#pragma unroll
    for (int j = 0; j < 4; ++j) { const int n = (lane >> 3) + 8 * j; const LAS float* s = scr + (8 * c) * 33 + n;
        u32x4 o; o.x = cvtpk(s[0 * 33], s[1 * 33]); o.y = cvtpk(s[2 * 33], s[3 * 33]); o.z = cvtpk(s[4 * 33], s[5 * 33]); o.w = cvtpk(s[6 * 33], s[7 * 33]);
        *(u32x4*)(WT + (size_t)(row_off + n0 + n) * K + k0 + 8 * c) = o; }
    LDS_WAIT(); asm volatile("" ::: "memory");
}
__device__ __forceinline__ void p0_ada_item(const Args& a, LAS unsigned char* lds, int wi, int tid) {
    LAS float* sc = (LAS float*)lds;
    LAS float* red = (LAS float*)(lds + 24576);
    const int l = wi >> 7, col0 = 96 * (wi & 127);
    for (int i = tid; i < 3 * 2048; i += 512) { const int v = i >> 11, k = i & 2047; const float x = v == 0 ? a.in[7][k] : a.in[6][(v - 1) * 2048 + k]; sc[i] = siluf(x); }
    __syncthreads();
    const int c4 = tid % 24, r = tid / 24;
    if (r < 21) {
        f32x4 a0 = {0.f, 0.f, 0.f, 0.f}, a1 = a0, a2 = a0;
        const float* wp = a.in[8] + (size_t)l * 2048 * NMODC + col0 + 4 * c4;
#pragma unroll 4
        for (int k = r; k < 2048; k += 21) { const f32x4 w = *(const f32x4*)(wp + (size_t)k * NMODC); a0 += w * sc[k]; a1 += w * sc[2048 + k]; a2 += w * sc[4096 + k]; }
        LAS float* rp = red + (r * 24 + c4) * 12;
        *(LAS f32x4*)rp = a0; *(LAS f32x4*)(rp + 4) = a1; *(LAS f32x4*)(rp + 8) = a2;
    }
    __syncthreads();
    if (tid < 288) { const int v = tid / 96, c = tid % 96; float s = 0.f;
        for (int rr = 0; rr < 21; ++rr) s += red[(rr * 24 + (c >> 2)) * 12 + v * 4 + (c & 3)];
        float* mod = (float*)(a.ws + WS_MOD);
        mod[(size_t)v * 2 * NMODC + l * NMODC + col0 + c] = s + a.in[9][l * NMODC + col0 + c]; }
    __syncthreads();
}

constexpr int I_IN = 32 * 208, I_OUT = 32 * 64, I_POOL = 8 * 16, I_M1 = 32 * 256, I_M2 = 128 * 64;
constexpr int R_IN = 0, R_OUT = R_IN + I_IN, R_M1_0 = R_OUT + I_OUT, R_M2_0 = R_M1_0 + I_M1, R_POOL = R_M2_0 + I_M2, R_M1_1 = R_POOL + 4 * I_POOL, R_M2_1 = R_M1_1 + I_M1, R_END = R_M2_1 + I_M2;
__device__ __forceinline__ void transpose_dispatch(const Args& a, int it, LAS float* scr, int lane) {
    unsigned char* ws = a.ws;
    const float* MOD = (const float*)(ws + WS_MOD); float* SW = (float*)(ws + WS_SW);
    if (it < R_OUT) { p0_transpose_item(a.in[12], 2048, IN_AB, (bf16_t*)(ws + WS_WIN), 0, scr, it - R_IN, lane); return; }
    if (it < R_M1_0) { p0_transpose_item(a.in[13], 2048, 2048, (bf16_t*)(ws + WS_WOUT), 0, scr, it - R_OUT, lane); return; }
    if (it < R_M2_0) { p0_transpose_item(a.in[20], 2048, DFF, (bf16_t*)(ws + WS_WM1), 0, scr, it - R_M1_0, lane, MOD + 3 * 2048, SW); return; }
    if (it < R_POOL) { p0_transpose_item(a.in[21], DFF, 2048, (bf16_t*)(ws + WS_WM2), 0, scr, it - R_M2_0, lane); return; }
    if (it < R_M1_1) { const int r = it - R_POOL, g = r / I_POOL; p0_transpose_item(a.in[18] + (size_t)g * 512 * 512, 512, 512, (bf16_t*)(ws + WS_WPOOL), g * 512, scr, r % I_POOL, lane); return; }
    if (it < R_M2_1) { p0_transpose_item(a.in[20] + (size_t)2048 * DFF, 2048, DFF, (bf16_t*)(ws + WS_WM1) + (size_t)DFF * 2048, 0, scr, it - R_M1_1, lane, MOD + NMODC + 3 * 2048, SW + 3 * DFF); return; }
    p0_transpose_item(a.in[21] + (size_t)DFF * 2048, DFF, 2048, (bf16_t*)(ws + WS_WM2) + (size_t)2048 * DFF, 0, scr, it - R_M2_1, lane);
}
__device__ __forceinline__ void bg_transposes(const Args& a, LAS unsigned char* lds, int lo, int hi, int w, int nw, int wave, int lane) {
    LAS float* scr = (LAS float*)(lds + wave * 16384);
    for (int it = lo + w; it < hi; it += nw) transpose_dispatch(a, it, scr, lane);
}

__device__ __forceinline__ void norm_rows_bf16(const Args& a, const float* xa  , const float* gain, int layer, int soff, bf16_t* H, int gw, int ngw, int lane) {
    const float* mod = (const float*)(a.ws + WS_MOD);
    for (int row = gw; row < NTOK; row += ngw) {
        const float* xr = xa ? xa + (size_t)row * DM : xin_row(a, row);
        const float* mp = mod + (size_t)cvec_of_row(row) * 2 * NMODC + layer * NMODC + soff;
        f32x4 v[8]; float ss = 0.f;
#pragma unroll
        for (int j = 0; j < 8; ++j) { v[j] = *(const f32x4*)(xr + 4 * (lane + 64 * j)); ss += v[j].x * v[j].x + v[j].y * v[j].y + v[j].z * v[j].z + v[j].w * v[j].w; }
        const float rstd = rsqrtf(wave_sum(ss) * (1.f / DM) + EPS);
#pragma unroll
        for (int j = 0; j < 8; ++j) { const int c = 4 * (lane + 64 * j);
            const f32x4 g = *(const f32x4*)(gain + c), sh = *(const f32x4*)(mp + c), sc = *(const f32x4*)(mp + 2048 + c);
            const f32x4 y = v[j] * rstd * g * (sc + 1.f) + sh;
            u32x2 w; w.x = cvtpk(y.x, y.y); w.y = cvtpk(y.z, y.w);
            *(u32x2*)(H + (size_t)row * DM + c) = w; }
    }
}
__device__ __forceinline__ void norm_rows_f32(const Args& a, const float* xa, const float* gain, int layer, int soff  , float* O, int gw, int ngw, int lane) {
    const float* mod = (const float*)(a.ws + WS_MOD);
    for (int row = gw; row < NTOK; row += ngw) {
        const float* xr = xa + (size_t)row * DM;
        const float* mp = mod + (size_t)cvec_of_row(row) * 2 * NMODC + layer * NMODC + (soff < 0 ? 0 : soff);
        f32x4 v[8]; float ss = 0.f;
#pragma unroll
        for (int j = 0; j < 8; ++j) { v[j] = *(const f32x4*)(xr + 4 * (lane + 64 * j)); ss += v[j].x * v[j].x + v[j].y * v[j].y + v[j].z * v[j].z + v[j].w * v[j].w; }
        const float rstd = rsqrtf(wave_sum(ss) * (1.f / DM) + EPS);
#pragma unroll
        for (int j = 0; j < 8; ++j) { const int c = 4 * (lane + 64 * j);
            const f32x4 g = *(const f32x4*)(gain + c);
            f32x4 y = v[j] * rstd * g;
            if (soff >= 0) { const f32x4 sh = *(const f32x4*)(mp + c), sc = *(const f32x4*)(mp + 2048 + c); y = y * (sc + 1.f) + sh; }
            *(f32x4*)(O + (size_t)row * DM + c) = y; }
    }
}
template <int HW> __device__ __forceinline__ void pool_out(const LAS float* T, bf16_t* P, int row0, int t0, int Tseq, int cb, int tid) {
    const int cq = tid & 63, tgp = tid >> 6;
#pragma unroll
    for (int j = 0; j < 8; ++j) { const int tl = tgp * 8 + j, t = t0 + tl;
        f32x4 s = {0.f, 0.f, 0.f, 0.f};
#pragma unroll
        for (int d = -HW; d < HW; ++d) { const int u = t + d; const f32x4 v = *(const LAS f32x4*)(T + (tl + 8 + d) * 256 + cq * 4); if (u >= 0 && u < Tseq) s += v; }
        const int lo = max(t - HW, 0), hi = min(t + HW, Tseq);
        const f32x4 x = *(const LAS f32x4*)(T + (tl + 8) * 256 + cq * 4);
        const f32x4 y = s * (1.f / (float)(hi - lo)) - x;
        u32x2 w; w.x = cvtpk(y.x, y.y); w.y = cvtpk(y.z, y.w);
        *(u32x2*)(P + (size_t)(row0 + tl) * DM + cb * 256 + cq * 4) = w; }
}
__device__ __forceinline__ void pool_phase(const Args& a, LAS unsigned char* lds, const float* XA, const float* rowss, bf16_t* P, int bx, int G, int tid) {
    LAS float* T = (LAS float*)lds;
    const float* MOD = (const float*)(a.ws + WS_MOD);
    const int lane = tid & 63, wave = tid >> 6;
    for (int item = bx; item < 768; item += G) {
        const int tt = item >> 3, cb = item & 7, g = cb >> 1, row0 = tt * 64;
        int s0, Tseq;
        if (row0 < NTOK_P) { s0 = row0 & ~255; Tseq = SEQ_P; } else { s0 = NTOK_P + ((row0 - NTOK_P) & ~1023); Tseq = SEQ_S; }
        const int t0 = row0 - s0, c = cb * 256 + lane * 4;
        const float* mp = MOD + (size_t)cvec_of_row(row0) * 2 * NMODC + NMODC;
        const f32x4 gmul = *(const f32x4*)(a.in[10] + 2048 + c) * (*(const f32x4*)(mp + 2048 + c) + 1.f), sh = *(const f32x4*)(mp + c);
        f32x4 xr[10]; float rs[10];
#pragma unroll
        for (int i = 0; i < 10; ++i) { const int t = t0 - 8 + wave + 8 * i; const bool ok = t >= 0 && t < Tseq; const int row = s0 + (ok ? t : t0);
            xr[i] = *(const f32x4*)(XA + (size_t)row * DM + c); rs[i] = rowss[row]; }
#pragma unroll
        for (int i = 0; i < 10; ++i) { const int rr = wave + 8 * i; const float rstd = rsqrtf(rs[i] * (1.f / DM) + EPS);
            *(LAS f32x4*)(T + rr * 256 + lane * 4) = xr[i] * rstd * gmul + sh; }
        __syncthreads();
        switch (g) { case 0: pool_out<1>(T, P, row0, t0, Tseq, cb, tid); break; case 1: pool_out<2>(T, P, row0, t0, Tseq, cb, tid); break;
                     case 2: pool_out<4>(T, P, row0, t0, Tseq, cb, tid); break; default: pool_out<8>(T, P, row0, t0, Tseq, cb, tid); break; }
        __syncthreads();
    }
}
__device__ __forceinline__ void final_rows(const float* XA, const float* rowss, const float* gain, float* O, int gw, int ngw, int lane) {
    for (int row = gw; row < NTOK; row += ngw) { const float rstd = rsqrtf(rowss[row] * (1.f / DM) + EPS);
#pragma unroll
        for (int j = 0; j < 8; ++j) { const int c = 4 * (lane + 64 * j);
            *(f32x4*)(O + (size_t)row * DM + c) = *(const f32x4*)(XA + (size_t)row * DM + c) * rstd * *(const f32x4*)(gain + c); } }
}

__device__ __forceinline__ void post_token(const Args& a, int row, int lane) {
    const bf16_t* ZB = (const bf16_t*)(a.ws + WS_ZB);
    bf16_t* QN = (bf16_t*)(a.ws + WS_QN);
    const bool samp = row >= NTOK_P;
    const int bb = samp ? (row - NTOK_P) >> 10 : row >> 8, t = samp ? (row - NTOK_P) & 1023 : row & 255;
    const int e0 = (lane & 31) * 4, hsel = lane >> 5;
    const int sect = e0 >> 5;
    float cs[4], sn[4];
    if (samp) {
        const float pos = (float)((sect < 2) ? (t >> 6) : (t & 63));
#pragma unroll
        for (int i = 0; i < 4; ++i) { const int j = (e0 + i) & 31; const float inv = exp2f(-(float)j * 0.41524101186092033f); const float ang = pos * inv; cs[i] = __cosf(ang); sn[i] = __sinf(ang); }
    }
    u32x2 raw6[6];
#pragma unroll
    for (int p = 0; p < 6; ++p) raw6[p] = *(const u32x2*)(ZB + (size_t)row * IN_AB + p * 256 + lane * 4);
#pragma unroll
    for (int p = 0; p < 6; ++p) {
        const int col = p * 256 + lane * 4;
        const u32x2 raw = raw6[p];
        float y[4] = {bflo(raw.x), bfhi(raw.x), bflo(raw.y), bfhi(raw.y)};
        if (p < 5) {
            const float ss = half_sum(y[0] * y[0] + y[1] * y[1] + y[2] * y[2] + y[3] * y[3]);
            const float rstd = rsqrtf(ss * (1.f / 128.f) + EPS);
            const f32x4 g = *(const f32x4*)((p < 4 ? a.in[14] : a.in[15]) + e0);
            y[0] *= rstd * g.x; y[1] *= rstd * g.y; y[2] *= rstd * g.z; y[3] *= rstd * g.w;
        }
        if (!samp && p >= 4) {
            float* o = a.out + (p == 4 ? 12582912 : 13631488) + (size_t)row * 256 + lane * 4;
            *(f32x4*)o = (f32x4){y[0], y[1], y[2], y[3]};
        }
        if (samp && p < 5) {
#pragma unroll
            for (int i = 0; i < 4; ++i) { const float py = __shfl_xor(y[i], 8); const float rot = (sect & 1) ? py : -py; y[i] = y[i] * cs[i] + rot * sn[i]; }
        }
        u32x2 w; w.x = cvtpk(y[0], y[1]); w.y = cvtpk(y[2], y[3]);
        if (p < 4) *(u32x2*)(QN + (size_t)row * 1024 + col) = w;
        else {
            bf16_t* dst;
            if (samp) dst = (bf16_t*)(a.ws + (p == 4 ? WS_KS : WS_VS)) + ((size_t)(bb * 2 + hsel) * 1280 + t) * 128 + e0;
            else      dst = (bf16_t*)(a.ws + (p == 4 ? WS_KP : WS_VP)) + ((size_t)(bb * 2 + hsel) * 256 + t) * 128 + e0;
            *(u32x2*)dst = w;
        }
    }
}
__device__ __forceinline__ void cache_item(const Args& a, int item, int lane) {
    const int which = item >> 9, b = (item >> 8) & 1, t = item & 255, hsel = lane >> 5, e0 = (lane & 31) * 4;
    const f32x4 v = *(const f32x4*)(a.in[2 + which] + ((size_t)(b * 256 + t) * 2 + hsel) * 128 + e0);
    bf16_t* dst = (bf16_t*)(a.ws + (which == 0 ? WS_KS : WS_VS)) + ((size_t)(b * 2 + hsel) * 1280 + 1024 + t) * 128 + e0;
    u32x2 w; w.x = cvtpk(v.x, v.y); w.y = cvtpk(v.z, v.w);
    *(u32x2*)dst = w;
}
__device__ __forceinline__ void combine_token(const Args& a, int row, int lane) {
    const float* OF = (const float*)(a.ws + WS_OF); const float* OB = (const float*)(a.ws + WS_OB);
    const bf16_t* ZB = (const bf16_t*)(a.ws + WS_ZB); bf16_t* A2 = (bf16_t*)(a.ws + WS_A2);
    const int e0 = (lane & 31) * 4;
    const f32x4 g = *(const f32x4*)(a.in[16] + e0);
#pragma unroll
    for (int p = 0; p < 4; ++p) {
        const int col = p * 256 + lane * 4;
        const f32x4 o = *(const f32x4*)(OF + (size_t)row * 1024 + col) + *(const f32x4*)(OB + (size_t)row * 1024 + col);
        const float ss = half_sum(o.x * o.x + o.y * o.y + o.z * o.z + o.w * o.w);
        const float rstd = rsqrtf(ss * (1.f / 128.f) + EPS);
        const u32x2 raw = *(const u32x2*)(ZB + (size_t)row * IN_AB + C_HG + col);
        const f32x4 y = o * rstd * g * (f32x4){bflo(raw.x), bfhi(raw.x), bflo(raw.y), bfhi(raw.y)};
        u32x2 w; w.x = cvtpk(y.x, y.y); w.y = cvtpk(y.z, y.w);
        *(u32x2*)(A2 + (size_t)row * DM + 1024 + col) = w;
    }
}

constexpr int HG_ROW = 136, HG_TROW = 40;
constexpr int HG_QI = 0, HG_KI = 32 * HG_ROW * 2, HG_QS = 2 * 32 * HG_ROW * 2, HG_KST = 3 * 32 * HG_ROW * 2, HG_IT = HG_KST + 128 * HG_TROW * 2, HG_A = HG_IT + 128 * HG_TROW * 2, HG_GT = HG_A + 512, HG_SEQ_BYTES = HG_GT + 4096;
static_assert(HG_SEQ_BYTES % 16 == 0 && 2 * HG_SEQ_BYTES <= RING_BYTES, "hgrn lds");
__device__ __forceinline__ int crow(int r, int hi) { return (r & 3) + 8 * (r >> 2) + 4 * hi; }
__device__ __forceinline__ int kpos(int k) { const int kp = k & 15; return (k & 16) + (((kp >> 2) & 1) << 3) + ((kp >> 3) << 2) + (kp & 3); }
#define MFMA32(a, b, c) __builtin_amdgcn_mfma_f32_32x32x16_bf16((a), (b), (c), 0, 0, 0)
__device__ __forceinline__ bf16x8 pack8(const f32x16& x, int s) {
    u32x4 p; p.x = cvtpk(x[8 * s], x[8 * s + 1]); p.y = cvtpk(x[8 * s + 2], x[8 * s + 3]); p.z = cvtpk(x[8 * s + 4], x[8 * s + 5]); p.w = cvtpk(x[8 * s + 6], x[8 * s + 7]);
    return __builtin_bit_cast(bf16x8, p);
}
struct HgRegs { f32x4 lf[4]; u32x2 qv[4], iv[4]; };
__device__ __forceinline__ void hg_load(HgRegs& R, const float* LF, const bf16_t* ZB, int rowbase, int dir, int hh, int cg, int tg, int ch) {
#pragma unroll
    for (int jj = 0; jj < 4; ++jj) { const int j = 4 * tg + jj;
        const int row = rowbase + (dir == 0 ? 32 * ch + j : 32 * (7 - ch) + 31 - j);
        R.lf[jj] = *(const f32x4*)(LF + (size_t)row * 2048 + dir * 1024 + hh * 128 + 4 * cg);
        R.qv[jj] = *(const u32x2*)(ZB + (size_t)row * IN_AB + C_HQ + hh * 128 + 4 * cg);
        R.iv[jj] = *(const u32x2*)(ZB + (size_t)row * IN_AB + C_HI + hh * 128 + 4 * cg); }
}
__device__ __forceinline__ void hg_chunk(const HgRegs& R, f32x16 (&S)[4], f32x4& ltot, LAS unsigned char* L, float* OUT, int rowbase, int dir, int hh, int ch,
                                         int cg, int tg, int r32, int hi, int e0) {
    f32x4 cb[4]; cb[0] = R.lf[0]; cb[1] = cb[0] + R.lf[1]; cb[2] = cb[1] + R.lf[2]; cb[3] = cb[2] + R.lf[3];
    *(LAS f32x4*)(L + HG_GT + (tg * 128 + 4 * cg) * 4) = cb[3];
    __syncthreads();
    f32x4 off = {0.f, 0.f, 0.f, 0.f}, bm = off, bl = off;
#pragma unroll
    for (int g = 0; g < 8; ++g) { const f32x4 t4 = *(const LAS f32x4*)(L + HG_GT + (g * 128 + 4 * cg) * 4); if (g < tg) off += t4; if (g < 4) bm += t4; bl += t4; }
    ltot += bl;
    f32x4 em, elm;
#pragma unroll
    for (int c = 0; c < 4; ++c) { em[c] = __expf(bm[c]); elm[c] = __expf(bl[c] - bm[c]); }
    if (tg == 0) { f32x4 av;
#pragma unroll
        for (int c = 0; c < 4; ++c) av[c] = __expf(bl[c]);
        *(LAS f32x4*)(L + HG_A + 16 * cg) = av; }
    float kS_[4][4], iv_[4][4];
#pragma unroll
    for (int jj = 0; jj < 4; ++jj) {
        const int j = 4 * tg + jj;
        const float q4[4] = {bflo(R.qv[jj].x), bfhi(R.qv[jj].x), bflo(R.qv[jj].y), bfhi(R.qv[jj].y)};
        iv_[jj][0] = bflo(R.iv[jj].x); iv_[jj][1] = bfhi(R.iv[jj].x); iv_[jj][2] = bflo(R.iv[jj].y); iv_[jj][3] = bfhi(R.iv[jj].y);
        float qI[4], qS[4], kI[4];
#pragma unroll
        for (int c = 0; c < 4; ++c) {
            const float b = off[c] + cb[jj][c];
            const float E1 = __expf(fminf(fmaxf(b - bm[c], -80.f), 80.f)), R1 = __builtin_amdgcn_rcpf(E1);
            const float kk = 1.f - __expf(R.lf[jj][c]);
            qI[c] = q4[c] * E1; qS[c] = qI[c] * em[c];
            kI[c] = kk * R1; kS_[jj][c] = kI[c] * elm[c];
        }
        u32x2 w; w.x = cvtpk(qI[0], qI[1]); w.y = cvtpk(qI[2], qI[3]);
        *(LAS u32x2*)(L + HG_QI + (j * HG_ROW + 4 * cg) * 2) = w;
        w.x = cvtpk(kI[0], kI[1]); w.y = cvtpk(kI[2], kI[3]);
        *(LAS u32x2*)(L + HG_KI + (j * HG_ROW + 4 * cg) * 2) = w;
        w.x = cvtpk(qS[0], qS[1]); w.y = cvtpk(qS[2], qS[3]);
        *(LAS u32x2*)(L + HG_QS + (j * HG_ROW + (4 * cg & ~31) + kpos(4 * cg & 31)) * 2) = w;
    }
    {
        const int p0 = kpos(4 * tg);
#pragma unroll
        for (int c = 0; c < 4; ++c) { u32x2 w; w.x = cvtpk(kS_[0][c], kS_[1][c]); w.y = cvtpk(kS_[2][c], kS_[3][c]);
            *(LAS u32x2*)(L + HG_KST + ((4 * cg + c) * HG_TROW + p0) * 2) = w;
            w.x = cvtpk(iv_[0][c], iv_[1][c]); w.y = cvtpk(iv_[2][c], iv_[3][c]);
            *(LAS u32x2*)(L + HG_IT + ((4 * cg + c) * HG_TROW + p0) * 2) = w; }
    }
    __syncthreads();
    f32x16 x;
#pragma unroll
    for (int i = 0; i < 16; ++i) x[i] = 0.f;
#pragma unroll
    for (int ks = 0; ks < 8; ++ks) {
        const bf16x8 fa = *(const LAS bf16x8*)(L + HG_KI + (r32 * HG_ROW + 16 * ks + 8 * hi) * 2);
        const bf16x8 fb = *(const LAS bf16x8*)(L + HG_QI + (r32 * HG_ROW + 16 * ks + 8 * hi) * 2);
        x = MFMA32(fa, fb, x);
    }
#pragma unroll
    for (int i = 0; i < 16; ++i) x[i] = (crow(i, hi) <= r32) ? x[i] : 0.f;
    f32x16 y;
#pragma unroll
    for (int i = 0; i < 16; ++i) y[i] = 0.f;
    bf16x8 fi[2];
#pragma unroll
    for (int ks = 0; ks < 2; ++ks) {
        fi[ks] = *(const LAS bf16x8*)(L + HG_IT + ((e0 + r32) * HG_TROW + 16 * ks + 8 * hi) * 2);
        y = MFMA32(fi[ks], pack8(x, ks), y);
    }
#pragma unroll
    for (int db = 0; db < 4; ++db)
#pragma unroll
        for (int ks = 0; ks < 2; ++ks) {
            const bf16x8 fq_ = *(const LAS bf16x8*)(L + HG_QS + (r32 * HG_ROW + 32 * db + 16 * ks + 8 * hi) * 2);
            y = MFMA32(pack8(S[db], ks), fq_, y);
        }
    {
        const int row = rowbase + (dir == 0 ? 32 * ch + r32 : 32 * (7 - ch) + 31 - r32);
        float* op = OUT + (size_t)row * 1024 + hh * 128 + e0 + 4 * hi;
#pragma unroll
        for (int g4 = 0; g4 < 4; ++g4) *(f32x4*)(op + 8 * g4) = (f32x4){y[4 * g4], y[4 * g4 + 1], y[4 * g4 + 2], y[4 * g4 + 3]};
    }
#pragma unroll
    for (int db = 0; db < 4; ++db) {
#pragma unroll
        for (int g4 = 0; g4 < 4; ++g4) { const f32x4 a4 = *(const LAS f32x4*)(L + HG_A + (32 * db + 8 * g4 + 4 * hi) * 4);
#pragma unroll
            for (int c = 0; c < 4; ++c) S[db][4 * g4 + c] *= a4[c]; }
#pragma unroll
        for (int ks = 0; ks < 2; ++ks) {
            const bf16x8 fk = *(const LAS bf16x8*)(L + HG_KST + ((32 * db + r32) * HG_TROW + 16 * ks + 8 * hi) * 2);
            S[db] = MFMA32(fk, fi[ks], S[db]);
        }
    }
}
__device__ __forceinline__ void hgrn_task(const Args& a, LAS unsigned char* lds0, int task, int tid) {
    const bool samp = task < 64;
    const int bb = samp ? task >> 5 : (task - 64) >> 3, hh = samp ? (task >> 2) & 7 : task & 7, seg = task & 3;
    const int rowbase = samp ? NTOK_P + bb * SEQ_S + seg * 256 : bb * SEQ_P;
    const int dir = tid >> 8, tl = tid & 255, lane = tid & 63, wq = (tid >> 6) & 3, r32 = lane & 31, hi = lane >> 5;
    LAS unsigned char* L = lds0 + dir * HG_SEQ_BYTES;
    const bf16_t* ZB = (const bf16_t*)(a.ws + WS_ZB); const float* LF = (const float*)(a.ws + WS_LF);
    float* OUT = (float*)(a.ws + (dir == 0 ? WS_OF : WS_OB));
    const int cg = tl & 31, tg = tl >> 5, e0 = 32 * wq;
    f32x16 S[4];
    const bool has_init = samp && (dir == 0 ? seg == 0 : seg == 3);
    if (has_init) { const float* s0 = a.in[4 + dir] + (size_t)(bb * 8 + hh) * 16384;
#pragma unroll
        for (int db = 0; db < 4; ++db)
#pragma unroll
            for (int i = 0; i < 16; ++i) S[db][i] = s0[(size_t)(32 * db + crow(i, hi)) * 128 + e0 + r32];
    } else {
#pragma unroll
        for (int db = 0; db < 4; ++db)
#pragma unroll
            for (int i = 0; i < 16; ++i) S[db][i] = 0.f;
    }
    f32x4 ltot = {0.f, 0.f, 0.f, 0.f};
    HgRegs RA, RB;
    hg_load(RA, LF, ZB, rowbase, dir, hh, cg, tg, 0);
    hg_load(RB, LF, ZB, rowbase, dir, hh, cg, tg, 1);
#pragma unroll
    for (int ch = 0; ch < 8; ch += 2) {
        hg_chunk(RA, S, ltot, L, OUT, rowbase, dir, hh, ch, cg, tg, r32, hi, e0);
        if (ch + 2 < 8) hg_load(RA, LF, ZB, rowbase, dir, hh, cg, tg, ch + 2);
        hg_chunk(RB, S, ltot, L, OUT, rowbase, dir, hh, ch + 1, cg, tg, r32, hi, e0);
        if (ch + 3 < 8) hg_load(RB, LF, ZB, rowbase, dir, hh, cg, tg, ch + 3);
    }
    if (!samp) { float* so = a.out + (dir == 0 ? 14680064 : 16777216) + (size_t)(bb * 8 + hh) * 16384;
#pragma unroll
        for (int db = 0; db < 4; ++db)
#pragma unroll
            for (int i = 0; i < 16; ++i) so[(size_t)(32 * db + crow(i, hi)) * 128 + e0 + r32] = S[db][i];
    } else {
        const size_t sidx = (size_t)(((bb * 8 + hh) * 2 + dir) * 4 + seg);
        float* so = (float*)(a.ws + WS_SEND) + sidx * 16384;
#pragma unroll
        for (int db = 0; db < 4; ++db)
#pragma unroll
            for (int i = 0; i < 16; ++i) so[(size_t)(32 * db + crow(i, hi)) * 128 + e0 + r32] = S[db][i];
        if (tg == 0) *(f32x4*)((float*)(a.ws + WS_LSEG) + sidx * 128 + 4 * cg) = ltot;
    }
    __syncthreads();
}
constexpr int FX_QS = 0, FX_GT = 32 * HG_ROW * 2, FX_DIR_BYTES = FX_GT + 4096, FX_Z = 2 * FX_DIR_BYTES, FX_ZROW = 132, FX_RED = FX_Z + 32 * FX_ZROW * 4, FX_BYTES = FX_RED + 512;
__device__ __forceinline__ void hgfix_task(const Args& a, LAS unsigned char* lds0, int task, int tid) {
    const int bb = task >> 5, hh = (task >> 2) & 7, seg = task & 3;
    const int rowbase = NTOK_P + bb * SEQ_S + seg * 256;
    const int dir = tid >> 8, tl = tid & 255, lane = tid & 63, wq = (tid >> 6) & 3, r32 = lane & 31, hi = lane >> 5;
    LAS unsigned char* L = lds0 + dir * FX_DIR_BYTES;
    const bf16_t* ZB = (const bf16_t*)(a.ws + WS_ZB); const float* LF = (const float*)(a.ws + WS_LF);
    const float* OIN = (const float*)(a.ws + (dir == 0 ? WS_OF : WS_OB));
    bf16_t* A2 = (bf16_t*)(a.ws + WS_A2);
    const int cg = tl & 31, tg = tl >> 5, e0 = 32 * wq;
    const size_t sbase = (size_t)((bb * 8 + hh) * 2 + dir) * 4;
    const float* SEND = (const float*)(a.ws + WS_SEND); const float* LSEG = (const float*)(a.ws + WS_LSEG);
    f32x16 S[4];
#pragma unroll
    for (int db = 0; db < 4; ++db)
#pragma unroll
        for (int i = 0; i < 16; ++i) S[db][i] = 0.f;
    const int nfold = dir == 0 ? seg : 3 - seg;
    for (int f = 0; f < nfold; ++f) { const int j = dir == 0 ? f : 3 - f;
        const float* sp = SEND + (sbase + j) * 16384; const float* lp = LSEG + (sbase + j) * 128;
#pragma unroll
        for (int db = 0; db < 4; ++db)
#pragma unroll
            for (int g4 = 0; g4 < 4; ++g4) { const f32x4 l4 = *(const f32x4*)(lp + 32 * db + 8 * g4 + 4 * hi);
#pragma unroll
                for (int c = 0; c < 4; ++c) { const int i = 4 * g4 + c; S[db][i] = S[db][i] * __expf(l4[c]) + sp[(size_t)(32 * db + crow(i, hi)) * 128 + e0 + r32]; } }
    }
    bf16x8 sf[4][2];
#pragma unroll
    for (int db = 0; db < 4; ++db)
#pragma unroll
        for (int ks = 0; ks < 2; ++ks) sf[db][ks] = pack8(S[db], ks);
    f32x4 run = {0.f, 0.f, 0.f, 0.f}, ltot = {0.f, 0.f, 0.f, 0.f};
    if (dir == 1) ltot = *(const f32x4*)(LSEG + (sbase + seg) * 128 + 4 * cg);
    const f32x4 gn0 = *(const f32x4*)(a.in[16] + e0 + 4 * hi), gn1 = *(const f32x4*)(a.in[16] + e0 + 4 * hi + 8), gn2 = *(const f32x4*)(a.in[16] + e0 + 4 * hi + 16), gn3 = *(const f32x4*)(a.in[16] + e0 + 4 * hi + 24);
    f32x4 lfn[4]; u32x2 qvn[4];
#define FX_LOAD(chn) do { _Pragma("unroll") for (int jj = 0; jj < 4; ++jj) { const int row_ = rowbase + 32 * (chn) + 4 * tg + jj; \
        lfn[jj] = *(const f32x4*)(LF + (size_t)row_ * 2048 + dir * 1024 + hh * 128 + 4 * cg); \
        qvn[jj] = *(const u32x2*)(ZB + (size_t)row_ * IN_AB + C_HQ + hh * 128 + 4 * cg); } } while (0)
    FX_LOAD(0);
#pragma unroll 1
    for (int ch = 0; ch < 8; ++ch) {
        f32x4 lf[4]; u32x2 qv[4];
#pragma unroll
        for (int jj = 0; jj < 4; ++jj) { lf[jj] = lfn[jj]; qv[jj] = qvn[jj]; }
        const int row = rowbase + 32 * ch + r32;
        f32x4 zin[4]; u32x2 hgraw[4];
        { const float* ip = OIN + (size_t)row * 1024 + hh * 128 + e0 + 4 * hi; const bf16_t* hgp = ZB + (size_t)row * IN_AB + C_HG + hh * 128 + e0 + 4 * hi;
#pragma unroll
          for (int g4 = 0; g4 < 4; ++g4) { zin[g4] = *(const f32x4*)(ip + 8 * g4); hgraw[g4] = *(const u32x2*)(hgp + 8 * g4); } }
        if (ch + 1 < 8) FX_LOAD(ch + 1);
        f32x4 cb[4]; cb[0] = lf[0]; cb[1] = cb[0] + lf[1]; cb[2] = cb[1] + lf[2]; cb[3] = cb[2] + lf[3];
        *(LAS f32x4*)(L + FX_GT + (tg * 128 + 4 * cg) * 4) = cb[3];
        __syncthreads();
        f32x4 off = {0.f, 0.f, 0.f, 0.f}, bl = off;
#pragma unroll
        for (int g = 0; g < 8; ++g) { const f32x4 t4 = *(const LAS f32x4*)(L + FX_GT + (g * 128 + 4 * cg) * 4); if (g < tg) off += t4; bl += t4; }
#pragma unroll
        for (int jj = 0; jj < 4; ++jj) { const int j = 4 * tg + jj;
            const float q4[4] = {bflo(qv[jj].x), bfhi(qv[jj].x), bflo(qv[jj].y), bfhi(qv[jj].y)};
            float qB[4];
#pragma unroll
            for (int c = 0; c < 4; ++c) { const float incl = run[c] + off[c] + cb[jj][c];
                const float B = dir == 0 ? incl : ltot[c] - (incl - lf[jj][c]);
                qB[c] = q4[c] * __expf(B); }
            u32x2 w; w.x = cvtpk(qB[0], qB[1]); w.y = cvtpk(qB[2], qB[3]);
            *(LAS u32x2*)(L + FX_QS + (j * HG_ROW + (4 * cg & ~31) + kpos(4 * cg & 31)) * 2) = w; }
        run += bl;
        __syncthreads();
        f32x16 y;
#pragma unroll
        for (int i = 0; i < 16; ++i) y[i] = 0.f;
        if (nfold > 0) {
#pragma unroll
            for (int db = 0; db < 4; ++db)
#pragma unroll
                for (int ks = 0; ks < 2; ++ks) { const bf16x8 fq_ = *(const LAS bf16x8*)(L + FX_QS + (r32 * HG_ROW + 32 * db + 16 * ks + 8 * hi) * 2); y = MFMA32(sf[db][ks], fq_, y); }
        }
        f32x4 z[4];
#pragma unroll
        for (int g4 = 0; g4 < 4; ++g4) z[g4] = zin[g4] + (f32x4){y[4 * g4], y[4 * g4 + 1], y[4 * g4 + 2], y[4 * g4 + 3]};
        LAS float* Z = (LAS float*)(lds0 + FX_Z);
        if (dir == 1) {
#pragma unroll
            for (int g4 = 0; g4 < 4; ++g4) *(LAS f32x4*)(Z + r32 * FX_ZROW + e0 + 4 * hi + 8 * g4) = z[g4]; }
        __syncthreads();
        float ssq = 0.f;
        if (dir == 0) {
#pragma unroll
            for (int g4 = 0; g4 < 4; ++g4) { z[g4] += *(const LAS f32x4*)(Z + r32 * FX_ZROW + e0 + 4 * hi + 8 * g4); ssq += (z[g4].x * z[g4].x + z[g4].y * z[g4].y) + (z[g4].z * z[g4].z + z[g4].w * z[g4].w); }
            ssq += __shfl_xor(ssq, 32);
            if (hi == 0) ((LAS float*)(lds0 + FX_RED))[wq * 32 + r32] = ssq;
        }
        __syncthreads();
        if (dir == 0) {
            const LAS float* red = (const LAS float*)(lds0 + FX_RED);
            const float tot = (red[r32] + red[32 + r32]) + (red[64 + r32] + red[96 + r32]);
            const float rstd = rsqrtf(tot * (1.f / 128.f) + EPS);
            bf16_t* op = A2 + (size_t)row * DM + 1024 + hh * 128 + e0 + 4 * hi;
            const f32x4 gn[4] = {gn0, gn1, gn2, gn3};
#pragma unroll
            for (int g4 = 0; g4 < 4; ++g4) { const u32x2 raw = hgraw[g4];
                const f32x4 o = z[g4] * rstd * gn[g4] * (f32x4){bflo(raw.x), bfhi(raw.x), bflo(raw.y), bfhi(raw.y)};
                u32x2 w; w.x = cvtpk(o.x, o.y); w.y = cvtpk(o.z, o.w); *(u32x2*)(op + 8 * g4) = w; }
        }
    }
    __syncthreads();
}

namespace att {
constexpr int D = 128, NW = 8, QBLK = 32, KVBLK = 64;
constexpr float SCALE = 0.088388347648318440f;
constexpr float THR = 0.f;
constexpr int LDQ = 1024, LDK = 128, LDO = 2048;
constexpr int SHM_V = KVBLK * D * 2, SHM_K = KVBLK * D * 2, SHM_ATTN = 2 * SHM_V + 2 * SHM_K + NW * 64 * 4;
#define KSWZ(row, colB) ((row) * 256 + ((colB) ^ (((row) & 7) << 4)))
#define SBAR() __builtin_amdgcn_sched_barrier(0)
__device__ __forceinline__ unsigned cvtpk_a(float lo, float hi) { unsigned r; asm volatile("v_cvt_pk_bf16_f32 %0, %1, %2" : "=v"(r) : "v"(lo), "v"(hi)); return r; }
__device__ __forceinline__ void partialSM(f32x16& p0, f32x16& p1, float& m_reg, float& mn, float& alpha) {
  constexpr float C = SCALE * 1.4426950408889634f;
  float pmax = p0[0]; for (int r = 1; r < 16; ++r) pmax = fmaxf(pmax, p0[r]); for (int r = 0; r < 16; ++r) pmax = fmaxf(pmax, p1[r]);
  { auto rr = __builtin_amdgcn_permlane32_swap(__float_as_uint(pmax), __float_as_uint(pmax), false, false);
    pmax = fmaxf(__uint_as_float(rr[0]), __uint_as_float(rr[1])); }
  if (__builtin_expect(__all(pmax - m_reg <= THR / SCALE), 1)) { mn = m_reg; alpha = 1.f; }
  else { mn = fmaxf(m_reg, pmax); alpha = __builtin_amdgcn_exp2f((m_reg - mn) * C); m_reg = mn; }
  float mnC = -mn * C;
  for (int r = 0; r < 16; ++r) p0[r] = fmaf(p0[r], C, mnC); for (int r = 0; r < 16; ++r) p1[r] = fmaf(p1[r], C, mnC);
  for (int r = 0; r < 16; ++r) p0[r] = __builtin_amdgcn_exp2f(p0[r]);
}
__device__ __forceinline__ void finishSM(f32x16& p0, f32x16& p1, float alpha, float& l_reg, bf16x8& pa0, bf16x8& pa1, bf16x8& pa2, bf16x8& pa3) {
  for (int r = 0; r < 16; ++r) p1[r] = __builtin_amdgcn_exp2f(p1[r]);
  float ps = 0; for (int r = 0; r < 16; ++r) ps += p0[r]; for (int r = 0; r < 16; ++r) ps += p1[r];
  { auto rr = __builtin_amdgcn_permlane32_swap(__float_as_uint(ps), __float_as_uint(ps), false, false);
    ps = __uint_as_float(rr[0]) + __uint_as_float(rr[1]); }
  l_reg = l_reg * alpha + ps;
#define PK4(P, BASE, OUT) do { unsigned a0 = cvtpk_a(P[BASE + 0], P[BASE + 1]), a1 = cvtpk_a(P[BASE + 2], P[BASE + 3]);   \
    unsigned b0 = cvtpk_a(P[BASE + 4], P[BASE + 5]), b1 = cvtpk_a(P[BASE + 6], P[BASE + 7]);                              \
    auto r0 = __builtin_amdgcn_permlane32_swap(a0, b0, false, false); auto r1 = __builtin_amdgcn_permlane32_swap(a1, b1, false, false); \
    u32x4 w = {r0[0], r1[0], r0[1], r1[1]}; OUT = *reinterpret_cast<bf16x8*>(&w); } while (0)
  PK4(p0, 0, pa0); PK4(p0, 8, pa1); PK4(p1, 0, pa2); PK4(p1, 8, pa3);
#undef PK4
}
__device__ __forceinline__ void qkt(f32x16& p0, f32x16& p1, const bf16_t* Ks, const bf16x8* qr, int r32, int hi) {
  p0 = f32x16{}; p1 = f32x16{};
  for (int d0 = 0; d0 < 8; ++d0) { int cb = (d0 * 16 + hi * 8) * 2;
    bf16x8 b0 = *reinterpret_cast<const bf16x8*>((const char*)Ks + KSWZ(r32, cb));
    bf16x8 b1 = *reinterpret_cast<const bf16x8*>((const char*)Ks + KSWZ(32 + r32, cb));
    p0 = __builtin_amdgcn_mfma_f32_32x32x16_bf16(b0, qr[d0], p0, 0, 0, 0);
    p1 = __builtin_amdgcn_mfma_f32_32x32x16_bf16(b1, qr[d0], p1, 0, 0, 0); }
}
__device__ __forceinline__ int v_st(int k, int c) { const int kk = (k & ~0xC) | ((k & 4) << 1) | ((k & 8) >> 1); return ((kk >> 3) * 4 + (c >> 5)) * 512 + ((kk & 7) * 32 + (c & 31)) * 2; }
__device__ __forceinline__ int v_rd_base(int lane) { return ((lane & 3) << 3) | (((lane >> 2) & 3) << 6) | (((lane >> 4) & 1) << 5) | (((lane >> 5) & 1) << 8); }
constexpr int v_rd_off(int d0, int ks, int half) { return d0 * 512 + ks * 4096 + half * 2048; }
template <int OFF> __device__ __forceinline__ s16x4 tr_read(int vb) {
  s16x4 r; asm volatile("ds_read_b64_tr_b16 %0, %1 offset:%2" : "=&v"(r) : "v"(vb), "i"(OFF) : "memory"); return r;
}
template <int D0> __device__ __forceinline__ void pv_one(f32x16& od, int vb, bf16x8 pa0, bf16x8 pa1, bf16x8 pa2, bf16x8 pa3) {
  const s16x4 l0 = tr_read<v_rd_off(D0, 0, 0)>(vb), h0 = tr_read<v_rd_off(D0, 0, 1)>(vb), l1 = tr_read<v_rd_off(D0, 1, 0)>(vb), h1 = tr_read<v_rd_off(D0, 1, 1)>(vb);
  const s16x4 l2 = tr_read<v_rd_off(D0, 2, 0)>(vb), h2 = tr_read<v_rd_off(D0, 2, 1)>(vb), l3 = tr_read<v_rd_off(D0, 3, 0)>(vb), h3 = tr_read<v_rd_off(D0, 3, 1)>(vb);
  asm volatile("s_waitcnt lgkmcnt(0)" ::: "memory"); SBAR();
#define PK(L, H) (bf16x8){L[0], L[1], L[2], L[3], H[0], H[1], H[2], H[3]}
  od = __builtin_amdgcn_mfma_f32_32x32x16_bf16(pa0, PK(l0, h0), od, 0, 0, 0);
  od = __builtin_amdgcn_mfma_f32_32x32x16_bf16(pa1, PK(l1, h1), od, 0, 0, 0);
  od = __builtin_amdgcn_mfma_f32_32x32x16_bf16(pa2, PK(l2, h2), od, 0, 0, 0);
  od = __builtin_amdgcn_mfma_f32_32x32x16_bf16(pa3, PK(l3, h3), od, 0, 0, 0);
#undef PK
}
__device__ __forceinline__ void pv_d0(f32x16* o, int vb, bf16x8 pa0, bf16x8 pa1, bf16x8 pa2, bf16x8 pa3) {
  pv_one<0>(o[0], vb, pa0, pa1, pa2, pa3); pv_one<1>(o[1], vb, pa0, pa1, pa2, pa3); pv_one<2>(o[2], vb, pa0, pa1, pa2, pa3); pv_one<3>(o[3], vb, pa0, pa1, pa2, pa3);
}
__device__ __forceinline__ void attn_dense_body(const bf16_t* __restrict__ Qb, const bf16_t* __restrict__ Kh, const bf16_t* __restrict__ Vh,
                                                bf16_t* __restrict__ Ob, int seq, char* lds) {
  const int tid = threadIdx.x, wid = tid >> 6, lane = tid & 63, r32 = lane & 31, hi = lane >> 5;
  bf16_t* V_lds = (bf16_t*)lds; bf16_t* K_lds = (bf16_t*)(lds + 2 * SHM_V);
  float* ws = (float*)(lds + 2 * SHM_V + 2 * SHM_K) + wid * 64; float* li_l = ws; float* al_l = ws + 32;
  float m_reg = -1e30f, l_reg = 0; f32x16 o[4] = {}; bf16x8 qr[8];
  const bf16_t* Qw = Qb + (long)(wid * QBLK + r32) * LDQ + hi * 8;
#pragma unroll
  for (int d0 = 0; d0 < 8; ++d0) qr[d0] = *reinterpret_cast<const bf16x8*>(Qw + d0 * 16);
  const int sr = tid >> 4, sc = (tid & 15) * 8, vst0 = v_st(sr, sc), vst1 = v_st(32 + sr, sc);
  const int vb0 = (int)(uintptr_t)V_lds + v_rd_base(lane);
  struct { bf16x8 vs0, vs1, ks0, ks1; } sr_[2];
#define LD8(p) (*reinterpret_cast<const bf16x8*>(p))
#define SLOAD(i, k0) do { sr_[i].vs0 = LD8(&Vh[(long)((k0) + sr) * LDK + sc]); sr_[i].vs1 = LD8(&Vh[(long)((k0) + 32 + sr) * LDK + sc]); \
    sr_[i].ks0 = LD8(&Kh[(long)((k0) + sr) * LDK + sc]); sr_[i].ks1 = LD8(&Kh[(long)((k0) + 32 + sr) * LDK + sc]); } while (0)
#define SWRITE(b, i) do { *(bf16x8*)((char*)V_lds + (b) * SHM_V + vst0) = sr_[i].vs0;          \
    *(bf16x8*)((char*)V_lds + (b) * SHM_V + vst1) = sr_[i].vs1; int kc = sc * 2;               \
    *(bf16x8*)((char*)K_lds + (b) * SHM_K + KSWZ(sr, kc)) = sr_[i].ks0;                       \
    *(bf16x8*)((char*)K_lds + (b) * SHM_K + KSWZ(32 + sr, kc)) = sr_[i].ks1; } while (0)
#define SWAIT() asm volatile("s_waitcnt vmcnt(4)" ::: "memory")
#define RESC(a) do { if (__any((a) < 1.f)) { if (hi == 0) al_l[r32] = (a); asm volatile("s_waitcnt lgkmcnt(0)" ::: "memory"); \
    for (int d = 0; d < 4; ++d) for (int r = 0; r < 16; ++r) o[d][r] *= al_l[crow(r, hi)]; } } while (0)
  f32x16 pA0, pA1, pB0, pB1; float mnA, mnB, alA, alB; bf16x8 pa0, pa1, pa2, pa3; const int NT = seq / KVBLK;
  constexpr int SE = 0, SO = 1;
  SLOAD(SE, 0); asm volatile("s_waitcnt vmcnt(0)" ::: "memory"); SWRITE(0, SE); __syncthreads();
  qkt(pA0, pA1, K_lds, qr, r32, hi); partialSM(pA0, pA1, m_reg, mnA, alA);
  SLOAD(SO, KVBLK); if (2 < NT) SLOAD(SE, 2 * KVBLK);
  SWAIT(); SWRITE(1, SO); __syncthreads();
  for (int j = 1; j + 1 < NT; j += 2) {
    SBAR(); qkt(pB0, pB1, (bf16_t*)((char*)K_lds + SHM_K), qr, r32, hi);
    finishSM(pA0, pA1, alA, l_reg, pa0, pa1, pa2, pa3); SBAR();
    SLOAD(SO, (j + 2) * KVBLK); SBAR();
    pv_d0(o, vb0, pa0, pa1, pa2, pa3); partialSM(pB0, pB1, m_reg, mnB, alB);
    __syncthreads(); SWAIT(); SWRITE(0, SE);
    RESC(alB); __syncthreads();
    SBAR(); qkt(pA0, pA1, K_lds, qr, r32, hi);
    finishSM(pB0, pB1, alB, l_reg, pa0, pa1, pa2, pa3); SBAR();
    if (j + 3 < NT) SLOAD(SE, (j + 3) * KVBLK); SBAR();
    pv_d0(o, vb0 + (int)SHM_V, pa0, pa1, pa2, pa3); partialSM(pA0, pA1, m_reg, mnA, alA);
    __syncthreads(); SWAIT(); SWRITE(1, SO);
    RESC(alA); __syncthreads();
  }
  SBAR(); qkt(pB0, pB1, (bf16_t*)((char*)K_lds + SHM_K), qr, r32, hi);
  finishSM(pA0, pA1, alA, l_reg, pa0, pa1, pa2, pa3); SBAR();
  pv_d0(o, vb0, pa0, pa1, pa2, pa3); partialSM(pB0, pB1, m_reg, mnB, alB);
  __syncthreads(); RESC(alB);
  finishSM(pB0, pB1, alB, l_reg, pa0, pa1, pa2, pa3); SBAR();
  pv_d0(o, vb0 + (int)SHM_V, pa0, pa1, pa2, pa3);
  if (hi == 0) li_l[r32] = l_reg; asm volatile("s_waitcnt lgkmcnt(0)" ::: "memory");
  float rli[16];
#pragma unroll
  for (int r = 0; r < 16; ++r) rli[r] = __builtin_amdgcn_rcpf(li_l[crow(r, hi)]);
  bf16_t* Ow = Ob + (long)(wid * QBLK) * LDO;
#pragma unroll
  for (int r = 0; r < 16; ++r) { int orow = crow(r, hi);
    for (int d0 = 0; d0 < 4; ++d0) { const float v = o[d0][r] * rli[r]; Ow[(long)orow * LDO + d0 * 32 + r32] = (bf16_t)(cvtpk(v, v) & 0xffffu); } }
  __syncthreads();
#undef LD8
#undef SLOAD
#undef SWRITE
#undef SWAIT
#undef RESC
}
#undef SBAR
}

constexpr int N_PHASES = 13;
__global__ void __launch_bounds__(NWAVES * 64, 2) fwd_kernel(Args args) {
    extern __shared__ __attribute__((aligned(16))) unsigned char lds_raw[];
    LAS unsigned char* lds = (LAS unsigned char*)lds_raw;
    volatile LAS unsigned* MISC = (volatile LAS unsigned*)(lds + MISC_OFF);
    const int tid = threadIdx.x, wave = __builtin_amdgcn_readfirstlane(tid >> 6);
    const int G = gridDim.x, bx = blockIdx.x;
    const int gw = bx * NWAVES + wave, NGW = G * NWAVES;
#define lane lane_id()
    gu32* ctl = (gu32*)(args.ws + WS_CTL);
    for (int u = tid; u < (LDS_BYTES - LDSCTL_OFF) / 4; u += NWAVES * 64) ((LAS unsigned*)(lds + LDSCTL_OFF))[u] = 0u;
    __syncthreads();
    XcdBarrier bar; bar.bar = (unsigned*)(ctl + CW_BAR); bar.x = 0; bar.st = nullptr;
    if (!MK_PER_PHASE) bar = xcd_barrier_post((unsigned*)(ctl + CW_BAR), MISC + 8);
    const int lo = args.ph_lo, hi = args.ph_hi;
#define IN(k) (lo <= (k) && (k) < hi)
#define SEAM(k) do { if (IN(k) && IN((k) + 1)) xcd_barrier(bar); } while (0)
#define W_IN ((bf16_t*)(args.ws + WS_WIN))
#define W_OUT ((bf16_t*)(args.ws + WS_WOUT))
#define W_POOL ((bf16_t*)(args.ws + WS_WPOOL))
#define W_M1 ((bf16_t*)(args.ws + WS_WM1))
#define W_M2 ((bf16_t*)(args.ws + WS_WM2))
#define Hb ((bf16_t*)(args.ws + WS_H))
#define ZB ((bf16_t*)(args.ws + WS_ZB))
#define LFb ((float*)(args.ws + WS_LF))
#define A2 ((bf16_t*)(args.ws + WS_A2))
#define XA ((float*)(args.ws + WS_XA))
#define Ub ((bf16_t*)(args.ws + WS_U))
#define MOD ((const float*)(args.ws + WS_MOD))
#define ROWSS ((float*)(args.ws + WS_ROWSS))
#define SW ((float*)(args.ws + WS_SW))
#define IDLE_FIRST(nwg) (((nwg) % G) ? ((nwg) % G) : 0)

    if (IN(0)) {
        const int hG = G / 2;
        if (bx < hG) { for (int wi = bx; wi < 128; wi += hG) p0_ada_item(args, lds, wi, tid); }
        else bg_transposes(args, lds, R_IN, R_OUT, (bx - hG) * NWAVES + wave, (G - hG) * NWAVES, wave, lane);
    }
    SEAM(0);
    if (IN(1)) norm_rows_bf16(args, nullptr, args.in[10], 0, 0, Hb, gw, NGW, lane);
    SEAM(1);
    if (IN(2)) { pg8::Gemm g{Hb, W_IN, NTOK, IN_AB, 2048, 2048, 2048, 0, 0}; pg8::StaticOrder S; S.init(NTOK, IN_AB, 2048, G, bx);
        EpiIn E{ZB, LFb, args.in[17]}; pg8::gemm_phase<EpiIn, pg8::StaticOrder>(lds, g, S, E);
        const int f = IDLE_FIRST(624); if (bx >= f) bg_transposes(args, lds, R_OUT, R_M2_0, (bx - f) * NWAVES + wave, (G - f) * NWAVES, wave, lane); }
    SEAM(2);
    if (IN(3)) {
        for (int row = gw; row < NTOK; row += NGW) post_token(args, row, lane);
        for (int it = gw; it < 1024; it += NGW) cache_item(args, it, lane);
        if (bx < 192) hgrn_task(args, lds, bx, tid);
        else bg_transposes(args, lds, R_M2_0, R_POOL, (bx - 192) * NWAVES + wave, (G - 192) * NWAVES, wave, lane);
    }
    SEAM(3);
    if (IN(4)) {
        if (bx < 192) { const int u = bx;
            const bf16_t *Q, *K, *V; bf16_t* O; int seq;
            if (u < 64) { const int b = u >> 5, h = (u >> 2) & 7, qb = u & 3; const size_t row0 = NTOK_P + b * SEQ_S + qb * 256;
                Q = (const bf16_t*)(args.ws + WS_QN) + row0 * 1024 + h * 128; O = A2 + row0 * DM + h * 128;
                K = (const bf16_t*)(args.ws + WS_KS) + (size_t)(b * 2 + (h >> 2)) * 1280 * 128; V = (const bf16_t*)(args.ws + WS_VS) + (size_t)(b * 2 + (h >> 2)) * 1280 * 128; seq = 1280; }
            else { const int v = u - 64, b = v >> 3, h = v & 7; const size_t row0 = b * 256;
                Q = (const bf16_t*)(args.ws + WS_QN) + row0 * 1024 + h * 128; O = A2 + row0 * DM + h * 128;
                K = (const bf16_t*)(args.ws + WS_KP) + (size_t)(b * 2 + (h >> 2)) * 256 * 128; V = (const bf16_t*)(args.ws + WS_VP) + (size_t)(b * 2 + (h >> 2)) * 256 * 128; seq = 256; }
            att::attn_dense_body(Q, K, V, O, seq, (char*)lds_raw);
        }
        if (bx >= 192) { for (int t = bx - 192; t < 64; t += G - 192) hgfix_task(args, lds, t, tid); }
        else if (bx >= 64) { for (int row = (bx - 64) * NWAVES + wave; row < NTOK_P; row += 128 * NWAVES) combine_token(args, row, lane); }
    }
    SEAM(4);
    if (IN(5)) { pg8::Gemm g{A2, W_OUT, NTOK, DM, 2048, 2048, 2048, 0, 0}; pg8::StaticOrder S; S.init(NTOK, DM, 2048, G, bx);
        EpiRes E{args.in[0], args.in[1], XA, MOD + 2 * 2048, nullptr, Hb, args.in[11], MOD + 4 * 2048, ROWSS}; pg8::gemm_phase<EpiRes, pg8::StaticOrder>(lds, g, S, E);
        const int f = IDLE_FIRST(192); if (bx >= f) for (int wi = 128 + (bx - f); wi < 256; wi += G - f) p0_ada_item(args, lds, wi, tid); }
    SEAM(5);
    if (IN(6)) { pg8::Gemm g{Hb, W_M1, NTOK, DFF, 2048, 2048, 2048, 0, 0}; pg8::StaticOrder S; S.init(NTOK, DFF, 2048, G, bx);
        EpiRelu2 E{Ub, ROWSS, SW}; pg8::gemm_phase<EpiRelu2, pg8::StaticOrder>(lds, g, S, E); }
    SEAM(6);
    if (IN(7)) { pg8::Gemm g{Ub, W_M2, NTOK, DM, DFF, DFF, DFF, 0, 0}; pg8::StaticOrder S; S.init(NTOK, DM, DFF, G, bx);
        EpiRes E{XA, XA + (size_t)NTOK_P * DM, XA, MOD + 5 * 2048, nullptr, nullptr, nullptr, nullptr, ROWSS + NTOK}; pg8::gemm_phase<EpiRes, pg8::StaticOrder>(lds, g, S, E);
        const int f = IDLE_FIRST(192); if (bx >= f) bg_transposes(args, lds, R_POOL, R_END, (bx - f) * NWAVES + wave, (G - f) * NWAVES, wave, lane); }
    SEAM(7);
    if (IN(8)) pool_phase(args, lds, XA, ROWSS + NTOK, Hb, bx, G, tid);
    SEAM(8);
    if (IN(9)) { pg8::Gemm g{Hb, W_POOL, NTOK, DM, 512, 2048, 512, 1, 512}; pg8::StaticOrder S; S.init(NTOK, DM, 512, G, bx);
        EpiRes E{XA, XA + (size_t)NTOK_P * DM, XA, MOD + NMODC + 2 * 2048, args.in[19], A2, args.in[11] + 2048, MOD + NMODC + 4 * 2048, ROWSS + 2 * NTOK}; pg8::gemm_phase<EpiRes, pg8::StaticOrder>(lds, g, S, E); }
    SEAM(9);
    if (IN(10)) { pg8::Gemm g{A2, W_M1 + (size_t)DFF * 2048, NTOK, DFF, 2048, 2048, 2048, 0, 0}; pg8::StaticOrder S; S.init(NTOK, DFF, 2048, G, bx);
        EpiRelu2 E{Ub, ROWSS + 2 * NTOK, SW + 3 * DFF}; pg8::gemm_phase<EpiRelu2, pg8::StaticOrder>(lds, g, S, E); }
    SEAM(10);
    if (IN(11)) { pg8::Gemm g{Ub, W_M2 + (size_t)2048 * DFF, NTOK, DM, DFF, DFF, DFF, 0, 0}; pg8::SplitOrder S; S.init(NTOK, DM, DFF, G, bx);
        EpiRes E{XA, XA + (size_t)NTOK_P * DM, XA, MOD + NMODC + 5 * 2048, nullptr, nullptr, nullptr, nullptr, ROWSS + 3 * NTOK};
        pg8::gemm_phase<EpiRes, pg8::SplitOrder>(lds, g, S, E, pg8::PartCtx{(float*)(args.ws + WS_PART), (unsigned*)(args.ws + WS_CTL) + CW_PFLAG, 11u}); }
    SEAM(11);
    if (IN(12)) final_rows(XA, ROWSS + 3 * NTOK, args.in[22], args.out, gw, NGW, lane);
#undef IN
#undef SEAM
#undef IDLE_FIRST
#undef lane
#undef W_IN
#undef W_OUT
#undef W_POOL
#undef W_M1
#undef W_M2
#undef Hb
#undef ZB
#undef LFb
#undef A2
#undef XA
#undef Ub
#undef MOD
#undef ROWSS
#undef SW
}

extern "C" void kernel_launch(void* const* d_in, const int* in_sizes, int n_in, void* d_out, int out_size, void* d_ws, size_t ws_size, hipStream_t stream) {
    static int grid = 0;
    if (grid == 0) {
        if (n_in != 23 || out_size != 18874368 || ws_size < WS_END) { fprintf(stderr, "kernel_launch: unexpected shapes (n_in %d out %d ws %zu)\n", n_in, out_size, ws_size); grid = -1; return; }
        int dev = 0, cus = 0;
        if (hipGetDevice(&dev) != hipSuccess || hipDeviceGetAttribute(&cus, hipDeviceAttributeMultiprocessorCount, dev) != hipSuccess) { grid = -1; return; }
        if (hipFuncSetAttribute((const void*)fwd_kernel, hipFuncAttributeMaxDynamicSharedMemorySize, LDS_BYTES) != hipSuccess) { fprintf(stderr, "kernel_launch: hipFuncSetAttribute failed\n"); grid = -1; return; }
        int per_cu = 0;
        if (hipOccupancyMaxActiveBlocksPerMultiprocessor(&per_cu, (const void*)fwd_kernel, NWAVES * 64, LDS_BYTES) != hipSuccess || per_cu < 1) fprintf(stderr, "kernel_launch: occupancy query says %d\n", per_cu);
        (void)hipGetLastError();
        if (cus != 256) { fprintf(stderr, "kernel_launch: built for a 256-CU device, found %d CUs\n", cus); grid = -1; return; }
        grid = cus;
    }
    if (grid < 0) return;
    (void)hipMemsetAsync((char*)d_ws + WS_CTL, 0, CTL_ZERO_BYTES, stream);
    Args a{};
    for (int i = 0; i < 23; ++i) a.in[i] = (const float*)d_in[i];
    a.out = (float*)d_out; a.ws = (unsigned char*)d_ws;
#if MK_PER_PHASE
    for (int p = 0; p < N_PHASES; ++p) { a.ph_lo = p; a.ph_hi = p + 1; hipLaunchKernelGGL(fwd_kernel, dim3(grid), dim3(NWAVES * 64), LDS_BYTES, stream, a);
        if (p == REP_PHASE) hipLaunchKernelGGL(fwd_kernel, dim3(grid), dim3(NWAVES * 64), LDS_BYTES, stream, a); }
#else
    a.ph_lo = 0; a.ph_hi = N_PHASES;
    hipLaunchKernelGGL(fwd_kernel, dim3(grid), dim3(NWAVES * 64), LDS_BYTES, stream, a);
#endif
}
```

```cpp
#include <hip/hip_runtime.h>
#include <hip/hip_bf16.h>
#include <cstdio>
#include <cstdint>

#ifndef MK_PER_PHASE
#define MK_PER_PHASE 0
#endif

#ifndef PROBE_PH
#define PROBE_PH -1
#endif
#define PROBE_K 8
#ifndef PROBE_A
#define PROBE_A (16 + PROBE_PH)
#define PROBE_B (17 + PROBE_PH)
#endif
#ifndef PROBE_GPH
#define PROBE_GPH -1
#endif
#ifndef REP_PHASE
#define REP_PHASE -1
#endif
constexpr int DM = 2048, NTOK_P = 4096, NTOK_S = 2048, NTOK = 6144, SEQ_P = 256, SEQ_S = 1024, NB_P = 16, NB_S = 2, PAST = 256;
constexpr int IN_AB = 6656, DFF = 8192, NMODC = 12288;
constexpr int C_Q = 0, C_K = 1024, C_V = 1280, C_HQ = 1536, C_ZF = 2560, C_ZB = 3584, C_HI = 4608, C_HG = 5632;
constexpr float EPS = 1e-6f;
constexpr int MISC_OFF = 131072 + 320;

#define GAS __attribute__((address_space(1)))
#define LAS __attribute__((address_space(3)))
typedef unsigned short bf16_t;
typedef short bf16x8 __attribute__((ext_vector_type(8)));
typedef short s16x4 __attribute__((ext_vector_type(4)));
typedef float f32x4 __attribute__((ext_vector_type(4)));
typedef float f32x2 __attribute__((ext_vector_type(2)));
typedef float f32x16 __attribute__((ext_vector_type(16)));
typedef unsigned u32x4 __attribute__((ext_vector_type(4)));
typedef unsigned u32x2 __attribute__((ext_vector_type(2)));
typedef __bf16 bf16x2_t __attribute__((ext_vector_type(2)));
typedef GAS unsigned gu32;

__device__ __forceinline__ unsigned cvtpk(float lo, float hi) { f32x2 v = {lo, hi}; bf16x2_t b = __builtin_convertvector(v, bf16x2_t); return __builtin_bit_cast(unsigned, b); }
__device__ __forceinline__ float bf2f(unsigned short u) { return __uint_as_float(((unsigned)u) << 16); }
__device__ __forceinline__ float bflo(unsigned u) { return __uint_as_float(u << 16); }
__device__ __forceinline__ float bfhi(unsigned u) { return __uint_as_float(u & 0xffff0000u); }
__device__ __forceinline__ float siluf(float x) { return x * __builtin_amdgcn_rcpf(1.f + __expf(-x)); }
__device__ __forceinline__ int lane_id() { int l; asm volatile("v_mbcnt_lo_u32_b32 %0, -1, 0\n\tv_mbcnt_hi_u32_b32 %0, -1, %0" : "=v"(l)); return l; }
__device__ __forceinline__ float wave_sum(float v) {
#pragma unroll
    for (int o = 1; o < 64; o <<= 1) v += __shfl_xor(v, o);
    return v;
}
__device__ __forceinline__ float half_sum(float v) {
#pragma unroll
    for (int o = 1; o < 32; o <<= 1) v += __shfl_xor(v, o);
    return v;
}

namespace pg8 {
#define PG8_LAS __attribute__((address_space(3)))
constexpr int BM = 256, BK = 64, HALF = 128, HTB = HALF * BK * 2, STAGE_BYTES = 8 * HTB, NXCD = 8, WGM = 8;
__host__ __device__ __forceinline__ int lds_byte(int r, int c) { const int st = (r >> 4) * 2 + (c >> 5), rr = r & 15, cc = c & 31, ob = rr * 64 + cc * 2; return st * 1024 + (ob ^ (((ob >> 9) & 1) << 5)); }
__host__ __device__ __forceinline__ void stage_rc(int b, int& R, int& C) { const int st = b / 1024, sb = b % 1024, swz = sb ^ (((sb >> 9) & 1) << 5); R = (st >> 1) * 16 + swz / 64; C = (st & 1) * 32 + (swz % 64) / 2; }
__host__ __device__ __forceinline__ int perm32(int rho) { const int n = rho >> 4, i = rho & 15; return 8 * (i >> 2) + 4 * n + (i & 3); }

struct Unit { int pm, pn, kt0, nkt, role, pidx; };
struct Gemm { const bf16_t* A; const bf16_t* Bt; int M, N, K, lda, ldb, apn_shift, apn_mul; };
struct PartCtx { float* part; unsigned* flags; unsigned epoch; };

struct StaticOrder {
    int nM, nN, nwg, G, c, nkt;
    __host__ __device__ void init(int M, int N, int K, int G_, int c_) { nM = M / BM; nN = N / BM; nwg = nM * nN; G = G_; c = c_; nkt = K / BK; }
    __host__ __device__ void unit_of(int L, Unit& u) const {
        int wgid = L; { const int q = nwg / NXCD, r = nwg % NXCD, xcd = wgid % NXCD, off = wgid / NXCD; wgid = (xcd < r ? xcd * (q + 1) : r * (q + 1) + (xcd - r) * q) + off; }
        const int nig = WGM * nN, gid = wgid / nig, fm = gid * WGM, gsz = (nM - fm) < WGM ? (nM - fm) : WGM;
        u.pm = fm + ((wgid % nig) % gsz); u.pn = (wgid % nig) / gsz;
    }
    __host__ __device__ bool next(int i, Unit& u) const {
        const long L = (long)i * G + c; if (L >= nwg) return false;
        unit_of((int)L, u); u.kt0 = 0; u.nkt = nkt; u.role = 0; u.pidx = 0; return true;
    }
};
struct SplitOrder {
    StaticOrder S;
    __host__ __device__ void init(int M, int N, int K, int G_, int c_) { S.init(M, N, K, G_, c_); }
    __host__ __device__ bool next(int i, Unit& u) const {
        const int q = S.nkt / 4;
        if (S.c < S.nwg) { if (i > 0) return false; S.unit_of(S.c, u); u.kt0 = 0; u.nkt = 3 * q; u.role = 1; u.pidx = S.c; return true; }
        if (i >= 3) return false;
        const int L = 3 * (S.c - S.nwg) + i; if (L >= S.nwg) return false;
        S.unit_of(L, u); u.kt0 = 3 * q; u.nkt = q; u.role = 2; u.pidx = L; return true;
    }
};
struct TailSplitOrder {
    StaticOrder S;
    __host__ __device__ void init(int M, int N, int K, int G_, int c_) { S.init(M, N, K, G_, c_); }
    __host__ __device__ bool next(int i, Unit& u) const {
        if (i < 2) return S.next(i, u);
        if (i > 2) return false;
        const int r = S.nwg - 2 * S.G, p = S.c >> 1; if (p >= r) return false;
        S.unit_of(2 * S.G + p, u); const int h = S.nkt / 2;
        if (S.c & 1) { u.kt0 = h; u.nkt = h; u.role = 2; } else { u.kt0 = 0; u.nkt = h; u.role = 1; }
        u.pidx = p; return true;
    }
};

template <class Epi, class Sched, bool ALIGN_EPI = true>
__device__ __forceinline__ void gemm_phase(PG8_LAS unsigned char* lds, const Gemm g, const Sched& S, const Epi& E, const PartCtx pc = PartCtx{nullptr, nullptr, 0u}) {
    const int tid = threadIdx.x, wid = __builtin_amdgcn_readfirstlane(tid >> 6), lane = tid & 63, wr = wid >> 2, wc = wid & 3, fr = lane & 15, fq = lane >> 4;
    unsigned voffA[2], voffB[2];
#pragma unroll
    for (int i = 0; i < 2; ++i) { int R, C; stage_rc(tid * 16 + i * 8192, R, C); const int Rb = Epi::PERM ? ((R & ~31) + perm32(R & 31)) : R;
        voffA[i] = (unsigned)(R * g.lda + C) * 2u; voffB[i] = (unsigned)(Rb * g.ldb + C) * 2u; }
    const size_t kstep = (size_t)(BK * 2);
    const size_t hstepA = (size_t)HALF * g.lda * 2, hstepB = (size_t)HALF * g.ldb * 2;
    const size_t tstepA = 2 * hstepA, tstepB = 2 * hstepB;
    const unsigned ldsw = (unsigned)wid * 1024u;
    const int aoff = lds_byte(wr * 64 + fr, fq * 8), boff = lds_byte(wc * 32 + fr, fq * 8);
#define PG8_SA(b, h) (((b) * 2 + (h)) * HTB)
#define PG8_SB(b, h) ((4 + (b) * 2 + (h)) * HTB)
#define PG8_STAGE(bufoff, gbase, voff) do { _Pragma("unroll") for (int _i = 0; _i < 2; ++_i) \
        __builtin_amdgcn_global_load_lds((const unsigned*)((const char*)(gbase) + (voff)[_i]), (PG8_LAS unsigned*)(lds + (bufoff) + ldsw + _i * 8192), 16, 0, 0); } while (0)
#define PG8_LDA(dst, b, h) do { _Pragma("unroll") for (int m = 0; m < 4; ++m) _Pragma("unroll") for (int k = 0; k < 2; ++k) dst[m][k] = *(const PG8_LAS bf16x8*)(lds + PG8_SA(b, h) + aoff + m * 2048 + k * 1024); } while (0)
#define PG8_LDB(dst, b, h) do { _Pragma("unroll") for (int n = 0; n < 2; ++n) _Pragma("unroll") for (int k = 0; k < 2; ++k) dst[n][k] = *(const PG8_LAS bf16x8*)(lds + PG8_SB(b, h) + boff + n * 2048 + k * 1024); } while (0)
#define PG8_MMA(ai, bj, At, Bt) do { __builtin_amdgcn_s_setprio(1); _Pragma("unroll") for (int m = 0; m < 4; ++m) _Pragma("unroll") for (int n = 0; n < 2; ++n) _Pragma("unroll") for (int k = 0; k < 2; ++k) \
        acc[ai][bj][m][n] = __builtin_amdgcn_mfma_f32_16x16x32_bf16(Bt[n][k], At[m][k], acc[ai][bj][m][n], 0, 0, 0); __builtin_amdgcn_s_setprio(0); } while (0)
#define PG8_WAIT_V(n) asm volatile("s_waitcnt vmcnt(" #n ")" ::: "memory")
#define PG8_WAIT_L(n) asm volatile("s_waitcnt lgkmcnt(" #n ")" ::: "memory")
#define PG8_BAR __builtin_amdgcn_s_barrier()
#define PG8_SCHED __builtin_amdgcn_sched_barrier(0)
#define PG8_AOFF(u) ((size_t)(((u).pn >> g.apn_shift) * g.apn_mul) * 2)
#define GSTAMP(i) do { if (PROBE_PH >= 0 && PROBE_GPH >= 0 && blockIdx.x == 0 && tid == 0) { volatile PG8_LAS unsigned* M_ = (volatile PG8_LAS unsigned*)(lds + MISC_OFF); if (M_[15] == (unsigned)PROBE_GPH) M_[40 + (i)] = (unsigned)__builtin_amdgcn_s_memrealtime(); } } while (0)
    Unit cur, nxt; int ui = 0;
    if (!S.next(0, cur)) return;
    GSTAMP(0);
    f32x4 acc[2][2][4][2];
#pragma unroll
    for (int a = 0; a < 2; ++a)
#pragma unroll
        for (int b = 0; b < 2; ++b)
#pragma unroll
            for (int m = 0; m < 4; ++m)
#pragma unroll
                for (int n = 0; n < 2; ++n) acc[a][b][m][n] = (f32x4){0.f, 0.f, 0.f, 0.f};
    bf16x8 At[4][2], B0[2][2], B1[2][2];
    const char* cA = (const char*)g.A + (size_t)cur.pm * tstepA + PG8_AOFF(cur) + (size_t)cur.kt0 * kstep; const char* cB = (const char*)g.Bt + (size_t)cur.pn * tstepB + (size_t)cur.kt0 * kstep;
    {
        PG8_STAGE(PG8_SB(0, 0), cB, voffB); PG8_STAGE(PG8_SB(0, 1), cB + hstepB, voffB); PG8_STAGE(PG8_SA(0, 0), cA, voffA); PG8_STAGE(PG8_SA(0, 1), cA + hstepA, voffA);
        if (wr == 1) PG8_BAR;
        PG8_WAIT_V(2); PG8_BAR;
        PG8_STAGE(PG8_SB(1, 0), cB + kstep, voffB); PG8_STAGE(PG8_SA(1, 0), cA + kstep, voffA); PG8_STAGE(PG8_SB(1, 1), cB + hstepB + kstep, voffB);
        PG8_WAIT_V(6); PG8_BAR;
    }
    for (;;) {
        const bool has_next = S.next(ui + 1, nxt);
        const char* nA = has_next ? (const char*)g.A + (size_t)nxt.pm * tstepA + PG8_AOFF(nxt) + (size_t)nxt.kt0 * kstep : cA; const char* nB = has_next ? (const char*)g.Bt + (size_t)nxt.pn * tstepB + (size_t)nxt.kt0 * kstep : cB;
        const int nt = cur.nkt;
        for (int t = 0; t < nt; t += 2) {
            const bool last = (t == nt - 2);
            const char* a1 = cA + (size_t)(t + 1) * kstep;
            const char* a2 = last ? nA : cA + (size_t)(t + 2) * kstep; const char* b2 = last ? nB : cB + (size_t)(t + 2) * kstep;
            const char* a3 = a2 + kstep; const char* b3 = b2 + kstep;
            PG8_LDB(B0, 0, 0); PG8_LDB(B1, 0, 1); PG8_SCHED; PG8_LDA(At, 0, 0); PG8_STAGE(PG8_SA(1, 1), a1 + hstepA, voffA);
            PG8_WAIT_V(8); PG8_WAIT_L(0); PG8_BAR; PG8_MMA(0, 0, At, B0); PG8_MMA(0, 1, At, B1); PG8_BAR; PG8_SCHED;
            PG8_LDA(At, 0, 1); PG8_STAGE(PG8_SB(0, 0), b2, voffB); PG8_STAGE(PG8_SB(0, 1), b2 + hstepB, voffB); PG8_STAGE(PG8_SA(0, 0), a2, voffA);
            PG8_WAIT_V(8); PG8_WAIT_L(0); PG8_BAR; PG8_MMA(1, 0, At, B0); PG8_MMA(1, 1, At, B1); PG8_BAR; PG8_SCHED;
            PG8_LDB(B0, 1, 0); PG8_LDB(B1, 1, 1); PG8_SCHED; PG8_LDA(At, 1, 0); PG8_STAGE(PG8_SA(0, 1), a2 + hstepA, voffA);
            PG8_WAIT_V(8); PG8_WAIT_L(0); PG8_BAR; PG8_MMA(0, 0, At, B0); PG8_MMA(0, 1, At, B1); PG8_BAR; PG8_SCHED;
            PG8_LDA(At, 1, 1); PG8_STAGE(PG8_SB(1, 0), b3, voffB); PG8_STAGE(PG8_SB(1, 1), b3 + hstepB, voffB); PG8_STAGE(PG8_SA(1, 0), a3, voffA);
            PG8_WAIT_V(8); PG8_WAIT_L(0); PG8_BAR; PG8_MMA(1, 0, At, B0); PG8_MMA(1, 1, At, B1); PG8_BAR; PG8_SCHED;
        }
        if constexpr (ALIGN_EPI) { if (wr == 0) PG8_BAR; }
        GSTAMP(1);
        if (cur.role == 2) {
            const __amdgpu_buffer_rsrc_t pr = __builtin_amdgcn_make_buffer_rsrc((void*)(pc.part + (size_t)cur.pidx * 65536), 0, 262144, 0x00020000);
            const unsigned pb = (unsigned)(wid * 2048 + lane) * 16u;
#pragma unroll
            for (int a = 0; a < 2; ++a)
#pragma unroll
                for (int b = 0; b < 2; ++b)
#pragma unroll
                    for (int m = 0; m < 4; ++m)
#pragma unroll
                        for (int n = 0; n < 2; ++n) __builtin_amdgcn_raw_buffer_store_b128(__builtin_bit_cast(u32x4, acc[a][b][m][n]), pr, pb + (unsigned)((((a * 2 + b) * 4 + m) * 2 + n) * 1024), 0, 16);
            asm volatile("s_waitcnt vmcnt(0)" ::: "memory"); PG8_BAR;
            if (tid == 0) __hip_atomic_store(pc.flags + 16 * cur.pidx, pc.epoch, __ATOMIC_RELAXED, __HIP_MEMORY_SCOPE_AGENT);
        } else {
            if (cur.role == 1) {
                if (wid == 0) { unsigned sp = 0; while (__hip_atomic_load(pc.flags + 16 * cur.pidx, __ATOMIC_RELAXED, __HIP_MEMORY_SCOPE_AGENT) != pc.epoch) { __builtin_amdgcn_s_sleep(2); if (++sp > (1u << 22)) break; }
                    __builtin_amdgcn_fence(__ATOMIC_ACQUIRE, "agent"); asm volatile("s_waitcnt vmcnt(0)" ::: "memory"); }
                PG8_BAR; asm volatile("" ::: "memory");
                const f32x4* ps = (const f32x4*)(pc.part + (size_t)cur.pidx * 65536) + wid * 2048 + lane;
#pragma unroll
                for (int a = 0; a < 2; ++a)
#pragma unroll
                    for (int b = 0; b < 2; ++b)
#pragma unroll
                        for (int m = 0; m < 4; ++m)
#pragma unroll
                            for (int n = 0; n < 2; ++n) acc[a][b][m][n] += ps[(((a * 2 + b) * 4 + m) * 2 + n) * 64];
            }
            E(acc, cur, wr, wc, fr, fq);
        }
        GSTAMP(2);
        if (!has_next) break;
#pragma unroll
        for (int a = 0; a < 2; ++a)
#pragma unroll
            for (int b = 0; b < 2; ++b)
#pragma unroll
                for (int m = 0; m < 4; ++m)
#pragma unroll
                    for (int n = 0; n < 2; ++n) acc[a][b][m][n] = (f32x4){0.f, 0.f, 0.f, 0.f};
        cur = nxt; cA = nA; cB = nB; ++ui;
        if constexpr (ALIGN_EPI) { if (wr == 1) PG8_BAR; }
    }
    PG8_WAIT_V(0);
    if constexpr (!ALIGN_EPI) { if (wr == 0) PG8_BAR; }
    PG8_BAR;
    GSTAMP(3);
#undef GSTAMP
#undef PG8_SA
#undef PG8_SB
#undef PG8_STAGE
#undef PG8_LDA
#undef PG8_LDB
#undef PG8_MMA
#undef PG8_WAIT_V
#undef PG8_WAIT_L
#undef PG8_BAR
#undef PG8_SCHED
#undef PG8_AOFF
}
}

constexpr size_t MiB = 1u << 20;
constexpr size_t WS_CTL = 0, CTL_ZERO_BYTES = 704 * 1024;
constexpr size_t WS_ROWSS = 64 * 1024;
constexpr size_t WS_SW = 160 * 1024;
constexpr size_t WS_MOD = 384 * 1024;
constexpr size_t WS_WIN = 2 * MiB;
constexpr size_t WS_WOUT = 28 * MiB;
constexpr size_t WS_WPOOL = 36 * MiB;
constexpr size_t WS_WM1 = 38 * MiB;
constexpr size_t WS_WM2 = 102 * MiB;
constexpr size_t WS_H = 166 * MiB;
constexpr size_t WS_ZB = 190 * MiB;
constexpr size_t WS_LF = 268 * MiB;
constexpr size_t WS_QN = 316 * MiB;
constexpr size_t WS_KP = 328 * MiB;
constexpr size_t WS_VP = 330 * MiB;
constexpr size_t WS_KS = 332 * MiB;
constexpr size_t WS_VS = 334 * MiB;
constexpr size_t WS_OF = 336 * MiB;
constexpr size_t WS_OB = 360 * MiB;
constexpr size_t WS_A2 = 384 * MiB;
constexpr size_t WS_XA = 408 * MiB;
constexpr size_t WS_U = 456 * MiB;
constexpr size_t WS_SEND = 552 * MiB;
constexpr size_t WS_LSEG = 560 * MiB;
constexpr size_t WS_PART = 562 * MiB;
constexpr size_t WS_END = 610 * MiB;
constexpr int CW_BAR = 1024;
constexpr int CW_PFLAG = 8192;

constexpr int RING_BYTES = 131072, LDSCTL_OFF = RING_BYTES, LDS_BYTES = 147456;
constexpr int NWAVES = 8;

#define RLX_AGENT __ATOMIC_RELAXED, __HIP_MEMORY_SCOPE_AGENT
#define LDS_WAIT() asm volatile("s_waitcnt lgkmcnt(0)" ::: "memory")
#define VM_WAIT() asm volatile("s_waitcnt vmcnt(0)" ::: "memory")

#define XB_TMO      128
#define XB_XCNT(j)  (256  + 64 * (j))
#define XB_XSUB(j)  (1280 + 64 * (j))
#define XB_XGEN(j)  (2304 + 64 * (j))
#define XB_TOP      3328
#define XB_TOPGEN   3392
#define XCD_BAR_WORDS 3456
#define XB_SPIN_CAP (1u << 18)
__device__ __forceinline__ unsigned xb_ld(unsigned* p)              { return __hip_atomic_load(p, __ATOMIC_RELAXED, __HIP_MEMORY_SCOPE_AGENT); }
__device__ __forceinline__ unsigned xb_add(unsigned* p, unsigned v) { return __hip_atomic_fetch_add(p, v, __ATOMIC_RELAXED, __HIP_MEMORY_SCOPE_AGENT); }
__device__ __forceinline__ unsigned xb_xcc_id() { return (unsigned)__builtin_amdgcn_s_getreg((3 << 11) | 20) & 0xFu; }
#define XB_SPIN(cond, bar) do { unsigned _sp = 0; while (cond) { __builtin_amdgcn_s_sleep(1); \
    if ((++_sp & 255u) == 0u) { if (xb_ld(&(bar)[XB_TMO])) break; if (_sp > XB_SPIN_CAP) { atomicAdd(&(bar)[XB_TMO], 1u); break; } } } } while (0)
struct XcdBarrier { unsigned* bar; unsigned x; volatile LAS unsigned* st; };
__device__ __forceinline__ XcdBarrier xcd_barrier_post(unsigned* bar, volatile LAS unsigned* st) {
    XcdBarrier b; b.bar = bar; b.x = xb_xcc_id(); b.st = st;
    if (threadIdx.x == 0) (void)xb_add(&bar[XB_XCNT(b.x)], 1u);
    return b;
}
__device__ __forceinline__ void xcd_barrier_complete(unsigned* bar, unsigned x, unsigned& nloc, unsigned& nx) {
    const unsigned G = gridDim.x * gridDim.y * gridDim.z;
    unsigned sum, cnt, mine, sp = 0u;
    for (;;) {
        sum = 0u; cnt = 0u; mine = 0u;
#pragma unroll
        for (unsigned j = 0; j < 16; ++j) { const unsigned c = xb_ld(&bar[XB_XCNT(j)]); sum += c; cnt += (c > 0u) ? 1u : 0u; mine = (j == x) ? c : mine; }
        if (sum == G) break;
        __builtin_amdgcn_s_sleep(1);
        if ((++sp & 255u) == 0u) { if (xb_ld(&bar[XB_TMO])) break; if (sp > XB_SPIN_CAP) { atomicAdd(&bar[XB_TMO], 1u); break; } }
    }
    nloc = mine > 0u ? mine : 1u; nx = cnt > 0u ? cnt : 1u;
}
__device__ __forceinline__ void xcd_barrier(const XcdBarrier& b) {
    asm volatile("s_waitcnt vmcnt(0)" ::: "memory");
    __syncthreads();
    if (threadIdx.x == 0) {
        unsigned* bar = b.bar;
        __builtin_amdgcn_s_waitcnt(0);
        unsigned nloc = b.st[0], nx = b.st[1];
        if (nloc == 0u) { xcd_barrier_complete(bar, b.x, nloc, nx); b.st[0] = nloc; b.st[1] = nx; }
        const unsigned old = xb_add(&bar[XB_XSUB(b.x)], 1u);
        const unsigned gen = old / nloc;
        if (old + 1u == (gen + 1u) * nloc) {
            __builtin_amdgcn_fence(__ATOMIC_RELEASE, "agent");
            asm volatile("s_waitcnt vmcnt(0)" ::: "memory");
            const unsigned og = xb_add(&bar[XB_TOP], 1u);
            const unsigned tg = og / nx;
            if (og + 1u == (tg + 1u) * nx) xb_add(&bar[XB_TOPGEN], 1u);
            else XB_SPIN(xb_ld(&bar[XB_TOPGEN]) == tg, bar);
            __builtin_amdgcn_fence(__ATOMIC_ACQUIRE, "agent");
            xb_add(&bar[XB_XGEN(b.x)], 1u);
            asm volatile("s_waitcnt vmcnt(0)" ::: "memory");
        } else {
            XB_SPIN(xb_ld(&bar[XB_XGEN(b.x)]) == gen, bar);
            __builtin_amdgcn_fence(__ATOMIC_ACQUIRE, "agent");
            asm volatile("s_waitcnt vmcnt(0)" ::: "memory");
        }
    }
    __syncthreads();
}

struct Args { const float* in[23]; float* out; unsigned char* ws; int ph_lo, ph_hi; };

__device__ __forceinline__ int cvec_of_row(int row) { return row < NTOK_P ? 0 : 1 + ((row - NTOK_P) >> 10); }
__device__ __forceinline__ const float* xin_row(const Args& a, int row) { return row < NTOK_P ? a.in[0] + (size_t)row * DM : a.in[1] + (size_t)(row - NTOK_P) * DM; }

struct EpiIn {
    static constexpr bool PERM = true;
    bf16_t* ZB; float* LF; const float* lb_raw;
    __device__ __forceinline__ void operator()(const f32x4 (&acc)[2][2][4][2], const pg8::Unit& u, int wr, int wc, int fr, int fq) const {
        const int row0 = u.pm * 256 + wr * 64 + fr, colt = u.pn * 256, cl = wc * 32 + 8 * fq;
        if (colt >= C_ZF && colt < C_HI) {
#pragma unroll
            for (int bj = 0; bj < 2; ++bj) {
                const int c2 = colt + bj * 128 + cl - C_ZF, dir = c2 >> 10, ch = c2 & 1023;
                float lb[8];
#pragma unroll
                for (int e = 0; e < 8; ++e) { const float x0 = lb_raw[dir * 3072 + ch + e], x1 = lb_raw[dir * 3072 + 1024 + ch + e], x2 = lb_raw[dir * 3072 + 2048 + ch + e];
                    lb[e] = 1.f / (1.f + __expf(x1 - x0) + __expf(x2 - x0)); }
#pragma unroll
                for (int ai = 0; ai < 2; ++ai)
#pragma unroll
                    for (int m = 0; m < 4; ++m) {
                        float* dst = LF + (size_t)(row0 + ai * 128 + m * 16) * 2048 + c2;
                        f32x4 o[2];
#pragma unroll
                        for (int n = 0; n < 2; ++n)
#pragma unroll
                            for (int e = 0; e < 4; ++e) { const float z = acc[ai][bj][m][n][e], sg = __builtin_amdgcn_rcpf(1.f + __expf(-z)), l = lb[n * 4 + e]; o[n][e] = __logf(l + (1.f - l) * sg); }
                        *(f32x4*)dst = o[0]; *(f32x4*)(dst + 4) = o[1];
                    }
            }
        } else {
            const bool act = (colt >= C_HQ && colt < C_ZF) || colt >= C_HG;
#pragma unroll
            for (int ai = 0; ai < 2; ++ai)
#pragma unroll
                for (int m = 0; m < 4; ++m) {
                    bf16_t* rowp = ZB + (size_t)(row0 + ai * 128 + m * 16) * IN_AB + colt + cl;
#pragma unroll
                    for (int bj = 0; bj < 2; ++bj) { f32x4 v0 = acc[ai][bj][m][0], v1 = acc[ai][bj][m][1];
                        if (act) {
#pragma unroll
                            for (int e = 0; e < 4; ++e) { v0[e] = siluf(v0[e]); v1[e] = siluf(v1[e]); } }
                        u32x4 w; w.x = cvtpk(v0[0], v0[1]); w.y = cvtpk(v0[2], v0[3]); w.z = cvtpk(v1[0], v1[1]); w.w = cvtpk(v1[2], v1[3]);
                        *(u32x4*)(rowp + bj * 128) = w; }
                }
        }
    }
};
struct EpiRes {
    static constexpr bool PERM = false;
    const float* baseP; const float* baseS; float* out; const float* gate; const float* pscale;
    bf16_t* XG; const float* ngain; const float* nsc;
    float* rowss;
    __device__ __forceinline__ void operator()(const f32x4 (&acc)[2][2][4][2], const pg8::Unit& u, int wr, int wc, int fr, int fq) const {
        const int cv = u.pm < 16 ? 0 : 1 + ((u.pm - 16) >> 2);
        const int ucol = u.pn * 256 + wc * 32;
        const float* gp = gate + (size_t)cv * 2 * NMODC + ucol;
        const char* bpu = (const char*)(u.pm < 16 ? baseP + (size_t)u.pm * 256 * DM : baseS + (size_t)(u.pm - 16) * 256 * DM) + ((size_t)wr * 64 * DM + ucol) * 4;
        char* opu = (char*)(out + (size_t)u.pm * 256 * DM) + ((size_t)wr * 64 * DM + ucol) * 4;
        char* xgu = (char*)(XG + (size_t)u.pm * 256 * DM) + ((size_t)wr * 64 * DM + ucol) * 2;
        const unsigned lv = (unsigned)(fr * DM + 4 * fq) * 4u, lv2 = (unsigned)(fr * DM + 4 * fq) * 2u, lq = (unsigned)fq * 16u;
        float ss[2][4];
#pragma unroll
        for (int ai = 0; ai < 2; ++ai)
#pragma unroll
            for (int m = 0; m < 4; ++m) ss[ai][m] = 0.f;
        f32x4 bcur[4], bnxt[4];
#define ER_UOFF(q, m) ((size_t)((((q) & 1) * 128 + (m) * 16) * DM + ((q) >> 2) * 128 + (((q) >> 1) & 1) * 16))
#define ER_LOAD(dst, q) do { _Pragma("unroll") for (int m = 0; m < 4; ++m) dst[m] = *(const f32x4*)(bpu + ER_UOFF(q, m) * 4 + lv); } while (0)
        ER_LOAD(bcur, 0);
        f32x4 g4 = {0.f, 0.f, 0.f, 0.f}, gm = g4;
#pragma unroll
        for (int q = 0; q < 8; ++q) {
            const int bj = q >> 2, n = (q >> 1) & 1, ai = q & 1, cu = bj * 128 + n * 16;
            if (ai == 0) { g4 = *(const f32x4*)((const char*)(gp + cu) + lq);
                if (pscale) g4 = g4 * *(const f32x4*)((const char*)(pscale + ucol + cu) + lq);
                if (XG) gm = *(const f32x4*)((const char*)(ngain + ucol + cu) + lq) * (*(const f32x4*)((const char*)(nsc + (size_t)cv * 2 * NMODC + ucol + cu) + lq) + 1.f); }
            if (q < 7) ER_LOAD(bnxt, q + 1);
            asm volatile("" ::: "memory");
#pragma unroll
            for (int m = 0; m < 4; ++m) {
                const f32x4 x = bcur[m] + g4 * acc[ai][bj][m][n]; *(f32x4*)(opu + ER_UOFF(q, m) * 4 + lv) = x;
                ss[ai][m] += (x.x * x.x + x.y * x.y) + (x.z * x.z + x.w * x.w);
                if (XG) { const f32x4 y = x * gm; u32x2 w; w.x = cvtpk(y.x, y.y); w.y = cvtpk(y.z, y.w); *(u32x2*)(xgu + ER_UOFF(q, m) * 2 + lv2) = w; } }
            asm volatile("" ::: "memory");
#pragma unroll
            for (int m = 0; m < 4; ++m) bcur[m] = bnxt[m];
        }
#undef ER_LOAD
#undef ER_UOFF
#pragma unroll
        for (int ai = 0; ai < 2; ++ai)
#pragma unroll
            for (int m = 0; m < 4; ++m) { float s = ss[ai][m]; s += __shfl_xor(s, 16); s += __shfl_xor(s, 32);
                if (fq == 0) atomicAdd(rowss + u.pm * 256 + ai * 128 + wr * 64 + m * 16 + fr, s); }
    }
};
struct EpiRelu2 {
    static constexpr bool PERM = true;
    bf16_t* U; const float* rowss; const float* sW;
    __device__ __forceinline__ void operator()(const f32x4 (&acc)[2][2][4][2], const pg8::Unit& u, int wr, int wc, int fr, int fq) const {
        const int row0 = u.pm * 256 + wr * 64 + fr, col0 = u.pn * 256 + wc * 32 + 8 * fq;
        const int cv = u.pm < 16 ? 0 : 1 + ((u.pm - 16) >> 2);
        f32x4 sw[2][2];
#pragma unroll
        for (int bj = 0; bj < 2; ++bj)
#pragma unroll
            for (int n = 0; n < 2; ++n) sw[bj][n] = *(const f32x4*)(sW + (size_t)cv * DFF + col0 + bj * 128 + 4 * n);
#pragma unroll
        for (int ai = 0; ai < 2; ++ai)
#pragma unroll
            for (int m = 0; m < 4; ++m) { const int row = row0 + ai * 128 + m * 16; bf16_t* rowp = U + (size_t)row * DFF + col0;
                const float rs = rsqrtf(rowss[row] * (1.f / DM) + EPS);
#pragma unroll
                for (int bj = 0; bj < 2; ++bj) { f32x4 v0 = acc[ai][bj][m][0] * rs + sw[bj][0], v1 = acc[ai][bj][m][1] * rs + sw[bj][1];
#pragma unroll
                    for (int e = 0; e < 4; ++e) { const float a = fmaxf(v0[e], 0.f), b = fmaxf(v1[e], 0.f); v0[e] = a * a; v1[e] = b * b; }
                    u32x4 w; w.x = cvtpk(v0[0], v0[1]); w.y = cvtpk(v0[2], v0[3]); w.z = cvtpk(v1[0], v1[1]); w.w = cvtpk(v1[2], v1[3]);
                    *(u32x4*)(rowp + bj * 128) = w; } }
    }
};

struct TrDesc { const float* W; bf16_t* WT; const float* shp; float* sWp; int K, N, row_off, item; };
__device__ __forceinline__ void tr_load(const TrDesc& d, f32x4 (&v)[8], int lane) {
    const int nblk = d.N / 32, kb = d.item / nblk, nb = d.item % nblk, k0 = 64 * kb, n0 = 32 * nb;
    const float* p = d.W + (size_t)(k0 + (lane >> 3)) * d.N + n0 + 4 * (lane & 7);
#pragma unroll
    for (int i = 0; i < 8; ++i) v[i] = __builtin_nontemporal_load((const f32x4*)(p + (size_t)(8 * i) * d.N));
}
__device__ __forceinline__ void tr_lds_write(const f32x4 (&v)[8], LAS float* scr, int lane) {
#pragma unroll
    for (int i = 0; i < 8; ++i) *(LAS f32x4*)(scr + (8 * i + (lane >> 3)) * 32 + ((4 * (lane & 7)) ^ (4 * i))) = v[i];
}
__device__ __forceinline__ void tr_finish(const TrDesc& d, LAS float* scr, int lane) {
    const int nblk = d.N / 32, kb = d.item / nblk, nb = d.item % nblk, k0 = 64 * kb, n0 = 32 * nb;
    if (d.shp) {
        const float h0 = d.shp[k0 + lane], h1 = d.shp[2 * NMODC + k0 + lane], h2 = d.shp[4 * NMODC + k0 + lane];
        float s0 = 0.f, s1 = 0.f, s2 = 0.f; const int n = lane & 31;
#pragma unroll 4
        for (int k = 0; k < 64; ++k) { const float w = scr[k * 32 + (n ^ (4 * ((k >> 3) & 7)))];
            s0 += w * __builtin_bit_cast(float, __builtin_amdgcn_readlane(__builtin_bit_cast(int, h0), k));
            s1 += w * __builtin_bit_cast(float, __builtin_amdgcn_readlane(__builtin_bit_cast(int, h1), k));
            s2 += w * __builtin_bit_cast(float, __builtin_amdgcn_readlane(__builtin_bit_cast(int, h2), k)); }
        if (lane < 32) { atomicAdd(d.sWp + n0 + n, s0); atomicAdd(d.sWp + DFF + n0 + n, s1); atomicAdd(d.sWp + 2 * DFF + n0 + n, s2); }
    }
    const int c = lane & 7;
#pragma unroll
    for (int j = 0; j < 4; ++j) { const int n = (lane >> 3) + 8 * j; const LAS float* s = scr + (8 * c) * 32 + (n ^ (4 * c));
        u32x4 o; o.x = cvtpk(s[0 * 32], s[1 * 32]); o.y = cvtpk(s[2 * 32], s[3 * 32]); o.z = cvtpk(s[4 * 32], s[5 * 32]); o.w = cvtpk(s[6 * 32], s[7 * 32]);
        *(u32x4*)(d.WT + (size_t)(d.row_off + n0 + n) * d.K + k0 + 8 * c) = o; }
}
__device__ __forceinline__ void p0_ada_item(const Args& a, LAS unsigned char* lds, int wi, int tid) {
    LAS float* sc = (LAS float*)lds;
    LAS float* part = (LAS float*)(lds + 1024);
    const int l = wi >> 8, cc = (wi & 255) >> 5, ks = wi & 31, k0 = 64 * ks, c0 = 1536 * cc;
    if (tid < 192) { const int v = tid >> 6, k = k0 + (tid & 63); const float x = v == 0 ? a.in[7][k] : a.in[6][(v - 1) * 2048 + k]; sc[tid] = siluf(x); }
    __syncthreads();
    if (tid < 384) {
        f32x4 a0 = {0.f, 0.f, 0.f, 0.f}, a1 = a0, a2 = a0;
        const float* wp = a.in[8] + ((size_t)l * 2048 + k0) * NMODC + c0 + 4 * tid;
        f32x4 wA[8], wB[8], wC[8];
#define ADA_LD(dst, b) do { _Pragma("unroll") for (int r_ = 0; r_ < 8; ++r_) dst[r_] = __builtin_nontemporal_load((const f32x4*)(wp + (size_t)((b) * 8 + r_) * NMODC)); } while (0)
#define ADA_FMA(srcv, b) do { _Pragma("unroll") for (int r_ = 0; r_ < 8; ++r_) { const int r = (b) * 8 + r_; a0 += srcv[r_] * sc[r]; a1 += srcv[r_] * sc[64 + r]; a2 += srcv[r_] * sc[128 + r]; } } while (0)
        ADA_LD(wA, 0); ADA_LD(wB, 1); ADA_LD(wC, 2); asm volatile("" ::: "memory");
        ADA_FMA(wA, 0); ADA_LD(wA, 3); asm volatile("" ::: "memory");
        ADA_FMA(wB, 1); ADA_LD(wB, 4); asm volatile("" ::: "memory");
        ADA_FMA(wC, 2); ADA_LD(wC, 5); asm volatile("" ::: "memory");
        ADA_FMA(wA, 3); ADA_LD(wA, 6); asm volatile("" ::: "memory");
        ADA_FMA(wB, 4); ADA_LD(wB, 7); asm volatile("" ::: "memory");
        ADA_FMA(wC, 5); ADA_FMA(wA, 6); ADA_FMA(wB, 7);
#undef ADA_LD
#undef ADA_FMA
        if (ks == 0) { const f32x4 b = *(const f32x4*)(a.in[9] + l * NMODC + c0 + 4 * tid); a0 += b; a1 += b; a2 += b; }
        *(LAS f32x4*)(part + 4 * tid) = a0; *(LAS f32x4*)(part + 1536 + 4 * tid) = a1; *(LAS f32x4*)(part + 3072 + 4 * tid) = a2;
    }
    __syncthreads();
    float* mod = (float*)(a.ws + WS_MOD);
#pragma unroll
    for (int i = 0; i < 9; ++i) { const int e = tid + 512 * i, v = e / 1536, c = e - v * 1536;
        atomicAdd(mod + (size_t)v * 2 * NMODC + l * NMODC + c0 + c, part[e]); }
    __syncthreads();
}
constexpr int I_IN = 32 * 208, I_OUT = 32 * 64, I_POOL = 8 * 16, I_M1 = 32 * 256, I_M2 = 128 * 64;
constexpr int R_IN = 0, R_OUT = R_IN + I_IN, R_M1_0 = R_OUT + I_OUT, R_M2_0 = R_M1_0 + I_M1, R_POOL = R_M2_0 + I_M2, R_M1_1 = R_POOL + 4 * I_POOL, R_M2_1 = R_M1_1 + I_M1, R_END = R_M2_1 + I_M2;
__device__ __forceinline__ TrDesc tr_desc(const Args& a, int it) {
    unsigned char* ws = a.ws;
    const float* MOD = (const float*)(ws + WS_MOD); float* SW = (float*)(ws + WS_SW);
    TrDesc d; d.shp = nullptr; d.sWp = nullptr; d.row_off = 0;
    if (it < R_OUT) { d.W = a.in[12]; d.K = 2048; d.N = IN_AB; d.WT = (bf16_t*)(ws + WS_WIN); d.item = it - R_IN; }
    else if (it < R_M1_0) { d.W = a.in[13]; d.K = 2048; d.N = 2048; d.WT = (bf16_t*)(ws + WS_WOUT); d.item = it - R_OUT; }
    else if (it < R_M2_0) { d.W = a.in[20]; d.K = 2048; d.N = DFF; d.WT = (bf16_t*)(ws + WS_WM1); d.item = it - R_M1_0; d.shp = MOD + 3 * 2048; d.sWp = SW; }
    else if (it < R_POOL) { d.W = a.in[21]; d.K = DFF; d.N = 2048; d.WT = (bf16_t*)(ws + WS_WM2); d.item = it - R_M2_0; }
    else if (it < R_M1_1) { const int r = it - R_POOL, g = r / I_POOL; d.W = a.in[18] + (size_t)g * 512 * 512; d.K = 512; d.N = 512; d.WT = (bf16_t*)(ws + WS_WPOOL); d.row_off = g * 512; d.item = r % I_POOL; }
    else if (it < R_M2_1) { d.W = a.in[20] + (size_t)2048 * DFF; d.K = 2048; d.N = DFF; d.WT = (bf16_t*)(ws + WS_WM1) + (size_t)DFF * 2048; d.item = it - R_M1_1; d.shp = MOD + NMODC + 3 * 2048; d.sWp = SW + 3 * DFF; }
    else { d.W = a.in[21] + (size_t)DFF * 2048; d.K = DFF; d.N = 2048; d.WT = (bf16_t*)(ws + WS_WM2) + (size_t)2048 * DFF; d.item = it - R_M2_1; }
    return d;
}
__device__ __forceinline__ void bg_transposes(const Args& a, LAS unsigned char* lds, int lo, int hi, int w, int nw, int wave, int lane) {
    LAS float* scr = (LAS float*)(lds + wave * 16384);
    int it = lo + w; if (it >= hi) return;
    f32x4 v[8];
    TrDesc d = tr_desc(a, it); tr_load(d, v, lane);
    for (;;) {
        tr_lds_write(v, scr, lane);
        const int itn = it + nw; const bool more = itn < hi;
        TrDesc dn = d;
        if (more) { dn = tr_desc(a, itn); tr_load(dn, v, lane); }
        LDS_WAIT(); asm volatile("" ::: "memory");
        tr_finish(d, scr, lane);
        LDS_WAIT(); asm volatile("" ::: "memory");
        if (!more) break;
        d = dn; it = itn;
    }
}

__device__ __forceinline__ void norm_rows_bf16(const Args& a, const float* xa  , const float* gain, int layer, int soff, bf16_t* H, int gw, int ngw, int lane) {
    const float* mod = (const float*)(a.ws + WS_MOD);
    for (int row0 = gw; row0 < NTOK; row0 += 2 * ngw) {
        const int row1 = row0 + ngw; const bool has1 = row1 < NTOK; const int r1 = has1 ? row1 : row0;
        const float* x0 = xa ? xa + (size_t)row0 * DM : xin_row(a, row0);
        const float* x1 = xa ? xa + (size_t)r1 * DM : xin_row(a, r1);
        f32x4 v0[8], v1[8]; float ss0 = 0.f, ss1 = 0.f;
#pragma unroll
        for (int j = 0; j < 8; ++j) { v0[j] = *(const f32x4*)(x0 + 4 * (lane + 64 * j)); v1[j] = *(const f32x4*)(x1 + 4 * (lane + 64 * j)); }
#pragma unroll
        for (int j = 0; j < 8; ++j) { ss0 += v0[j].x * v0[j].x + v0[j].y * v0[j].y + v0[j].z * v0[j].z + v0[j].w * v0[j].w; ss1 += v1[j].x * v1[j].x + v1[j].y * v1[j].y + v1[j].z * v1[j].z + v1[j].w * v1[j].w; }
        const float rstd0 = rsqrtf(wave_sum(ss0) * (1.f / DM) + EPS), rstd1 = rsqrtf(wave_sum(ss1) * (1.f / DM) + EPS);
        const float* mp0 = mod + (size_t)cvec_of_row(row0) * 2 * NMODC + layer * NMODC + soff;
        const float* mp1 = mod + (size_t)cvec_of_row(r1) * 2 * NMODC + layer * NMODC + soff;
#pragma unroll
        for (int j = 0; j < 8; ++j) { const int c = 4 * (lane + 64 * j);
            const f32x4 g = *(const f32x4*)(gain + c);
            { const f32x4 sh = *(const f32x4*)(mp0 + c), sc = *(const f32x4*)(mp0 + 2048 + c); const f32x4 y = v0[j] * rstd0 * g * (sc + 1.f) + sh;
              u32x2 w; w.x = cvtpk(y.x, y.y); w.y = cvtpk(y.z, y.w); *(u32x2*)(H + (size_t)row0 * DM + c) = w; }
            if (has1) { const f32x4 sh = *(const f32x4*)(mp1 + c), sc = *(const f32x4*)(mp1 + 2048 + c); const f32x4 y = v1[j] * rstd1 * g * (sc + 1.f) + sh;
              u32x2 w; w.x = cvtpk(y.x, y.y); w.y = cvtpk(y.z, y.w); *(u32x2*)(H + (size_t)row1 * DM + c) = w; } }
    }
}
__device__ __forceinline__ void norm_rows_f32(const Args& a, const float* xa, const float* gain, int layer, int soff  , float* O, int gw, int ngw, int lane) {
    const float* mod = (const float*)(a.ws + WS_MOD);
    for (int row = gw; row < NTOK; row += ngw) {
        const float* xr = xa + (size_t)row * DM;
        const float* mp = mod + (size_t)cvec_of_row(row) * 2 * NMODC + layer * NMODC + (soff < 0 ? 0 : soff);
        f32x4 v[8]; float ss = 0.f;
#pragma unroll
        for (int j = 0; j < 8; ++j) { v[j] = *(const f32x4*)(xr + 4 * (lane + 64 * j)); ss += v[j].x * v[j].x + v[j].y * v[j].y + v[j].z * v[j].z + v[j].w * v[j].w; }
        const float rstd = rsqrtf(wave_sum(ss) * (1.f / DM) + EPS);
#pragma unroll
        for (int j = 0; j < 8; ++j) { const int c = 4 * (lane + 64 * j);
            const f32x4 g = *(const f32x4*)(gain + c);
            f32x4 y = v[j] * rstd * g;
            if (soff >= 0) { const f32x4 sh = *(const f32x4*)(mp + c), sc = *(const f32x4*)(mp + 2048 + c); y = y * (sc + 1.f) + sh; }
            *(f32x4*)(O + (size_t)row * DM + c) = y; }
    }
}
template <int HW> __device__ __forceinline__ void pool_out(const LAS float* T, bf16_t* P, int row0, int t0, int Tseq, int cb, int tid) {
    const int cq = tid & 63, tgp = tid >> 6;
#pragma unroll
    for (int j = 0; j < 8; ++j) { const int tl = tgp * 8 + j, t = t0 + tl;
        f32x4 s = {0.f, 0.f, 0.f, 0.f};
#pragma unroll
        for (int d = -HW; d < HW; ++d) { const int u = t + d; const f32x4 v = *(const LAS f32x4*)(T + (tl + 8 + d) * 256 + cq * 4); if (u >= 0 && u < Tseq) s += v; }
        const int lo = max(t - HW, 0), hi = min(t + HW, Tseq);
        const f32x4 x = *(const LAS f32x4*)(T + (tl + 8) * 256 + cq * 4);
        const f32x4 y = s * (1.f / (float)(hi - lo)) - x;
        u32x2 w; w.x = cvtpk(y.x, y.y); w.y = cvtpk(y.z, y.w);
        *(u32x2*)(P + (size_t)(row0 + tl) * DM + cb * 256 + cq * 4) = w; }
}
struct PoolItem { int row0, cb, s0, Tseq, t0; };
__device__ __forceinline__ PoolItem pool_item(int item) {
    PoolItem p; const int tt = item >> 3; p.cb = item & 7; p.row0 = tt * 64;
    if (p.row0 < NTOK_P) { p.s0 = p.row0 & ~255; p.Tseq = SEQ_P; } else { p.s0 = NTOK_P + ((p.row0 - NTOK_P) & ~1023); p.Tseq = SEQ_S; }
    p.t0 = p.row0 - p.s0; return p;
}
__device__ __forceinline__ void pool_load(const PoolItem& p, const float* XA, const float* rowss, f32x4 (&xr)[10], float (&rs)[10], int wave, int lane) {
    const int c = p.cb * 256 + lane * 4;
#pragma unroll
    for (int i = 0; i < 10; ++i) { const int t = p.t0 - 8 + wave + 8 * i; const bool ok = t >= 0 && t < p.Tseq; const int row = p.s0 + (ok ? t : p.t0);
        xr[i] = *(const f32x4*)(XA + (size_t)row * DM + c); rs[i] = rowss[row]; }
}
__device__ __forceinline__ void pool_phase(const Args& a, LAS unsigned char* lds, const float* XA, const float* rowss, bf16_t* P, int bx, int G, int tid) {
    LAS float* T = (LAS float*)lds;
    const float* MOD = (const float*)(a.ws + WS_MOD);
    const int lane = tid & 63, wave = tid >> 6;
    int item = bx; if (item >= 768) return;
    f32x4 xr[10]; float rs[10];
    PoolItem p = pool_item(item); pool_load(p, XA, rowss, xr, rs, wave, lane);
    for (;;) {
        const int c = p.cb * 256 + lane * 4, g = p.cb >> 1;
        const float* mp = MOD + (size_t)cvec_of_row(p.row0) * 2 * NMODC + NMODC;
        const f32x4 gmul = *(const f32x4*)(a.in[10] + 2048 + c) * (*(const f32x4*)(mp + 2048 + c) + 1.f), sh = *(const f32x4*)(mp + c);
#pragma unroll
        for (int i = 0; i < 10; ++i) { const int rr = wave + 8 * i; const float rstd = rsqrtf(rs[i] * (1.f / DM) + EPS);
            *(LAS f32x4*)(T + rr * 256 + lane * 4) = xr[i] * rstd * gmul + sh; }
        const int nitem = item + G; const bool more = nitem < 768;
        PoolItem pn = p;
        if (more) { pn = pool_item(nitem); pool_load(pn, XA, rowss, xr, rs, wave, lane); }
        __syncthreads();
        switch (g) { case 0: pool_out<1>(T, P, p.row0, p.t0, p.Tseq, p.cb, tid); break; case 1: pool_out<2>(T, P, p.row0, p.t0, p.Tseq, p.cb, tid); break;
                     case 2: pool_out<4>(T, P, p.row0, p.t0, p.Tseq, p.cb, tid); break; default: pool_out<8>(T, P, p.row0, p.t0, p.Tseq, p.cb, tid); break; }
        __syncthreads();
        if (!more) break;
        p = pn; item = nitem;
    }
}
__device__ __forceinline__ void final_rows(const float* XA, const float* rowss, const float* gain, float* O, int gw, int ngw, int lane) {
    for (int row = gw; row < NTOK; row += ngw) { const float rstd = rsqrtf(rowss[row] * (1.f / DM) + EPS);
#pragma unroll
        for (int j = 0; j < 8; ++j) { const int c = 4 * (lane + 64 * j);
            __builtin_nontemporal_store(__builtin_nontemporal_load((const f32x4*)(XA + (size_t)row * DM + c)) * rstd * *(const f32x4*)(gain + c), (f32x4*)(O + (size_t)row * DM + c)); } }
}

__device__ __forceinline__ void post_token(const Args& a, int row, int lane) {
    const bf16_t* ZB = (const bf16_t*)(a.ws + WS_ZB);
    bf16_t* QN = (bf16_t*)(a.ws + WS_QN);
    const bool samp = row >= NTOK_P;
    const int bb = samp ? (row - NTOK_P) >> 10 : row >> 8, t = samp ? (row - NTOK_P) & 1023 : row & 255;
    const int e0 = (lane & 31) * 4, hsel = lane >> 5;
    const int sect = e0 >> 5;
    float cs[4], sn[4];
    if (samp) {
        const float pos = (float)((sect < 2) ? (t >> 6) : (t & 63));
#pragma unroll
        for (int i = 0; i < 4; ++i) { const int j = (e0 + i) & 31; const float inv = exp2f(-(float)j * 0.41524101186092033f); const float ang = pos * inv; cs[i] = __cosf(ang); sn[i] = __sinf(ang); }
    }
    u32x2 raw6[6];
#pragma unroll
    for (int p = 0; p < 6; ++p) raw6[p] = *(const u32x2*)(ZB + (size_t)row * IN_AB + p * 256 + lane * 4);
#pragma unroll
    for (int p = 0; p < 6; ++p) {
        const int col = p * 256 + lane * 4;
        const u32x2 raw = raw6[p];
        float y[4] = {bflo(raw.x), bfhi(raw.x), bflo(raw.y), bfhi(raw.y)};
        if (p < 5) {
            const float ss = half_sum(y[0] * y[0] + y[1] * y[1] + y[2] * y[2] + y[3] * y[3]);
            const float rstd = rsqrtf(ss * (1.f / 128.f) + EPS);
            const f32x4 g = *(const f32x4*)((p < 4 ? a.in[14] : a.in[15]) + e0);
            y[0] *= rstd * g.x; y[1] *= rstd * g.y; y[2] *= rstd * g.z; y[3] *= rstd * g.w;
        }
        if (!samp && p >= 4) {
            float* o = a.out + (p == 4 ? 12582912 : 13631488) + (size_t)row * 256 + lane * 4;
            *(f32x4*)o = (f32x4){y[0], y[1], y[2], y[3]};
        }
        if (samp && p < 5) {
#pragma unroll
            for (int i = 0; i < 4; ++i) { const float py = __shfl_xor(y[i], 8); const float rot = (sect & 1) ? py : -py; y[i] = y[i] * cs[i] + rot * sn[i]; }
        }
        u32x2 w; w.x = cvtpk(y[0], y[1]); w.y = cvtpk(y[2], y[3]);
        if (p < 4) *(u32x2*)(QN + (size_t)row * 1024 + col) = w;
        else {
            bf16_t* dst;
            if (samp) dst = (bf16_t*)(a.ws + (p == 4 ? WS_KS : WS_VS)) + ((size_t)(bb * 2 + hsel) * 1280 + t) * 128 + e0;
            else      dst = (bf16_t*)(a.ws + (p == 4 ? WS_KP : WS_VP)) + ((size_t)(bb * 2 + hsel) * 256 + t) * 128 + e0;
            *(u32x2*)dst = w;
        }
    }
}
__device__ __forceinline__ void cache_item(const Args& a, int item, int lane) {
    const int which = item >> 9, b = (item >> 8) & 1, t = item & 255, hsel = lane >> 5, e0 = (lane & 31) * 4;
    const f32x4 v = *(const f32x4*)(a.in[2 + which] + ((size_t)(b * 256 + t) * 2 + hsel) * 128 + e0);
    bf16_t* dst = (bf16_t*)(a.ws + (which == 0 ? WS_KS : WS_VS)) + ((size_t)(b * 2 + hsel) * 1280 + 1024 + t) * 128 + e0;
    u32x2 w; w.x = cvtpk(v.x, v.y); w.y = cvtpk(v.z, v.w);
    *(u32x2*)dst = w;
}
__device__ __forceinline__ void combine_token(const Args& a, int row, int lane) {
    const float* OF = (const float*)(a.ws + WS_OF); const float* OB = (const float*)(a.ws + WS_OB);
    const bf16_t* ZB = (const bf16_t*)(a.ws + WS_ZB); bf16_t* A2 = (bf16_t*)(a.ws + WS_A2);
    const int e0 = (lane & 31) * 4;
    const f32x4 g = *(const f32x4*)(a.in[16] + e0);
#pragma unroll
    for (int p = 0; p < 4; ++p) {
        const int col = p * 256 + lane * 4;
        const f32x4 o = *(const f32x4*)(OF + (size_t)row * 1024 + col) + *(const f32x4*)(OB + (size_t)row * 1024 + col);
        const float ss = half_sum(o.x * o.x + o.y * o.y + o.z * o.z + o.w * o.w);
        const float rstd = rsqrtf(ss * (1.f / 128.f) + EPS);
        const u32x2 raw = *(const u32x2*)(ZB + (size_t)row * IN_AB + C_HG + col);
        const f32x4 y = o * rstd * g * (f32x4){bflo(raw.x), bfhi(raw.x), bflo(raw.y), bfhi(raw.y)};
        u32x2 w; w.x = cvtpk(y.x, y.y); w.y = cvtpk(y.z, y.w);
        *(u32x2*)(A2 + (size_t)row * DM + 1024 + col) = w;
    }
}

constexpr int HG_ROW = 136, HG_TROW = 40;
constexpr int HG_QI = 0, HG_KI = 32 * HG_ROW * 2, HG_QS = 2 * 32 * HG_ROW * 2, HG_KST = 3 * 32 * HG_ROW * 2, HG_IT = HG_KST + 128 * HG_TROW * 2, HG_A = HG_IT + 128 * HG_TROW * 2, HG_GT = HG_A + 512, HG_SEQ_BYTES = HG_GT + 4096;
static_assert(HG_SEQ_BYTES % 16 == 0 && 2 * HG_SEQ_BYTES <= RING_BYTES, "hgrn lds");
__device__ __forceinline__ int crow(int r, int hi) { return (r & 3) + 8 * (r >> 2) + 4 * hi; }
__device__ __forceinline__ int kpos(int k) { const int kp = k & 15; return (k & 16) + (((kp >> 2) & 1) << 3) + ((kp >> 3) << 2) + (kp & 3); }
#define MFMA32(a, b, c) __builtin_amdgcn_mfma_f32_32x32x16_bf16((a), (b), (c), 0, 0, 0)
__device__ __forceinline__ bf16x8 pack8(const f32x16& x, int s) {
    u32x4 p; p.x = cvtpk(x[8 * s], x[8 * s + 1]); p.y = cvtpk(x[8 * s + 2], x[8 * s + 3]); p.z = cvtpk(x[8 * s + 4], x[8 * s + 5]); p.w = cvtpk(x[8 * s + 6], x[8 * s + 7]);
    return __builtin_bit_cast(bf16x8, p);
}
struct HgRegs { f32x4 lf[4]; u32x2 qv[4], iv[4]; };
__device__ __forceinline__ void hg_load(HgRegs& R, const float* LF, const bf16_t* ZB, int rowbase, int dir, int hh, int cg, int tg, int ch) {
#pragma unroll
    for (int jj = 0; jj < 4; ++jj) { const int j = 4 * tg + jj;
        const int row = rowbase + (dir == 0 ? 32 * ch + j : 32 * (7 - ch) + 31 - j);
        R.lf[jj] = *(const f32x4*)(LF + (size_t)row * 2048 + dir * 1024 + hh * 128 + 4 * cg);
        R.qv[jj] = *(const u32x2*)(ZB + (size_t)row * IN_AB + C_HQ + hh * 128 + 4 * cg);
        R.iv[jj] = *(const u32x2*)(ZB + (size_t)row * IN_AB + C_HI + hh * 128 + 4 * cg); }
}
__device__ __forceinline__ void hg_chunk(const HgRegs& R, f32x16 (&S)[4], f32x4& ltot, LAS unsigned char* L, float* OUT, int rowbase, int dir, int hh, int ch,
                                         int cg, int tg, int r32, int hi, int e0) {
    f32x4 cb[4]; cb[0] = R.lf[0]; cb[1] = cb[0] + R.lf[1]; cb[2] = cb[1] + R.lf[2]; cb[3] = cb[2] + R.lf[3];
    *(LAS f32x4*)(L + HG_GT + (tg * 128 + 4 * cg) * 4) = cb[3];
    __syncthreads();
    f32x4 off = {0.f, 0.f, 0.f, 0.f}, bm = off, bl = off;
#pragma unroll
    for (int g = 0; g < 8; ++g) { const f32x4 t4 = *(const LAS f32x4*)(L + HG_GT + (g * 128 + 4 * cg) * 4); if (g < tg) off += t4; if (g < 4) bm += t4; bl += t4; }
    ltot += bl;
    f32x4 em, elm;
#pragma unroll
    for (int c = 0; c < 4; ++c) { em[c] = __expf(bm[c]); elm[c] = __expf(bl[c] - bm[c]); }
    if (tg == 0) { f32x4 av;
#pragma unroll
        for (int c = 0; c < 4; ++c) av[c] = __expf(bl[c]);
        *(LAS f32x4*)(L + HG_A + 16 * cg) = av; }
    float kS_[4][4], iv_[4][4];
#pragma unroll
    for (int jj = 0; jj < 4; ++jj) {
        const int j = 4 * tg + jj;
        const float q4[4] = {bflo(R.qv[jj].x), bfhi(R.qv[jj].x), bflo(R.qv[jj].y), bfhi(R.qv[jj].y)};
        iv_[jj][0] = bflo(R.iv[jj].x); iv_[jj][1] = bfhi(R.iv[jj].x); iv_[jj][2] = bflo(R.iv[jj].y); iv_[jj][3] = bfhi(R.iv[jj].y);
        float qI[4], qS[4], kI[4];
#pragma unroll
        for (int c = 0; c < 4; ++c) {
            const float b = off[c] + cb[jj][c];
            const float E1 = __expf(fminf(fmaxf(b - bm[c], -80.f), 80.f)), R1 = __builtin_amdgcn_rcpf(E1);
            const float kk = 1.f - __expf(R.lf[jj][c]);
            qI[c] = q4[c] * E1; qS[c] = qI[c] * em[c];
            kI[c] = kk * R1; kS_[jj][c] = kI[c] * elm[c];
        }
        u32x2 w; w.x = cvtpk(qI[0], qI[1]); w.y = cvtpk(qI[2], qI[3]);
        *(LAS u32x2*)(L + HG_QI + (j * HG_ROW + 4 * cg) * 2) = w;
        w.x = cvtpk(kI[0], kI[1]); w.y = cvtpk(kI[2], kI[3]);
        *(LAS u32x2*)(L + HG_KI + (j * HG_ROW + 4 * cg) * 2) = w;
        w.x = cvtpk(qS[0], qS[1]); w.y = cvtpk(qS[2], qS[3]);
        *(LAS u32x2*)(L + HG_QS + (j * HG_ROW + (4 * cg & ~31) + kpos(4 * cg & 31)) * 2) = w;
    }
    {
        const int p0 = kpos(4 * tg);
#pragma unroll
        for (int c = 0; c < 4; ++c) { u32x2 w; w.x = cvtpk(kS_[0][c], kS_[1][c]); w.y = cvtpk(kS_[2][c], kS_[3][c]);
            *(LAS u32x2*)(L + HG_KST + ((4 * cg + c) * HG_TROW + p0) * 2) = w;
            w.x = cvtpk(iv_[0][c], iv_[1][c]); w.y = cvtpk(iv_[2][c], iv_[3][c]);
            *(LAS u32x2*)(L + HG_IT + ((4 * cg + c) * HG_TROW + p0) * 2) = w; }
    }
    __syncthreads();
    f32x16 x;
#pragma unroll
    for (int i = 0; i < 16; ++i) x[i] = 0.f;
#pragma unroll
    for (int ks = 0; ks < 8; ++ks) {
        const bf16x8 fa = *(const LAS bf16x8*)(L + HG_KI + (r32 * HG_ROW + 16 * ks + 8 * hi) * 2);
        const bf16x8 fb = *(const LAS bf16x8*)(L + HG_QI + (r32 * HG_ROW + 16 * ks + 8 * hi) * 2);
        x = MFMA32(fa, fb, x);
    }
#pragma unroll
    for (int i = 0; i < 16; ++i) x[i] = (crow(i, hi) <= r32) ? x[i] : 0.f;
    f32x16 y;
#pragma unroll
    for (int i = 0; i < 16; ++i) y[i] = 0.f;
    bf16x8 fi[2];
#pragma unroll
    for (int ks = 0; ks < 2; ++ks) {
        fi[ks] = *(const LAS bf16x8*)(L + HG_IT + ((e0 + r32) * HG_TROW + 16 * ks + 8 * hi) * 2);
        y = MFMA32(fi[ks], pack8(x, ks), y);
    }
#pragma unroll
    for (int db = 0; db < 4; ++db)
#pragma unroll
        for (int ks = 0; ks < 2; ++ks) {
            const bf16x8 fq_ = *(const LAS bf16x8*)(L + HG_QS + (r32 * HG_ROW + 32 * db + 16 * ks + 8 * hi) * 2);
            y = MFMA32(pack8(S[db], ks), fq_, y);
        }
    {
        const int row = rowbase + (dir == 0 ? 32 * ch + r32 : 32 * (7 - ch) + 31 - r32);
        float* op = OUT + (size_t)row * 1024 + hh * 128 + e0 + 4 * hi;
#pragma unroll
        for (int g4 = 0; g4 < 4; ++g4) *(f32x4*)(op + 8 * g4) = (f32x4){y[4 * g4], y[4 * g4 + 1], y[4 * g4 + 2], y[4 * g4 + 3]};
    }
#pragma unroll
    for (int db = 0; db < 4; ++db) {
#pragma unroll
        for (int g4 = 0; g4 < 4; ++g4) { const f32x4 a4 = *(const LAS f32x4*)(L + HG_A + (32 * db + 8 * g4 + 4 * hi) * 4);
#pragma unroll
            for (int c = 0; c < 4; ++c) S[db][4 * g4 + c] *= a4[c]; }
#pragma unroll
        for (int ks = 0; ks < 2; ++ks) {
            const bf16x8 fk = *(const LAS bf16x8*)(L + HG_KST + ((32 * db + r32) * HG_TROW + 16 * ks + 8 * hi) * 2);
            S[db] = MFMA32(fk, fi[ks], S[db]);
        }
    }
}
__device__ __forceinline__ void hgrn_prefetch(const Args& a, int task, int tid, HgRegs& RA, HgRegs& RB) {
    const bool samp = task < 64;
    const int bb = samp ? task >> 5 : (task - 64) >> 3, hh = samp ? (task >> 2) & 7 : task & 7, seg = task & 3;
    const int rowbase = samp ? NTOK_P + bb * SEQ_S + seg * 256 : bb * SEQ_P;
    const int dir = tid >> 8, tl = tid & 255, cg = tl & 31, tg = tl >> 5;
    const bf16_t* ZB = (const bf16_t*)(a.ws + WS_ZB); const float* LF = (const float*)(a.ws + WS_LF);
    hg_load(RA, LF, ZB, rowbase, dir, hh, cg, tg, 0);
    hg_load(RB, LF, ZB, rowbase, dir, hh, cg, tg, 1);
}
__device__ __forceinline__ void hgrn_task(const Args& a, LAS unsigned char* lds0, int task, int tid, HgRegs& RA, HgRegs& RB) {
    const bool samp = task < 64;
    const int bb = samp ? task >> 5 : (task - 64) >> 3, hh = samp ? (task >> 2) & 7 : task & 7, seg = task & 3;
    const int rowbase = samp ? NTOK_P + bb * SEQ_S + seg * 256 : bb * SEQ_P;
    const int dir = tid >> 8, tl = tid & 255, lane = tid & 63, wq = (tid >> 6) & 3, r32 = lane & 31, hi = lane >> 5;
    LAS unsigned char* L = lds0 + dir * HG_SEQ_BYTES;
    const bf16_t* ZB = (const bf16_t*)(a.ws + WS_ZB); const float* LF = (const float*)(a.ws + WS_LF);
    float* OUT = (float*)(a.ws + (dir == 0 ? WS_OF : WS_OB));
    const int cg = tl & 31, tg = tl >> 5, e0 = 32 * wq;
    f32x16 S[4];
    const bool has_init = samp && (dir == 0 ? seg == 0 : seg == 3);
    if (has_init) { const float* s0 = a.in[4 + dir] + (size_t)(bb * 8 + hh) * 16384;
#pragma unroll
        for (int db = 0; db < 4; ++db)
#pragma unroll
            for (int i = 0; i < 16; ++i) S[db][i] = s0[(size_t)(32 * db + crow(i, hi)) * 128 + e0 + r32];
    } else {
#pragma unroll
        for (int db = 0; db < 4; ++db)
#pragma unroll
            for (int i = 0; i < 16; ++i) S[db][i] = 0.f;
    }
    f32x4 ltot = {0.f, 0.f, 0.f, 0.f};
#pragma unroll
    for (int ch = 0; ch < 8; ch += 2) {
        hg_chunk(RA, S, ltot, L, OUT, rowbase, dir, hh, ch, cg, tg, r32, hi, e0);
        if (ch + 2 < 8) hg_load(RA, LF, ZB, rowbase, dir, hh, cg, tg, ch + 2);
        hg_chunk(RB, S, ltot, L, OUT, rowbase, dir, hh, ch + 1, cg, tg, r32, hi, e0);
        if (ch + 3 < 8) hg_load(RB, LF, ZB, rowbase, dir, hh, cg, tg, ch + 3);
    }
    if (!samp) { float* so = a.out + (dir == 0 ? 14680064 : 16777216) + (size_t)(bb * 8 + hh) * 16384;
#pragma unroll
        for (int db = 0; db < 4; ++db)
#pragma unroll
            for (int i = 0; i < 16; ++i) so[(size_t)(32 * db + crow(i, hi)) * 128 + e0 + r32] = S[db][i];
    } else {
        const size_t sidx = (size_t)(((bb * 8 + hh) * 2 + dir) * 4 + seg);
        float* so = (float*)(a.ws + WS_SEND) + sidx * 16384;
#pragma unroll
        for (int db = 0; db < 4; ++db)
#pragma unroll
            for (int i = 0; i < 16; ++i) so[(size_t)(32 * db + crow(i, hi)) * 128 + e0 + r32] = S[db][i];
        if (tg == 0) *(f32x4*)((float*)(a.ws + WS_LSEG) + sidx * 128 + 4 * cg) = ltot;
    }
    __syncthreads();
}
constexpr int FX_QS = 0, FX_GT = 32 * HG_ROW * 2, FX_DIR_BYTES = FX_GT + 4096, FX_Z = 2 * FX_DIR_BYTES, FX_ZROW = 132, FX_RED = FX_Z + 32 * FX_ZROW * 4, FX_BYTES = FX_RED + 512;
__device__ __forceinline__ void hgfix_task(const Args& a, LAS unsigned char* lds0, int task, int tid) {
    const int bb = task >> 5, hh = (task >> 2) & 7, seg = task & 3;
    const int rowbase = NTOK_P + bb * SEQ_S + seg * 256;
    const int dir = tid >> 8, tl = tid & 255, lane = tid & 63, wq = (tid >> 6) & 3, r32 = lane & 31, hi = lane >> 5;
    LAS unsigned char* L = lds0 + dir * FX_DIR_BYTES;
    const bf16_t* ZB = (const bf16_t*)(a.ws + WS_ZB); const float* LF = (const float*)(a.ws + WS_LF);
    const float* OIN = (const float*)(a.ws + (dir == 0 ? WS_OF : WS_OB));
    bf16_t* A2 = (bf16_t*)(a.ws + WS_A2);
    const int cg = tl & 31, tg = tl >> 5, e0 = 32 * wq;
    const size_t sbase = (size_t)((bb * 8 + hh) * 2 + dir) * 4;
    const float* SEND = (const float*)(a.ws + WS_SEND); const float* LSEG = (const float*)(a.ws + WS_LSEG);
    f32x16 S[4];
#pragma unroll
    for (int db = 0; db < 4; ++db)
#pragma unroll
        for (int i = 0; i < 16; ++i) S[db][i] = 0.f;
    const int nfold = dir == 0 ? seg : 3 - seg;
    for (int f = 0; f < nfold; ++f) { const int j = dir == 0 ? f : 3 - f;
        const float* sp = SEND + (sbase + j) * 16384; const float* lp = LSEG + (sbase + j) * 128;
#pragma unroll
        for (int db = 0; db < 4; ++db)
#pragma unroll
            for (int g4 = 0; g4 < 4; ++g4) { const f32x4 l4 = *(const f32x4*)(lp + 32 * db + 8 * g4 + 4 * hi);
#pragma unroll
                for (int c = 0; c < 4; ++c) { const int i = 4 * g4 + c; S[db][i] = S[db][i] * __expf(l4[c]) + sp[(size_t)(32 * db + crow(i, hi)) * 128 + e0 + r32]; } }
    }
    bf16x8 sf[4][2];
#pragma unroll
    for (int db = 0; db < 4; ++db)
#pragma unroll
        for (int ks = 0; ks < 2; ++ks) sf[db][ks] = pack8(S[db], ks);
    f32x4 run = {0.f, 0.f, 0.f, 0.f}, ltot = {0.f, 0.f, 0.f, 0.f};
    if (dir == 1) ltot = *(const f32x4*)(LSEG + (sbase + seg) * 128 + 4 * cg);
    const f32x4 gn0 = *(const f32x4*)(a.in[16] + e0 + 4 * hi), gn1 = *(const f32x4*)(a.in[16] + e0 + 4 * hi + 8), gn2 = *(const f32x4*)(a.in[16] + e0 + 4 * hi + 16), gn3 = *(const f32x4*)(a.in[16] + e0 + 4 * hi + 24);
    f32x4 lfn[4]; u32x2 qvn[4];
#define FX_LOAD(chn) do { _Pragma("unroll") for (int jj = 0; jj < 4; ++jj) { const int row_ = rowbase + 32 * (chn) + 4 * tg + jj; \
        lfn[jj] = *(const f32x4*)(LF + (size_t)row_ * 2048 + dir * 1024 + hh * 128 + 4 * cg); \
        qvn[jj] = *(const u32x2*)(ZB + (size_t)row_ * IN_AB + C_HQ + hh * 128 + 4 * cg); } } while (0)
    FX_LOAD(0);
#pragma unroll 1
    for (int ch = 0; ch < 8; ++ch) {
        f32x4 lf[4]; u32x2 qv[4];
#pragma unroll
        for (int jj = 0; jj < 4; ++jj) { lf[jj] = lfn[jj]; qv[jj] = qvn[jj]; }
        const int row = rowbase + 32 * ch + r32;
        f32x4 zin[4]; u32x2 hgraw[4];
        { const float* ip = OIN + (size_t)row * 1024 + hh * 128 + e0 + 4 * hi; const bf16_t* hgp = ZB + (size_t)row * IN_AB + C_HG + hh * 128 + e0 + 4 * hi;
#pragma unroll
          for (int g4 = 0; g4 < 4; ++g4) { zin[g4] = *(const f32x4*)(ip + 8 * g4); hgraw[g4] = *(const u32x2*)(hgp + 8 * g4); } }
        if (ch + 1 < 8) FX_LOAD(ch + 1);
        f32x4 cb[4]; cb[0] = lf[0]; cb[1] = cb[0] + lf[1]; cb[2] = cb[1] + lf[2]; cb[3] = cb[2] + lf[3];
        *(LAS f32x4*)(L + FX_GT + (tg * 128 + 4 * cg) * 4) = cb[3];
        __syncthreads();
        f32x4 off = {0.f, 0.f, 0.f, 0.f}, bl = off;
#pragma unroll
        for (int g = 0; g < 8; ++g) { const f32x4 t4 = *(const LAS f32x4*)(L + FX_GT + (g * 128 + 4 * cg) * 4); if (g < tg) off += t4; bl += t4; }
#pragma unroll
        for (int jj = 0; jj < 4; ++jj) { const int j = 4 * tg + jj;
            const float q4[4] = {bflo(qv[jj].x), bfhi(qv[jj].x), bflo(qv[jj].y), bfhi(qv[jj].y)};
            float qB[4];
#pragma unroll
            for (int c = 0; c < 4; ++c) { const float incl = run[c] + off[c] + cb[jj][c];
                const float B = dir == 0 ? incl : ltot[c] - (incl - lf[jj][c]);
                qB[c] = q4[c] * __expf(B); }
            u32x2 w; w.x = cvtpk(qB[0], qB[1]); w.y = cvtpk(qB[2], qB[3]);
            *(LAS u32x2*)(L + FX_QS + (j * HG_ROW + (4 * cg & ~31) + kpos(4 * cg & 31)) * 2) = w; }
        run += bl;
        __syncthreads();
        f32x16 y;
#pragma unroll
        for (int i = 0; i < 16; ++i) y[i] = 0.f;
        if (nfold > 0) {
#pragma unroll
            for (int db = 0; db < 4; ++db)
#pragma unroll
                for (int ks = 0; ks < 2; ++ks) { const bf16x8 fq_ = *(const LAS bf16x8*)(L + FX_QS + (r32 * HG_ROW + 32 * db + 16 * ks + 8 * hi) * 2); y = MFMA32(sf[db][ks], fq_, y); }
        }
        f32x4 z[4];
#pragma unroll
        for (int g4 = 0; g4 < 4; ++g4) z[g4] = zin[g4] + (f32x4){y[4 * g4], y[4 * g4 + 1], y[4 * g4 + 2], y[4 * g4 + 3]};
        LAS float* Z = (LAS float*)(lds0 + FX_Z);
        if (dir == 1) {
#pragma unroll
            for (int g4 = 0; g4 < 4; ++g4) *(LAS f32x4*)(Z + r32 * FX_ZROW + e0 + 4 * hi + 8 * g4) = z[g4]; }
        __syncthreads();
        float ssq = 0.f;
        if (dir == 0) {
#pragma unroll
            for (int g4 = 0; g4 < 4; ++g4) { z[g4] += *(const LAS f32x4*)(Z + r32 * FX_ZROW + e0 + 4 * hi + 8 * g4); ssq += (z[g4].x * z[g4].x + z[g4].y * z[g4].y) + (z[g4].z * z[g4].z + z[g4].w * z[g4].w); }
            ssq += __shfl_xor(ssq, 32);
            if (hi == 0) ((LAS float*)(lds0 + FX_RED))[wq * 32 + r32] = ssq;
        }
        __syncthreads();
        if (dir == 0) {
            const LAS float* red = (const LAS float*)(lds0 + FX_RED);
            const float tot = (red[r32] + red[32 + r32]) + (red[64 + r32] + red[96 + r32]);
            const float rstd = rsqrtf(tot * (1.f / 128.f) + EPS);
            bf16_t* op = A2 + (size_t)row * DM + 1024 + hh * 128 + e0 + 4 * hi;
            const f32x4 gn[4] = {gn0, gn1, gn2, gn3};
#pragma unroll
            for (int g4 = 0; g4 < 4; ++g4) { const u32x2 raw = hgraw[g4];
                const f32x4 o = z[g4] * rstd * gn[g4] * (f32x4){bflo(raw.x), bfhi(raw.x), bflo(raw.y), bfhi(raw.y)};
                u32x2 w; w.x = cvtpk(o.x, o.y); w.y = cvtpk(o.z, o.w); *(u32x2*)(op + 8 * g4) = w; }
        }
    }
    __syncthreads();
}

namespace att {
constexpr int D = 128, NW = 8, QBLK = 32, KVBLK = 64;
constexpr float SCALE = 0.088388347648318440f;
constexpr float THR = 0.f;
constexpr int LDQ = 1024, LDK = 128, LDO = 2048;
constexpr int SHM_V = KVBLK * D * 2, SHM_K = KVBLK * D * 2, SHM_ATTN = 2 * SHM_V + 2 * SHM_K + NW * 64 * 4;
#define KSWZ(row, colB) ((row) * 256 + ((colB) ^ (((row) & 7) << 4)))
#define SBAR() __builtin_amdgcn_sched_barrier(0)
__device__ __forceinline__ unsigned cvtpk_a(float lo, float hi) { unsigned r; asm volatile("v_cvt_pk_bf16_f32 %0, %1, %2" : "=v"(r) : "v"(lo), "v"(hi)); return r; }
__device__ __forceinline__ void partialSM(f32x16& p0, f32x16& p1, float& m_reg, float& mn, float& alpha) {
  constexpr float C = SCALE * 1.4426950408889634f;
  float pmax = p0[0]; for (int r = 1; r < 16; ++r) pmax = fmaxf(pmax, p0[r]); for (int r = 0; r < 16; ++r) pmax = fmaxf(pmax, p1[r]);
  { auto rr = __builtin_amdgcn_permlane32_swap(__float_as_uint(pmax), __float_as_uint(pmax), false, false);
    pmax = fmaxf(__uint_as_float(rr[0]), __uint_as_float(rr[1])); }
  if (__builtin_expect(__all(pmax - m_reg <= THR / SCALE), 1)) { mn = m_reg; alpha = 1.f; }
  else { mn = fmaxf(m_reg, pmax); alpha = __builtin_amdgcn_exp2f((m_reg - mn) * C); m_reg = mn; }
  float mnC = -mn * C;
  for (int r = 0; r < 16; ++r) p0[r] = fmaf(p0[r], C, mnC); for (int r = 0; r < 16; ++r) p1[r] = fmaf(p1[r], C, mnC);
  for (int r = 0; r < 16; ++r) p0[r] = __builtin_amdgcn_exp2f(p0[r]);
}
__device__ __forceinline__ void finishSM(f32x16& p0, f32x16& p1, float alpha, float& l_reg, bf16x8& pa0, bf16x8& pa1, bf16x8& pa2, bf16x8& pa3) {
  for (int r = 0; r < 16; ++r) p1[r] = __builtin_amdgcn_exp2f(p1[r]);
  float ps = 0; for (int r = 0; r < 16; ++r) ps += p0[r]; for (int r = 0; r < 16; ++r) ps += p1[r];
  { auto rr = __builtin_amdgcn_permlane32_swap(__float_as_uint(ps), __float_as_uint(ps), false, false);
    ps = __uint_as_float(rr[0]) + __uint_as_float(rr[1]); }
  l_reg = l_reg * alpha + ps;
#define PK4(P, BASE, OUT) do { unsigned a0 = cvtpk_a(P[BASE + 0], P[BASE + 1]), a1 = cvtpk_a(P[BASE + 2], P[BASE + 3]);   \
    unsigned b0 = cvtpk_a(P[BASE + 4], P[BASE + 5]), b1 = cvtpk_a(P[BASE + 6], P[BASE + 7]);                              \
    auto r0 = __builtin_amdgcn_permlane32_swap(a0, b0, false, false); auto r1 = __builtin_amdgcn_permlane32_swap(a1, b1, false, false); \
    u32x4 w = {r0[0], r1[0], r0[1], r1[1]}; OUT = *reinterpret_cast<bf16x8*>(&w); } while (0)
  PK4(p0, 0, pa0); PK4(p0, 8, pa1); PK4(p1, 0, pa2); PK4(p1, 8, pa3);
#undef PK4
}
__device__ __forceinline__ void qkt(f32x16& p0, f32x16& p1, const bf16_t* Ks, const bf16x8* qr, int r32, int hi) {
  p0 = f32x16{}; p1 = f32x16{};
  for (int d0 = 0; d0 < 8; ++d0) { int cb = (d0 * 16 + hi * 8) * 2;
    bf16x8 b0 = *reinterpret_cast<const bf16x8*>((const char*)Ks + KSWZ(r32, cb));
    bf16x8 b1 = *reinterpret_cast<const bf16x8*>((const char*)Ks + KSWZ(32 + r32, cb));
    p0 = __builtin_amdgcn_mfma_f32_32x32x16_bf16(b0, qr[d0], p0, 0, 0, 0);
    p1 = __builtin_amdgcn_mfma_f32_32x32x16_bf16(b1, qr[d0], p1, 0, 0, 0); }
}
__device__ __forceinline__ int v_st(int k, int c) { const int kk = (k & ~0xC) | ((k & 4) << 1) | ((k & 8) >> 1); return ((kk >> 3) * 4 + (c >> 5)) * 512 + ((kk & 7) * 32 + (c & 31)) * 2; }
__device__ __forceinline__ int v_rd_base(int lane) { return ((lane & 3) << 3) | (((lane >> 2) & 3) << 6) | (((lane >> 4) & 1) << 5) | (((lane >> 5) & 1) << 8); }
constexpr int v_rd_off(int d0, int ks, int half) { return d0 * 512 + ks * 4096 + half * 2048; }
template <int OFF> __device__ __forceinline__ s16x4 tr_read(int vb) {
  s16x4 r; asm volatile("ds_read_b64_tr_b16 %0, %1 offset:%2" : "=&v"(r) : "v"(vb), "i"(OFF) : "memory"); return r;
}
template <int D0> __device__ __forceinline__ void pv_one(f32x16& od, int vb, bf16x8 pa0, bf16x8 pa1, bf16x8 pa2, bf16x8 pa3) {
  const s16x4 l0 = tr_read<v_rd_off(D0, 0, 0)>(vb), h0 = tr_read<v_rd_off(D0, 0, 1)>(vb), l1 = tr_read<v_rd_off(D0, 1, 0)>(vb), h1 = tr_read<v_rd_off(D0, 1, 1)>(vb);
  const s16x4 l2 = tr_read<v_rd_off(D0, 2, 0)>(vb), h2 = tr_read<v_rd_off(D0, 2, 1)>(vb), l3 = tr_read<v_rd_off(D0, 3, 0)>(vb), h3 = tr_read<v_rd_off(D0, 3, 1)>(vb);
  asm volatile("s_waitcnt lgkmcnt(0)" ::: "memory"); SBAR();
#define PK(L, H) (bf16x8){L[0], L[1], L[2], L[3], H[0], H[1], H[2], H[3]}
  od = __builtin_amdgcn_mfma_f32_32x32x16_bf16(pa0, PK(l0, h0), od, 0, 0, 0);
  od = __builtin_amdgcn_mfma_f32_32x32x16_bf16(pa1, PK(l1, h1), od, 0, 0, 0);
  od = __builtin_amdgcn_mfma_f32_32x32x16_bf16(pa2, PK(l2, h2), od, 0, 0, 0);
  od = __builtin_amdgcn_mfma_f32_32x32x16_bf16(pa3, PK(l3, h3), od, 0, 0, 0);
#undef PK
}
__device__ __forceinline__ void pv_d0(f32x16* o, int vb, bf16x8 pa0, bf16x8 pa1, bf16x8 pa2, bf16x8 pa3) {
  pv_one<0>(o[0], vb, pa0, pa1, pa2, pa3); pv_one<1>(o[1], vb, pa0, pa1, pa2, pa3); pv_one<2>(o[2], vb, pa0, pa1, pa2, pa3); pv_one<3>(o[3], vb, pa0, pa1, pa2, pa3);
}
__device__ __forceinline__ void attn_dense_body(const bf16_t* __restrict__ Qb, const bf16_t* __restrict__ Kh, const bf16_t* __restrict__ Vh,
                                                bf16_t* __restrict__ Ob, int seq, char* lds) {
  const int tid = threadIdx.x, wid = tid >> 6, lane = tid & 63, r32 = lane & 31, hi = lane >> 5;
  bf16_t* V_lds = (bf16_t*)lds; bf16_t* K_lds = (bf16_t*)(lds + 2 * SHM_V);
  float* ws = (float*)(lds + 2 * SHM_V + 2 * SHM_K) + wid * 64; float* li_l = ws; float* al_l = ws + 32;
  float m_reg = -1e30f, l_reg = 0; f32x16 o[4] = {}; bf16x8 qr[8];
  const bf16_t* Qw = Qb + (long)(wid * QBLK + r32) * LDQ + hi * 8;
#pragma unroll
  for (int d0 = 0; d0 < 8; ++d0) qr[d0] = *reinterpret_cast<const bf16x8*>(Qw + d0 * 16);
  const int sr = tid >> 4, sc = (tid & 15) * 8, vst0 = v_st(sr, sc), vst1 = v_st(32 + sr, sc);
  const int vb0 = (int)(uintptr_t)V_lds + v_rd_base(lane);
  struct { bf16x8 vs0, vs1, ks0, ks1; } sr_[2];
#define LD8(p) (*reinterpret_cast<const bf16x8*>(p))
#define SLOAD(i, k0) do { sr_[i].vs0 = LD8(&Vh[(long)((k0) + sr) * LDK + sc]); sr_[i].vs1 = LD8(&Vh[(long)((k0) + 32 + sr) * LDK + sc]); \
    sr_[i].ks0 = LD8(&Kh[(long)((k0) + sr) * LDK + sc]); sr_[i].ks1 = LD8(&Kh[(long)((k0) + 32 + sr) * LDK + sc]); } while (0)
#define SWRITE(b, i) do { *(bf16x8*)((char*)V_lds + (b) * SHM_V + vst0) = sr_[i].vs0;          \
    *(bf16x8*)((char*)V_lds + (b) * SHM_V + vst1) = sr_[i].vs1; int kc = sc * 2;               \
    *(bf16x8*)((char*)K_lds + (b) * SHM_K + KSWZ(sr, kc)) = sr_[i].ks0;                       \
    *(bf16x8*)((char*)K_lds + (b) * SHM_K + KSWZ(32 + sr, kc)) = sr_[i].ks1; } while (0)
#define SWAIT() asm volatile("s_waitcnt vmcnt(4)" ::: "memory")
#define RESC(a) do { if (__any((a) < 1.f)) { if (hi == 0) al_l[r32] = (a); asm volatile("s_waitcnt lgkmcnt(0)" ::: "memory"); \
    for (int d = 0; d < 4; ++d) for (int r = 0; r < 16; ++r) o[d][r] *= al_l[crow(r, hi)]; } } while (0)
  f32x16 pA0, pA1, pB0, pB1; float mnA, mnB, alA, alB; bf16x8 pa0, pa1, pa2, pa3; const int NT = seq / KVBLK;
  constexpr int SE = 0, SO = 1;
  SLOAD(SE, 0); asm volatile("s_waitcnt vmcnt(0)" ::: "memory"); SWRITE(0, SE); __syncthreads();
  qkt(pA0, pA1, K_lds, qr, r32, hi); partialSM(pA0, pA1, m_reg, mnA, alA);
  SLOAD(SO, KVBLK); if (2 < NT) SLOAD(SE, 2 * KVBLK);
  SWAIT(); SWRITE(1, SO); __syncthreads();
  for (int j = 1; j + 1 < NT; j += 2) {
    SBAR(); qkt(pB0, pB1, (bf16_t*)((char*)K_lds + SHM_K), qr, r32, hi);
    finishSM(pA0, pA1, alA, l_reg, pa0, pa1, pa2, pa3); SBAR();
    SLOAD(SO, (j + 2) * KVBLK); SBAR();
    pv_d0(o, vb0, pa0, pa1, pa2, pa3); partialSM(pB0, pB1, m_reg, mnB, alB);
    __syncthreads(); SWAIT(); SWRITE(0, SE);
    RESC(alB); __syncthreads();
    SBAR(); qkt(pA0, pA1, K_lds, qr, r32, hi);
    finishSM(pB0, pB1, alB, l_reg, pa0, pa1, pa2, pa3); SBAR();
    if (j + 3 < NT) SLOAD(SE, (j + 3) * KVBLK); SBAR();
    pv_d0(o, vb0 + (int)SHM_V, pa0, pa1, pa2, pa3); partialSM(pA0, pA1, m_reg, mnA, alA);
    __syncthreads(); SWAIT(); SWRITE(1, SO);
    RESC(alA); __syncthreads();
  }
  SBAR(); qkt(pB0, pB1, (bf16_t*)((char*)K_lds + SHM_K), qr, r32, hi);
  finishSM(pA0, pA1, alA, l_reg, pa0, pa1, pa2, pa3); SBAR();
  pv_d0(o, vb0, pa0, pa1, pa2, pa3); partialSM(pB0, pB1, m_reg, mnB, alB);
  __syncthreads(); RESC(alB);
  finishSM(pB0, pB1, alB, l_reg, pa0, pa1, pa2, pa3); SBAR();
  pv_d0(o, vb0 + (int)SHM_V, pa0, pa1, pa2, pa3);
  if (hi == 0) li_l[r32] = l_reg; asm volatile("s_waitcnt lgkmcnt(0)" ::: "memory");
  float rli[16];
#pragma unroll
  for (int r = 0; r < 16; ++r) rli[r] = __builtin_amdgcn_rcpf(li_l[crow(r, hi)]);
  bf16_t* Ow = Ob + (long)(wid * QBLK) * LDO;
#pragma unroll
  for (int r = 0; r < 16; ++r) { int orow = crow(r, hi);
    for (int d0 = 0; d0 < 4; ++d0) { const float v = o[d0][r] * rli[r]; Ow[(long)orow * LDO + d0 * 32 + r32] = (bf16_t)(cvtpk(v, v) & 0xffffu); } }
  __syncthreads();
#undef LD8
#undef SLOAD
#undef SWRITE
#undef SWAIT
#undef RESC
}
#undef SBAR
}

constexpr int N_PHASES = 13;
__global__ void __launch_bounds__(NWAVES * 64, 2) fwd_kernel(Args args) {
    extern __shared__ __attribute__((aligned(16))) unsigned char lds_raw[];
    LAS unsigned char* lds = (LAS unsigned char*)lds_raw;
    volatile LAS unsigned* MISC = (volatile LAS unsigned*)(lds + MISC_OFF);
    const int tid = threadIdx.x, wave = __builtin_amdgcn_readfirstlane(tid >> 6);
    const int G = gridDim.x, bx = blockIdx.x;
    const int gw = bx * NWAVES + wave, NGW = G * NWAVES;
#define lane lane_id()
    gu32* ctl = (gu32*)(args.ws + WS_CTL);
    for (int u = tid; u < (LDS_BYTES - LDSCTL_OFF) / 4; u += NWAVES * 64) ((LAS unsigned*)(lds + LDSCTL_OFF))[u] = 0u;
    __syncthreads();
    XcdBarrier bar; bar.bar = (unsigned*)(ctl + CW_BAR); bar.x = 0; bar.st = nullptr;
    if (!MK_PER_PHASE) bar = xcd_barrier_post((unsigned*)(ctl + CW_BAR), MISC + 8);
    const int lo = args.ph_lo, hi = args.ph_hi;
#define IN(k) (lo <= (k) && (k) < hi)
#define STAMP(i) do { if (PROBE_PH >= 0 && bx == 0 && tid == 0) { MISC[16 + (i)] = (unsigned)__builtin_amdgcn_s_memrealtime(); MISC[15] = (unsigned)(i); } } while (0)
#define SEAM(k) do { if (IN(k) && IN((k) + 1)) xcd_barrier(bar); STAMP((k) + 1); } while (0)
#define W_IN ((bf16_t*)(args.ws + WS_WIN))
#define W_OUT ((bf16_t*)(args.ws + WS_WOUT))
#define W_POOL ((bf16_t*)(args.ws + WS_WPOOL))
#define W_M1 ((bf16_t*)(args.ws + WS_WM1))
#define W_M2 ((bf16_t*)(args.ws + WS_WM2))
#define Hb ((bf16_t*)(args.ws + WS_H))
#define ZB ((bf16_t*)(args.ws + WS_ZB))
#define LFb ((float*)(args.ws + WS_LF))
#define A2 ((bf16_t*)(args.ws + WS_A2))
#define XA ((float*)(args.ws + WS_XA))
#define Ub ((bf16_t*)(args.ws + WS_U))
#define MOD ((const float*)(args.ws + WS_MOD))
#define ROWSS ((float*)(args.ws + WS_ROWSS))
#define SW ((float*)(args.ws + WS_SW))
#define IDLE_FIRST(nwg) (((nwg) % G) ? ((nwg) % G) : 0)

    STAMP(0);
    if (IN(0)) {
        for (int wi = bx; wi < 256; wi += G) p0_ada_item(args, lds, wi, tid);
    }
    SEAM(0);
    if (IN(1)) { norm_rows_bf16(args, nullptr, args.in[10], 0, 0, Hb, gw, NGW, lane); bg_transposes(args, lds, R_IN, R_OUT, gw, NGW, wave, lane); }
    SEAM(1);
    if (IN(2)) { pg8::Gemm g{Hb, W_IN, NTOK, IN_AB, 2048, 2048, 2048, 0, 0}; pg8::StaticOrder S; S.init(NTOK, IN_AB, 2048, G, bx);
        EpiIn E{ZB, LFb, args.in[17]}; pg8::gemm_phase<EpiIn, pg8::StaticOrder>(lds, g, S, E);
        const int f = IDLE_FIRST(624); if (bx >= f) bg_transposes(args, lds, R_OUT, R_M2_0, (bx - f) * NWAVES + wave, (G - f) * NWAVES, wave, lane); }
    SEAM(2);
    if (IN(3)) {
        HgRegs RA, RB;
        if (bx < 192) hgrn_prefetch(args, bx, tid, RA, RB);
        for (int row = gw; row < NTOK; row += NGW) post_token(args, row, lane);
        for (int it = gw; it < 1024; it += NGW) cache_item(args, it, lane);
        if (bx < 192) hgrn_task(args, lds, bx, tid, RA, RB);
        else bg_transposes(args, lds, R_M2_0, R_POOL, (bx - 192) * NWAVES + wave, (G - 192) * NWAVES, wave, lane);
    }
    SEAM(3);
    if (IN(4)) {
        if (bx < 192) { const int u = bx;
            const bf16_t *Q, *K, *V; bf16_t* O; int seq;
            if (u < 64) { const int b = u >> 5, h = (u >> 2) & 7, qb = u & 3; const size_t row0 = NTOK_P + b * SEQ_S + qb * 256;
                Q = (const bf16_t*)(args.ws + WS_QN) + row0 * 1024 + h * 128; O = A2 + row0 * DM + h * 128;
                K = (const bf16_t*)(args.ws + WS_KS) + (size_t)(b * 2 + (h >> 2)) * 1280 * 128; V = (const bf16_t*)(args.ws + WS_VS) + (size_t)(b * 2 + (h >> 2)) * 1280 * 128; seq = 1280; }
            else { const int v = u - 64, b = v >> 3, h = v & 7; const size_t row0 = b * 256;
                Q = (const bf16_t*)(args.ws + WS_QN) + row0 * 1024 + h * 128; O = A2 + row0 * DM + h * 128;
                K = (const bf16_t*)(args.ws + WS_KP) + (size_t)(b * 2 + (h >> 2)) * 256 * 128; V = (const bf16_t*)(args.ws + WS_VP) + (size_t)(b * 2 + (h >> 2)) * 256 * 128; seq = 256; }
            att::attn_dense_body(Q, K, V, O, seq, (char*)lds_raw);
        }
        if (bx >= 192) { for (int t = bx - 192; t < 64; t += G - 192) hgfix_task(args, lds, t, tid); }
        else if (bx >= 64) { for (int row = (bx - 64) * NWAVES + wave; row < NTOK_P; row += 128 * NWAVES) combine_token(args, row, lane); }
    }
    SEAM(4);
    if (IN(5)) { pg8::Gemm g{A2, W_OUT, NTOK, DM, 2048, 2048, 2048, 0, 0}; pg8::StaticOrder S; S.init(NTOK, DM, 2048, G, bx);
        EpiRes E{args.in[0], args.in[1], XA, MOD + 2 * 2048, nullptr, Hb, args.in[11], MOD + 4 * 2048, ROWSS}; pg8::gemm_phase<EpiRes, pg8::StaticOrder>(lds, g, S, E);
        const int f = IDLE_FIRST(192); if (bx >= f) for (int wi = 256 + (bx - f); wi < 512; wi += G - f) p0_ada_item(args, lds, wi, tid); }
    SEAM(5);
    if (IN(6)) { pg8::Gemm g{Hb, W_M1, NTOK, DFF, 2048, 2048, 2048, 0, 0}; pg8::StaticOrder S; S.init(NTOK, DFF, 2048, G, bx);
        EpiRelu2 E{Ub, ROWSS, SW}; pg8::gemm_phase<EpiRelu2, pg8::StaticOrder>(lds, g, S, E); }
    SEAM(6);
    if (IN(7)) { pg8::Gemm g{Ub, W_M2, NTOK, DM, DFF, DFF, DFF, 0, 0}; pg8::StaticOrder S; S.init(NTOK, DM, DFF, G, bx);
        EpiRes E{XA, XA + (size_t)NTOK_P * DM, XA, MOD + 5 * 2048, nullptr, nullptr, nullptr, nullptr, ROWSS + NTOK}; pg8::gemm_phase<EpiRes, pg8::StaticOrder>(lds, g, S, E);
        const int f = IDLE_FIRST(192); if (bx >= f) bg_transposes(args, lds, R_POOL, R_END, (bx - f) * NWAVES + wave, (G - f) * NWAVES, wave, lane); }
    SEAM(7);
    if (IN(8)) pool_phase(args, lds, XA, ROWSS + NTOK, Hb, bx, G, tid);
    SEAM(8);
    if (IN(9)) { pg8::Gemm g{Hb, W_POOL, NTOK, DM, 512, 2048, 512, 1, 512}; pg8::StaticOrder S; S.init(NTOK, DM, 512, G, bx);
        EpiRes E{XA, XA + (size_t)NTOK_P * DM, XA, MOD + NMODC + 2 * 2048, args.in[19], A2, args.in[11] + 2048, MOD + NMODC + 4 * 2048, ROWSS + 2 * NTOK}; pg8::gemm_phase<EpiRes, pg8::StaticOrder>(lds, g, S, E); }
    SEAM(9);
    if (IN(10)) { pg8::Gemm g{A2, W_M1 + (size_t)DFF * 2048, NTOK, DFF, 2048, 2048, 2048, 0, 0}; pg8::StaticOrder S; S.init(NTOK, DFF, 2048, G, bx);
        EpiRelu2 E{Ub, ROWSS + 2 * NTOK, SW + 3 * DFF}; pg8::gemm_phase<EpiRelu2, pg8::StaticOrder>(lds, g, S, E); }
    SEAM(10);
    if (IN(11)) { pg8::Gemm g{Ub, W_M2 + (size_t)2048 * DFF, NTOK, DM, DFF, DFF, DFF, 0, 0}; pg8::SplitOrder S; S.init(NTOK, DM, DFF, G, bx);
        EpiRes E{XA, XA + (size_t)NTOK_P * DM, XA, MOD + NMODC + 5 * 2048, nullptr, nullptr, nullptr, nullptr, ROWSS + 3 * NTOK};
        pg8::gemm_phase<EpiRes, pg8::SplitOrder>(lds, g, S, E, pg8::PartCtx{(float*)(args.ws + WS_PART), (unsigned*)(args.ws + WS_CTL) + CW_PFLAG, 11u}); }
    SEAM(11);
    if (IN(12)) final_rows(XA, ROWSS + 3 * NTOK, args.in[22], args.out, gw, NGW, lane);
    if (PROBE_PH >= 0 && bx == 0 && tid == 0) { STAMP(13); const unsigned d = (MISC[PROBE_B] - MISC[PROBE_A]) * PROBE_K, t0 = (unsigned)__builtin_amdgcn_s_memrealtime();
        while ((unsigned)__builtin_amdgcn_s_memrealtime() - t0 < d) __builtin_amdgcn_s_sleep(8); }
#undef IN
#undef SEAM
#undef STAMP
#undef IDLE_FIRST
#undef lane
#undef W_IN
#undef W_OUT
#undef W_POOL
#undef W_M1
#undef W_M2
#undef Hb
#undef ZB
#undef LFb
#undef A2
#undef XA
#undef Ub
#undef MOD
#undef ROWSS
#undef SW
}

extern "C" void kernel_launch(void* const* d_in, const int* in_sizes, int n_in, void* d_out, int out_size, void* d_ws, size_t ws_size, hipStream_t stream) {
    static int grid = 0;
    if (grid == 0) {
        if (n_in != 23 || out_size != 18874368 || ws_size < WS_END) { fprintf(stderr, "kernel_launch: unexpected shapes (n_in %d out %d ws %zu)\n", n_in, out_size, ws_size); grid = -1; return; }
        int dev = 0, cus = 0;
        if (hipGetDevice(&dev) != hipSuccess || hipDeviceGetAttribute(&cus, hipDeviceAttributeMultiprocessorCount, dev) != hipSuccess) { grid = -1; return; }
        if (hipFuncSetAttribute((const void*)fwd_kernel, hipFuncAttributeMaxDynamicSharedMemorySize, LDS_BYTES) != hipSuccess) { fprintf(stderr, "kernel_launch: hipFuncSetAttribute failed\n"); grid = -1; return; }
        int per_cu = 0;
        if (hipOccupancyMaxActiveBlocksPerMultiprocessor(&per_cu, (const void*)fwd_kernel, NWAVES * 64, LDS_BYTES) != hipSuccess || per_cu < 1) fprintf(stderr, "kernel_launch: occupancy query says %d\n", per_cu);
        (void)hipGetLastError();
        if (cus != 256) { fprintf(stderr, "kernel_launch: built for a 256-CU device, found %d CUs\n", cus); grid = -1; return; }
        grid = cus;
    }
    if (grid < 0) return;
    (void)hipMemsetAsync((char*)d_ws + WS_CTL, 0, CTL_ZERO_BYTES, stream);
    Args a{};
    for (int i = 0; i < 23; ++i) a.in[i] = (const float*)d_in[i];
    a.out = (float*)d_out; a.ws = (unsigned char*)d_ws;
#if MK_PER_PHASE
    for (int p = 0; p < N_PHASES; ++p) { a.ph_lo = p; a.ph_hi = p + 1; hipLaunchKernelGGL(fwd_kernel, dim3(grid), dim3(NWAVES * 64), LDS_BYTES, stream, a);
        if (p == REP_PHASE) hipLaunchKernelGGL(fwd_kernel, dim3(grid), dim3(NWAVES * 64), LDS_BYTES, stream, a); }
#else
    a.ph_lo = 0; a.ph_hi = N_PHASES;
    hipLaunchKernelGGL(fwd_kernel, dim3(grid), dim3(NWAVES * 64), LDS_BYTES, stream, a);
#endif
}
```

```cpp
#include <hip/hip_runtime.h>
#include <hip/hip_bf16.h>
#include <cstdio>
#include <cstdint>

#ifndef MK_PER_PHASE
#define MK_PER_PHASE 0
#endif

#ifndef PROBE_PH
#define PROBE_PH -1
#endif
#define PROBE_K 8
#ifndef PROBE_A
#define PROBE_A (16 + PROBE_PH)
#define PROBE_B (17 + PROBE_PH)
#endif
#ifndef PROBE_GPH
#define PROBE_GPH -1
#endif
#ifndef REP_PHASE
#define REP_PHASE -1
#endif
constexpr int DM = 2048, NTOK_P = 4096, NTOK_S = 2048, NTOK = 6144, SEQ_P = 256, SEQ_S = 1024, NB_P = 16, NB_S = 2, PAST = 256;
constexpr int IN_AB = 6656, DFF = 8192, NMODC = 12288;
constexpr int C_Q = 0, C_K = 1024, C_V = 1280, C_HQ = 1536, C_ZF = 2560, C_ZB = 3584, C_HI = 4608, C_HG = 5632;
constexpr float EPS = 1e-6f;
constexpr int MISC_OFF = 131072 + 320;

#define GAS __attribute__((address_space(1)))
#define LAS __attribute__((address_space(3)))
typedef unsigned short bf16_t;
typedef short bf16x8 __attribute__((ext_vector_type(8)));
typedef short s16x4 __attribute__((ext_vector_type(4)));
typedef float f32x4 __attribute__((ext_vector_type(4)));
typedef float f32x2 __attribute__((ext_vector_type(2)));
typedef float f32x16 __attribute__((ext_vector_type(16)));
typedef unsigned u32x4 __attribute__((ext_vector_type(4)));
typedef unsigned u32x2 __attribute__((ext_vector_type(2)));
typedef __bf16 bf16x2_t __attribute__((ext_vector_type(2)));
typedef GAS unsigned gu32;

__device__ __forceinline__ unsigned cvtpk(float lo, float hi) { f32x2 v = {lo, hi}; bf16x2_t b = __builtin_convertvector(v, bf16x2_t); return __builtin_bit_cast(unsigned, b); }
__device__ __forceinline__ float bf2f(unsigned short u) { return __uint_as_float(((unsigned)u) << 16); }
__device__ __forceinline__ float bflo(unsigned u) { return __uint_as_float(u << 16); }
__device__ __forceinline__ float bfhi(unsigned u) { return __uint_as_float(u & 0xffff0000u); }
__device__ __forceinline__ float siluf(float x) { return x * __builtin_amdgcn_rcpf(1.f + __expf(-x)); }
__device__ __forceinline__ int lane_id() { int l; asm volatile("v_mbcnt_lo_u32_b32 %0, -1, 0\n\tv_mbcnt_hi_u32_b32 %0, -1, %0" : "=v"(l)); return l; }
__device__ __forceinline__ float wave_sum(float v) {
#pragma unroll
    for (int o = 1; o < 64; o <<= 1) v += __shfl_xor(v, o);
    return v;
}
__device__ __forceinline__ float half_sum(float v) {
#pragma unroll
    for (int o = 1; o < 32; o <<= 1) v += __shfl_xor(v, o);
    return v;
}

namespace pg8 {
#define PG8_LAS __attribute__((address_space(3)))
constexpr int BM = 256, BK = 64, HALF = 128, HTB = HALF * BK * 2, STAGE_BYTES = 8 * HTB, NXCD = 8, WGM = 8;
__host__ __device__ __forceinline__ int lds_byte(int r, int c) { const int st = (r >> 4) * 2 + (c >> 5), rr = r & 15, cc = c & 31, ob = rr * 64 + cc * 2; return st * 1024 + (ob ^ (((ob >> 9) & 1) << 5)); }
__host__ __device__ __forceinline__ void stage_rc(int b, int& R, int& C) { const int st = b / 1024, sb = b % 1024, swz = sb ^ (((sb >> 9) & 1) << 5); R = (st >> 1) * 16 + swz / 64; C = (st & 1) * 32 + (swz % 64) / 2; }
__host__ __device__ __forceinline__ int perm32(int rho) { const int n = rho >> 4, i = rho & 15; return 8 * (i >> 2) + 4 * n + (i & 3); }

struct Unit { int pm, pn, kt0, nkt, role, pidx; };
struct Gemm { const bf16_t* A; const bf16_t* Bt; int M, N, K, lda, ldb, apn_shift, apn_mul; };
struct PartCtx { float* part; unsigned* flags; unsigned epoch; };

struct StaticOrder {
    int nM, nN, nwg, G, c, nkt;
    __host__ __device__ void init(int M, int N, int K, int G_, int c_, int bmr = BM) { nM = M / bmr; nN = N / BM; nwg = nM * nN; G = G_; c = c_; nkt = K / BK; }
    __host__ __device__ void unit_of(int L, Unit& u) const {
        int wgid = L; { const int q = nwg / NXCD, r = nwg % NXCD, xcd = wgid % NXCD, off = wgid / NXCD; wgid = (xcd < r ? xcd * (q + 1) : r * (q + 1) + (xcd - r) * q) + off; }
        const int nig = WGM * nN, gid = wgid / nig, fm = gid * WGM, gsz = (nM - fm) < WGM ? (nM - fm) : WGM;
        u.pm = fm + ((wgid % nig) % gsz); u.pn = (wgid % nig) / gsz;
    }
    __host__ __device__ bool next(int i, Unit& u) const {
        const long L = (long)i * G + c; if (L >= nwg) return false;
        unit_of((int)L, u); u.kt0 = 0; u.nkt = nkt; u.role = 0; u.pidx = 0; return true;
    }
};
struct SplitOrder {
    StaticOrder S;
    __host__ __device__ void init(int M, int N, int K, int G_, int c_) { S.init(M, N, K, G_, c_); }
    __host__ __device__ bool next(int i, Unit& u) const {
        const int q = S.nkt / 4;
        if (S.c < S.nwg) { if (i > 0) return false; S.unit_of(S.c, u); u.kt0 = 0; u.nkt = 3 * q; u.role = 1; u.pidx = S.c; return true; }
        if (i >= 3) return false;
        const int L = 3 * (S.c - S.nwg) + i; if (L >= S.nwg) return false;
        S.unit_of(L, u); u.kt0 = 3 * q; u.nkt = q; u.role = 2; u.pidx = L; return true;
    }
};
struct TailSplitOrder {
    StaticOrder S;
    __host__ __device__ void init(int M, int N, int K, int G_, int c_) { S.init(M, N, K, G_, c_); }
    __host__ __device__ bool next(int i, Unit& u) const {
        if (i < 2) return S.next(i, u);
        if (i > 2) return false;
        const int r = S.nwg - 2 * S.G, p = S.c >> 1; if (p >= r) return false;
        S.unit_of(2 * S.G + p, u); const int h = S.nkt / 2;
        if (S.c & 1) { u.kt0 = h; u.nkt = h; u.role = 2; } else { u.kt0 = 0; u.nkt = h; u.role = 1; }
        u.pidx = p; return true;
    }
};

template <class Epi, class Sched, bool ALIGN_EPI = true, int MR = 4>
__device__ __forceinline__ void gemm_phase(PG8_LAS unsigned char* lds, const Gemm g, const Sched& S, const Epi& E, const PartCtx pc = PartCtx{nullptr, nullptr, 0u}) {
    const int tid = threadIdx.x, wid = __builtin_amdgcn_readfirstlane(tid >> 6), lane = tid & 63, wr = wid >> 2, wc = wid & 3, fr = lane & 15, fq = lane >> 4;
    unsigned voffA[2], voffB[2];
#pragma unroll
    for (int i = 0; i < 2; ++i) { int R, C; stage_rc(tid * 16 + i * 8192, R, C); const int Rb = Epi::PERM ? ((R & ~31) + perm32(R & 31)) : R;
        voffA[i] = (unsigned)(R * g.lda + C) * 2u; voffB[i] = (unsigned)(Rb * g.ldb + C) * 2u; }
    const size_t kstep = (size_t)(BK * 2);
    const size_t hstepA = (size_t)(32 * MR) * g.lda * 2, hstepB = (size_t)HALF * g.ldb * 2;
    const size_t tstepA = 2 * hstepA, tstepB = 2 * hstepB;
    const unsigned ldsw = (unsigned)wid * 1024u;
    const int aoff = lds_byte(wr * (16 * MR) + fr, fq * 8), boff = lds_byte(wc * 32 + fr, fq * 8);
#define PG8_SA(b, h) (((b) * 2 + (h)) * HTB)
#define PG8_SB(b, h) ((4 + (b) * 2 + (h)) * HTB)
#define PG8_STAGE(bufoff, gbase, voff) do { _Pragma("unroll") for (int _i = 0; _i < 2; ++_i) \
        __builtin_amdgcn_global_load_lds((const unsigned*)((const char*)(gbase) + (voff)[_i]), (PG8_LAS unsigned*)(lds + (bufoff) + ldsw + _i * 8192), 16, 0, 0); } while (0)
#define PG8_LDA(dst, b, h) do { _Pragma("unroll") for (int m = 0; m < MR; ++m) _Pragma("unroll") for (int k = 0; k < 2; ++k) dst[m][k] = *(const PG8_LAS bf16x8*)(lds + PG8_SA(b, h) + aoff + m * 2048 + k * 1024); } while (0)
#define PG8_LDB(dst, b, h) do { _Pragma("unroll") for (int n = 0; n < 2; ++n) _Pragma("unroll") for (int k = 0; k < 2; ++k) dst[n][k] = *(const PG8_LAS bf16x8*)(lds + PG8_SB(b, h) + boff + n * 2048 + k * 1024); } while (0)
#define PG8_MMA(ai, bj, At, Bt) do { __builtin_amdgcn_s_setprio(1); _Pragma("unroll") for (int m = 0; m < MR; ++m) _Pragma("unroll") for (int n = 0; n < 2; ++n) _Pragma("unroll") for (int k = 0; k < 2; ++k) \
        acc[ai][bj][m][n] = __builtin_amdgcn_mfma_f32_16x16x32_bf16(Bt[n][k], At[m][k], acc[ai][bj][m][n], 0, 0, 0); __builtin_amdgcn_s_setprio(0); } while (0)
#define PG8_WAIT_V(n) asm volatile("s_waitcnt vmcnt(" #n ")" ::: "memory")
#define PG8_WAIT_L(n) asm volatile("s_waitcnt lgkmcnt(" #n ")" ::: "memory")
#define PG8_BAR __builtin_amdgcn_s_barrier()
#define PG8_SCHED __builtin_amdgcn_sched_barrier(0)
#define PG8_AOFF(u) ((size_t)(((u).pn >> g.apn_shift) * g.apn_mul) * 2)
#define GSTAMP(i) do { if (PROBE_PH >= 0 && PROBE_GPH >= 0 && blockIdx.x == 0 && tid == 0) { volatile PG8_LAS unsigned* M_ = (volatile PG8_LAS unsigned*)(lds + MISC_OFF); if (M_[15] == (unsigned)PROBE_GPH) M_[40 + (i)] = (unsigned)__builtin_amdgcn_s_memrealtime(); } } while (0)
    Unit cur, nxt; int ui = 0;
    if (!S.next(0, cur)) return;
    GSTAMP(0);
    f32x4 acc[2][2][MR][2];
#pragma unroll
    for (int a = 0; a < 2; ++a)
#pragma unroll
        for (int b = 0; b < 2; ++b)
#pragma unroll
            for (int m = 0; m < MR; ++m)
#pragma unroll
                for (int n = 0; n < 2; ++n) acc[a][b][m][n] = (f32x4){0.f, 0.f, 0.f, 0.f};
    bf16x8 At[MR][2], B0[2][2], B1[2][2];
    const char* cA = (const char*)g.A + (size_t)cur.pm * tstepA + PG8_AOFF(cur) + (size_t)cur.kt0 * kstep; const char* cB = (const char*)g.Bt + (size_t)cur.pn * tstepB + (size_t)cur.kt0 * kstep;
    {
        PG8_STAGE(PG8_SB(0, 0), cB, voffB); PG8_STAGE(PG8_SB(0, 1), cB + hstepB, voffB); PG8_STAGE(PG8_SA(0, 0), cA, voffA); PG8_STAGE(PG8_SA(0, 1), cA + hstepA, voffA);
        if (wr == 1) PG8_BAR;
        PG8_WAIT_V(2); PG8_BAR;
        PG8_STAGE(PG8_SB(1, 0), cB + kstep, voffB); PG8_STAGE(PG8_SA(1, 0), cA + kstep, voffA); PG8_STAGE(PG8_SB(1, 1), cB + hstepB + kstep, voffB);
        PG8_WAIT_V(6); PG8_BAR;
    }
    for (;;) {
        const bool has_next = S.next(ui + 1, nxt);
        const char* nA = has_next ? (const char*)g.A + (size_t)nxt.pm * tstepA + PG8_AOFF(nxt) + (size_t)nxt.kt0 * kstep : cA; const char* nB = has_next ? (const char*)g.Bt + (size_t)nxt.pn * tstepB + (size_t)nxt.kt0 * kstep : cB;
        const int nt = cur.nkt;
        for (int t = 0; t < nt; t += 2) {
            const bool last = (t == nt - 2);
            const char* a1 = cA + (size_t)(t + 1) * kstep;
            const char* a2 = last ? nA : cA + (size_t)(t + 2) * kstep; const char* b2 = last ? nB : cB + (size_t)(t + 2) * kstep;
            const char* a3 = a2 + kstep; const char* b3 = b2 + kstep;
            PG8_LDB(B0, 0, 0); PG8_LDB(B1, 0, 1); PG8_SCHED; PG8_LDA(At, 0, 0); PG8_STAGE(PG8_SA(1, 1), a1 + hstepA, voffA);
            PG8_WAIT_V(8); PG8_WAIT_L(0); PG8_BAR; PG8_MMA(0, 0, At, B0); PG8_MMA(0, 1, At, B1); PG8_BAR; PG8_SCHED;
            PG8_LDA(At, 0, 1); PG8_STAGE(PG8_SB(0, 0), b2, voffB); PG8_STAGE(PG8_SB(0, 1), b2 + hstepB, voffB); PG8_STAGE(PG8_SA(0, 0), a2, voffA);
            PG8_WAIT_V(8); PG8_WAIT_L(0); PG8_BAR; PG8_MMA(1, 0, At, B0); PG8_MMA(1, 1, At, B1); PG8_BAR; PG8_SCHED;
            PG8_LDB(B0, 1, 0); PG8_LDB(B1, 1, 1); PG8_SCHED; PG8_LDA(At, 1, 0); PG8_STAGE(PG8_SA(0, 1), a2 + hstepA, voffA);
            PG8_WAIT_V(8); PG8_WAIT_L(0); PG8_BAR; PG8_MMA(0, 0, At, B0); PG8_MMA(0, 1, At, B1); PG8_BAR; PG8_SCHED;
            PG8_LDA(At, 1, 1); PG8_STAGE(PG8_SB(1, 0), b3, voffB); PG8_STAGE(PG8_SB(1, 1), b3 + hstepB, voffB); PG8_STAGE(PG8_SA(1, 0), a3, voffA);
            PG8_WAIT_V(8); PG8_WAIT_L(0); PG8_BAR; PG8_MMA(1, 0, At, B0); PG8_MMA(1, 1, At, B1); PG8_BAR; PG8_SCHED;
        }
        if constexpr (ALIGN_EPI) { if (wr == 0) PG8_BAR; }
        GSTAMP(1);
        if (cur.role == 2) {
            const __amdgpu_buffer_rsrc_t pr = __builtin_amdgcn_make_buffer_rsrc((void*)(pc.part + (size_t)cur.pidx * 65536), 0, 262144, 0x00020000);
            const unsigned pb = (unsigned)(wid * 2048 + lane) * 16u;
#pragma unroll
            for (int a = 0; a < 2; ++a)
#pragma unroll
                for (int b = 0; b < 2; ++b)
#pragma unroll
                    for (int m = 0; m < MR; ++m)
#pragma unroll
                        for (int n = 0; n < 2; ++n) __builtin_amdgcn_raw_buffer_store_b128(__builtin_bit_cast(u32x4, acc[a][b][m][n]), pr, pb + (unsigned)((((a * 2 + b) * 4 + m) * 2 + n) * 1024), 0, 16);
            asm volatile("s_waitcnt vmcnt(0)" ::: "memory"); PG8_BAR;
            if (tid == 0) __hip_atomic_store(pc.flags + 16 * cur.pidx, pc.epoch, __ATOMIC_RELAXED, __HIP_MEMORY_SCOPE_AGENT);
        } else {
            if (cur.role == 1) {
                if (wid == 0) { unsigned sp = 0; while (__hip_atomic_load(pc.flags + 16 * cur.pidx, __ATOMIC_RELAXED, __HIP_MEMORY_SCOPE_AGENT) != pc.epoch) { __builtin_amdgcn_s_sleep(2); if (++sp > (1u << 22)) break; }
                    __builtin_amdgcn_fence(__ATOMIC_ACQUIRE, "agent"); asm volatile("s_waitcnt vmcnt(0)" ::: "memory"); }
                PG8_BAR; asm volatile("" ::: "memory");
                const f32x4* ps = (const f32x4*)(pc.part + (size_t)cur.pidx * 65536) + wid * 2048 + lane;
#pragma unroll
                for (int a = 0; a < 2; ++a)
#pragma unroll
                    for (int b = 0; b < 2; ++b)
#pragma unroll
                        for (int m = 0; m < MR; ++m)
#pragma unroll
                            for (int n = 0; n < 2; ++n) acc[a][b][m][n] += ps[(((a * 2 + b) * 4 + m) * 2 + n) * 64];
            }
            E(acc, cur, wr, wc, fr, fq);
        }
        GSTAMP(2);
        if (!has_next) break;
#pragma unroll
        for (int a = 0; a < 2; ++a)
#pragma unroll
            for (int b = 0; b < 2; ++b)
#pragma unroll
                for (int m = 0; m < MR; ++m)
#pragma unroll
                    for (int n = 0; n < 2; ++n) acc[a][b][m][n] = (f32x4){0.f, 0.f, 0.f, 0.f};
        cur = nxt; cA = nA; cB = nB; ++ui;
        if constexpr (ALIGN_EPI) { if (wr == 1) PG8_BAR; }
    }
    PG8_WAIT_V(0);
    if constexpr (!ALIGN_EPI) { if (wr == 0) PG8_BAR; }
    PG8_BAR;
    GSTAMP(3);
#undef GSTAMP
#undef PG8_SA
#undef PG8_SB
#undef PG8_STAGE
#undef PG8_LDA
#undef PG8_LDB
#undef PG8_MMA
#undef PG8_WAIT_V
#undef PG8_WAIT_L
#undef PG8_BAR
#undef PG8_SCHED
#undef PG8_AOFF
}
}

constexpr size_t MiB = 1u << 20;
constexpr size_t WS_CTL = 0, CTL_ZERO_BYTES = 704 * 1024;
constexpr size_t WS_ROWSS = 64 * 1024;
constexpr size_t WS_SW = 160 * 1024;
constexpr size_t WS_MOD = 384 * 1024;
constexpr size_t WS_WIN = 2 * MiB;
constexpr size_t WS_WOUT = 28 * MiB;
constexpr size_t WS_WPOOL = 36 * MiB;
constexpr size_t WS_WM1 = 38 * MiB;
constexpr size_t WS_WM2 = 102 * MiB;
constexpr size_t WS_H = 166 * MiB;
constexpr size_t WS_ZB = 190 * MiB;
constexpr size_t WS_LF = 268 * MiB;
constexpr size_t WS_QN = 316 * MiB;
constexpr size_t WS_KP = 328 * MiB;
constexpr size_t WS_VP = 330 * MiB;
constexpr size_t WS_KS = 332 * MiB;
constexpr size_t WS_VS = 334 * MiB;
constexpr size_t WS_OF = 336 * MiB;
constexpr size_t WS_OB = 360 * MiB;
constexpr size_t WS_A2 = 384 * MiB;
constexpr size_t WS_XA = 408 * MiB;
constexpr size_t WS_U = 456 * MiB;
constexpr size_t WS_SEND = 552 * MiB;
constexpr size_t WS_LSEG = 560 * MiB;
constexpr size_t WS_PART = 562 * MiB;
constexpr size_t WS_END = 610 * MiB;
constexpr int CW_BAR = 1024;
constexpr int CW_ADA1 = 14400;
constexpr int CW_PFLAG = 8192;

constexpr int RING_BYTES = 131072, LDSCTL_OFF = RING_BYTES, LDS_BYTES = 147456;
constexpr int NWAVES = 8;

#define RLX_AGENT __ATOMIC_RELAXED, __HIP_MEMORY_SCOPE_AGENT
#define LDS_WAIT() asm volatile("s_waitcnt lgkmcnt(0)" ::: "memory")
#define VM_WAIT() asm volatile("s_waitcnt vmcnt(0)" ::: "memory")

#define XB_TMO      128
#define XB_XCNT(j)  (256  + 64 * (j))
#define XB_XSUB(j)  (1280 + 64 * (j))
#define XB_XGEN(j)  (2304 + 64 * (j))
#define XB_TOP      3328
#define XB_TOPGEN   3392
#define XCD_BAR_WORDS 3456
#define XB_SPIN_CAP (1u << 18)
__device__ __forceinline__ unsigned xb_ld(unsigned* p)              { return __hip_atomic_load(p, __ATOMIC_RELAXED, __HIP_MEMORY_SCOPE_AGENT); }
__device__ __forceinline__ unsigned xb_add(unsigned* p, unsigned v) { return __hip_atomic_fetch_add(p, v, __ATOMIC_RELAXED, __HIP_MEMORY_SCOPE_AGENT); }
__device__ __forceinline__ unsigned xb_xcc_id() { return (unsigned)__builtin_amdgcn_s_getreg((3 << 11) | 20) & 0xFu; }
#define XB_SPIN(cond, bar) do { unsigned _sp = 0; while (cond) { __builtin_amdgcn_s_sleep(1); \
    if ((++_sp & 255u) == 0u) { if (xb_ld(&(bar)[XB_TMO])) break; if (_sp > XB_SPIN_CAP) { atomicAdd(&(bar)[XB_TMO], 1u); break; } } } } while (0)
struct XcdBarrier { unsigned* bar; unsigned x; volatile LAS unsigned* st; };
__device__ __forceinline__ XcdBarrier xcd_barrier_post(unsigned* bar, volatile LAS unsigned* st) {
    XcdBarrier b; b.bar = bar; b.x = xb_xcc_id(); b.st = st;
    if (threadIdx.x == 0) (void)xb_add(&bar[XB_XCNT(b.x)], 1u);
    return b;
}
__device__ __forceinline__ void xcd_barrier_complete(unsigned* bar, unsigned x, unsigned& nloc, unsigned& nx) {
    const unsigned G = gridDim.x * gridDim.y * gridDim.z;
    unsigned sum, cnt, mine, sp = 0u;
    for (;;) {
        sum = 0u; cnt = 0u; mine = 0u;
#pragma unroll
        for (unsigned j = 0; j < 16; ++j) { const unsigned c = xb_ld(&bar[XB_XCNT(j)]); sum += c; cnt += (c > 0u) ? 1u : 0u; mine = (j == x) ? c : mine; }
        if (sum == G) break;
        __builtin_amdgcn_s_sleep(1);
        if ((++sp & 255u) == 0u) { if (xb_ld(&bar[XB_TMO])) break; if (sp > XB_SPIN_CAP) { atomicAdd(&bar[XB_TMO], 1u); break; } }
    }
    nloc = mine > 0u ? mine : 1u; nx = cnt > 0u ? cnt : 1u;
}
__device__ __forceinline__ void xcd_barrier(const XcdBarrier& b) {
    asm volatile("s_waitcnt vmcnt(0)" ::: "memory");
    __syncthreads();
    if (threadIdx.x == 0) {
        unsigned* bar = b.bar;
        __builtin_amdgcn_s_waitcnt(0);
        unsigned nloc = b.st[0], nx = b.st[1];
        if (nloc == 0u) { xcd_barrier_complete(bar, b.x, nloc, nx); b.st[0] = nloc; b.st[1] = nx; }
        const unsigned old = xb_add(&bar[XB_XSUB(b.x)], 1u);
        const unsigned gen = old / nloc;
        if (old + 1u == (gen + 1u) * nloc) {
            __builtin_amdgcn_fence(__ATOMIC_RELEASE, "agent");
            asm volatile("s_waitcnt vmcnt(0)" ::: "memory");
            const unsigned og = xb_add(&bar[XB_TOP], 1u);
            const unsigned tg = og / nx;
            if (og + 1u == (tg + 1u) * nx) xb_add(&bar[XB_TOPGEN], 1u);
            else XB_SPIN(xb_ld(&bar[XB_TOPGEN]) == tg, bar);
            __builtin_amdgcn_fence(__ATOMIC_ACQUIRE, "agent");
            xb_add(&bar[XB_XGEN(b.x)], 1u);
            asm volatile("s_waitcnt vmcnt(0)" ::: "memory");
        } else {
            XB_SPIN(xb_ld(&bar[XB_XGEN(b.x)]) == gen, bar);
            __builtin_amdgcn_fence(__ATOMIC_ACQUIRE, "agent");
            asm volatile("s_waitcnt vmcnt(0)" ::: "memory");
        }
    }
    __syncthreads();
}

struct Args { const float* in[23]; float* out; unsigned char* ws; int ph_lo, ph_hi; };

__device__ __forceinline__ int cvec_of_row(int row) { return row < NTOK_P ? 0 : 1 + ((row - NTOK_P) >> 10); }
__device__ __forceinline__ const float* xin_row(const Args& a, int row) { return row < NTOK_P ? a.in[0] + (size_t)row * DM : a.in[1] + (size_t)(row - NTOK_P) * DM; }

struct EpiIn {
    static constexpr bool PERM = true;
    bf16_t* ZB; float* LF; const float* lb_raw;
    __device__ __forceinline__ void operator()(const f32x4 (&acc)[2][2][4][2], const pg8::Unit& u, int wr, int wc, int fr, int fq) const {
        const int row0 = u.pm * 256 + wr * 64 + fr, colt = u.pn * 256, cl = wc * 32 + 8 * fq;
        if (colt >= C_ZF && colt < C_HI) {
#pragma unroll
            for (int bj = 0; bj < 2; ++bj) {
                const int c2 = colt + bj * 128 + cl - C_ZF, dir = c2 >> 10, ch = c2 & 1023;
                float lb[8];
#pragma unroll
                for (int e = 0; e < 8; ++e) { const float x0 = lb_raw[dir * 3072 + ch + e], x1 = lb_raw[dir * 3072 + 1024 + ch + e], x2 = lb_raw[dir * 3072 + 2048 + ch + e];
                    lb[e] = 1.f / (1.f + __expf(x1 - x0) + __expf(x2 - x0)); }
#pragma unroll
                for (int ai = 0; ai < 2; ++ai)
#pragma unroll
                    for (int m = 0; m < 4; ++m) {
                        float* dst = LF + (size_t)(row0 + ai * 128 + m * 16) * 2048 + c2;
                        f32x4 o[2];
#pragma unroll
                        for (int n = 0; n < 2; ++n)
#pragma unroll
                            for (int e = 0; e < 4; ++e) { const float z = acc[ai][bj][m][n][e], sg = __builtin_amdgcn_rcpf(1.f + __expf(-z)), l = lb[n * 4 + e]; o[n][e] = __logf(l + (1.f - l) * sg); }
                        *(f32x4*)dst = o[0]; *(f32x4*)(dst + 4) = o[1];
                    }
            }
        } else {
            const bool act = (colt >= C_HQ && colt < C_ZF) || colt >= C_HG;
#pragma unroll
            for (int ai = 0; ai < 2; ++ai)
#pragma unroll
                for (int m = 0; m < 4; ++m) {
                    bf16_t* rowp = ZB + (size_t)(row0 + ai * 128 + m * 16) * IN_AB + colt + cl;
#pragma unroll
                    for (int bj = 0; bj < 2; ++bj) { f32x4 v0 = acc[ai][bj][m][0], v1 = acc[ai][bj][m][1];
                        if (act) {
#pragma unroll
                            for (int e = 0; e < 4; ++e) { v0[e] = siluf(v0[e]); v1[e] = siluf(v1[e]); } }
                        u32x4 w; w.x = cvtpk(v0[0], v0[1]); w.y = cvtpk(v0[2], v0[3]); w.z = cvtpk(v1[0], v1[1]); w.w = cvtpk(v1[2], v1[3]);
                        *(u32x4*)(rowp + bj * 128) = w; }
                }
        }
    }
};
template <int MR> struct EpiRes {
    static constexpr bool PERM = true;
    static constexpr int RG = (MR == 3) ? 3 : 2, GR = 2 * RG, NG = 2 * 2 * MR / RG;
    const float* baseP; const float* baseS; float* out; const float* gate; const float* pscale;
    bf16_t* XG; const float* ngain; const float* nsc;
    float* rowss;
    static __device__ __forceinline__ constexpr int g_bj(int q) { return MR == 3 ? (q >> 1) : (q >> 2); }
    static __device__ __forceinline__ constexpr int g_ai(int q) { return MR == 3 ? (q & 1) : ((q >> 1) & 1); }
    static __device__ __forceinline__ constexpr int g_m(int q, int r) { return MR == 3 ? r : 2 * (q & 1) + r; }
    __device__ __forceinline__ void operator()(const f32x4 (&acc)[2][2][MR][2], const pg8::Unit& u, int wr, int wc, int fr, int fq) const {
        const int ucol = u.pn * 256 + wc * 32;
        const int R0 = u.pm * (64 * MR) + wr * (16 * MR);
        const unsigned lv = (unsigned)(fr * DM + 8 * fq) * 4u, lv2 = (unsigned)(fr * DM + 8 * fq) * 2u, lq = (unsigned)fq * 32u;
        float ss[2][MR];
#pragma unroll
        for (int ai = 0; ai < 2; ++ai)
#pragma unroll
            for (int m = 0; m < MR; ++m) ss[ai][m] = 0.f;
        f32x4 bcur[GR], bnxt[GR];
#define ER_ROW2(ai, m) (R0 + (ai) * (32 * MR) + (m) * 16)
#define ER_BASE(R) ((const char*)((R) < NTOK_P ? baseP + (size_t)(R) * DM : baseS + (size_t)((R) - NTOK_P) * DM))
#define ER_LOAD(dst, q) do { _Pragma("unroll") for (int r = 0; r < RG; ++r) { const char* p_ = ER_BASE(ER_ROW2(g_ai(q), g_m(q, r))) + (size_t)(ucol + g_bj(q) * 128) * 4 + lv; \
            dst[2 * r] = *(const f32x4*)p_; dst[2 * r + 1] = *(const f32x4*)(p_ + 16); } } while (0)
        ER_LOAD(bcur, 0);
        const int cvA = cvec_of_row(u.pm * (64 * MR)), cvB = cvec_of_row(u.pm * (64 * MR) + 64 * MR - 1); const bool uni = cvA == cvB;
        f32x4 g4u[2] = {{0.f, 0.f, 0.f, 0.f}, {0.f, 0.f, 0.f, 0.f}}, gmu[2] = {{0.f, 0.f, 0.f, 0.f}, {0.f, 0.f, 0.f, 0.f}};
#define ER_GATES(G4, GM, cv_) do { const char* gq_ = (const char*)(gate + (size_t)(cv_) * 2 * NMODC + cu) + lq; G4[0] = *(const f32x4*)gq_; G4[1] = *(const f32x4*)(gq_ + 16); \
            if (pscale) { const char* pq_ = (const char*)(pscale + cu) + lq; G4[0] = G4[0] * *(const f32x4*)pq_; G4[1] = G4[1] * *(const f32x4*)(pq_ + 16); } \
            if (XG) { const char* nq_ = (const char*)(ngain + cu) + lq; const char* sq_ = (const char*)(nsc + (size_t)(cv_) * 2 * NMODC + cu) + lq; \
                GM[0] = *(const f32x4*)nq_ * (*(const f32x4*)sq_ + 1.f); GM[1] = *(const f32x4*)(nq_ + 16) * (*(const f32x4*)(sq_ + 16) + 1.f); } } while (0)
#pragma unroll
        for (int q = 0; q < NG; ++q) {
            const int bj = g_bj(q), ai = g_ai(q), cu = ucol + bj * 128;
            if (uni && (q == 0 || g_bj(q) != g_bj(q > 0 ? q - 1 : 0))) ER_GATES(g4u, gmu, cvA);
            if (q < NG - 1) ER_LOAD(bnxt, q + 1);
            asm volatile("" ::: "memory");
#pragma unroll
            for (int r = 0; r < RG; ++r) {
                const int m = g_m(q, r), R = ER_ROW2(ai, m);
                f32x4 g4[2] = {g4u[0], g4u[1]}, gm[2] = {gmu[0], gmu[1]};
                if (!uni) ER_GATES(g4, gm, cvec_of_row(R));
                const f32x4 x0 = bcur[2 * r] + g4[0] * acc[ai][bj][m][0], x1 = bcur[2 * r + 1] + g4[1] * acc[ai][bj][m][1];
                char* op_ = (char*)(out + (size_t)R * DM + cu) + lv; *(f32x4*)op_ = x0; *(f32x4*)(op_ + 16) = x1;
                ss[ai][m] += ((x0.x * x0.x + x0.y * x0.y) + (x0.z * x0.z + x0.w * x0.w)) + ((x1.x * x1.x + x1.y * x1.y) + (x1.z * x1.z + x1.w * x1.w));
                if (XG) { const f32x4 y0 = x0 * gm[0], y1 = x1 * gm[1]; u32x4 w; w.x = cvtpk(y0.x, y0.y); w.y = cvtpk(y0.z, y0.w); w.z = cvtpk(y1.x, y1.y); w.w = cvtpk(y1.z, y1.w);
                    *(u32x4*)((char*)(XG + (size_t)R * DM + cu) + lv2) = w; } }
            asm volatile("" ::: "memory");
#pragma unroll
            for (int r = 0; r < GR; ++r) bcur[r] = bnxt[r];
        }
#undef ER_GATES
#undef ER_LOAD
#undef ER_BASE
#pragma unroll
        for (int ai = 0; ai < 2; ++ai)
#pragma unroll
            for (int m = 0; m < MR; ++m) { float s = ss[ai][m]; s += __shfl_xor(s, 16); s += __shfl_xor(s, 32);
                if (fq == 0) atomicAdd(rowss + ER_ROW2(ai, m) + fr, s); }
#undef ER_ROW2
    }
};
struct EpiRelu2 {
    static constexpr bool PERM = true;
    bf16_t* U; const float* rowss; const float* sW;
    __device__ __forceinline__ void operator()(const f32x4 (&acc)[2][2][4][2], const pg8::Unit& u, int wr, int wc, int fr, int fq) const {
        const int row0 = u.pm * 256 + wr * 64 + fr, col0 = u.pn * 256 + wc * 32 + 8 * fq;
        const int cv = u.pm < 16 ? 0 : 1 + ((u.pm - 16) >> 2);
        f32x4 sw[2][2];
#pragma unroll
        for (int bj = 0; bj < 2; ++bj)
#pragma unroll
            for (int n = 0; n < 2; ++n) sw[bj][n] = *(const f32x4*)(sW + (size_t)cv * DFF + col0 + bj * 128 + 4 * n);
#pragma unroll
        for (int ai = 0; ai < 2; ++ai)
#pragma unroll
            for (int m = 0; m < 4; ++m) { const int row = row0 + ai * 128 + m * 16; bf16_t* rowp = U + (size_t)row * DFF + col0;
                const float rs = rsqrtf(rowss[row] * (1.f / DM) + EPS);
#pragma unroll
                for (int bj = 0; bj < 2; ++bj) { f32x4 v0 = acc[ai][bj][m][0] * rs + sw[bj][0], v1 = acc[ai][bj][m][1] * rs + sw[bj][1];
#pragma unroll
                    for (int e = 0; e < 4; ++e) { const float a = fmaxf(v0[e], 0.f), b = fmaxf(v1[e], 0.f); v0[e] = a * a; v1[e] = b * b; }
                    u32x4 w; w.x = cvtpk(v0[0], v0[1]); w.y = cvtpk(v0[2], v0[3]); w.z = cvtpk(v1[0], v1[1]); w.w = cvtpk(v1[2], v1[3]);
                    *(u32x4*)(rowp + bj * 128) = w; } }
    }
};

struct TrDesc { const float* W; bf16_t* WT; const float* shp; float* sWp; int K, N, row_off, item; };
__device__ __forceinline__ void tr_load(const TrDesc& d, f32x4 (&v)[8], int lane) {
    const int nblk = d.N / 32, kb = d.item / nblk, nb = d.item % nblk, k0 = 64 * kb, n0 = 32 * nb;
    const float* p = d.W + (size_t)(k0 + (lane >> 3)) * d.N + n0 + 4 * (lane & 7);
#pragma unroll
    for (int i = 0; i < 8; ++i) v[i] = __builtin_nontemporal_load((const f32x4*)(p + (size_t)(8 * i) * d.N));
}
__device__ __forceinline__ void tr_lds_write(const f32x4 (&v)[8], LAS float* scr, int lane) {
#pragma unroll
    for (int i = 0; i < 8; ++i) *(LAS f32x4*)(scr + (8 * i + (lane >> 3)) * 32 + ((4 * (lane & 7)) ^ (4 * i))) = v[i];
}
__device__ __forceinline__ void tr_finish(const TrDesc& d, LAS float* scr, int lane) {
    const int nblk = d.N / 32, kb = d.item / nblk, nb = d.item % nblk, k0 = 64 * kb, n0 = 32 * nb;
    if (d.shp) {
        const float h0 = d.shp[k0 + lane], h1 = d.shp[2 * NMODC + k0 + lane], h2 = d.shp[4 * NMODC + k0 + lane];
        float s0 = 0.f, s1 = 0.f, s2 = 0.f; const int n = lane & 31;
#pragma unroll 4
        for (int k = 0; k < 64; ++k) { const float w = scr[k * 32 + (n ^ (4 * ((k >> 3) & 7)))];
            s0 += w * __builtin_bit_cast(float, __builtin_amdgcn_readlane(__builtin_bit_cast(int, h0), k));
            s1 += w * __builtin_bit_cast(float, __builtin_amdgcn_readlane(__builtin_bit_cast(int, h1), k));
            s2 += w * __builtin_bit_cast(float, __builtin_amdgcn_readlane(__builtin_bit_cast(int, h2), k)); }
        if (lane < 32) { atomicAdd(d.sWp + n0 + n, s0); atomicAdd(d.sWp + DFF + n0 + n, s1); atomicAdd(d.sWp + 2 * DFF + n0 + n, s2); }
    }
    const int c = lane & 7;
#pragma unroll
    for (int j = 0; j < 4; ++j) { const int n = (lane >> 3) + 8 * j; const LAS float* s = scr + (8 * c) * 32 + (n ^ (4 * c));
        u32x4 o; o.x = cvtpk(s[0 * 32], s[1 * 32]); o.y = cvtpk(s[2 * 32], s[3 * 32]); o.z = cvtpk(s[4 * 32], s[5 * 32]); o.w = cvtpk(s[6 * 32], s[7 * 32]);
        *(u32x4*)(d.WT + (size_t)(d.row_off + n0 + n) * d.K + k0 + 8 * c) = o; }
}
__device__ __forceinline__ void p0_ada_item(const Args& a, LAS unsigned char* lds, int wi, int tid) {
    LAS float* sc = (LAS float*)lds;
    LAS float* part = (LAS float*)(lds + 1024);
    const int l = wi >> 8, cc = (wi & 255) >> 5, ks = wi & 31, k0 = 64 * ks, c0 = 1536 * cc;
    if (tid < 192) { const int v = tid >> 6, k = k0 + (tid & 63); const float x = v == 0 ? a.in[7][k] : a.in[6][(v - 1) * 2048 + k]; sc[tid] = siluf(x); }
    __syncthreads();
    if (tid < 384) {
        f32x4 a0 = {0.f, 0.f, 0.f, 0.f}, a1 = a0, a2 = a0;
        const float* wp = a.in[8] + ((size_t)l * 2048 + k0) * NMODC + c0 + 4 * tid;
        f32x4 wA[8], wB[8], wC[8];
#define ADA_LD(dst, b) do { _Pragma("unroll") for (int r_ = 0; r_ < 8; ++r_) dst[r_] = __builtin_nontemporal_load((const f32x4*)(wp + (size_t)((b) * 8 + r_) * NMODC)); } while (0)
#define ADA_FMA(srcv, b) do { _Pragma("unroll") for (int r_ = 0; r_ < 8; ++r_) { const int r = (b) * 8 + r_; a0 += srcv[r_] * sc[r]; a1 += srcv[r_] * sc[64 + r]; a2 += srcv[r_] * sc[128 + r]; } } while (0)
        ADA_LD(wA, 0); ADA_LD(wB, 1); ADA_LD(wC, 2); asm volatile("" ::: "memory");
        ADA_FMA(wA, 0); ADA_LD(wA, 3); asm volatile("" ::: "memory");
        ADA_FMA(wB, 1); ADA_LD(wB, 4); asm volatile("" ::: "memory");
        ADA_FMA(wC, 2); ADA_LD(wC, 5); asm volatile("" ::: "memory");
        ADA_FMA(wA, 3); ADA_LD(wA, 6); asm volatile("" ::: "memory");
        ADA_FMA(wB, 4); ADA_LD(wB, 7); asm volatile("" ::: "memory");
        ADA_FMA(wC, 5); ADA_FMA(wA, 6); ADA_FMA(wB, 7);
#undef ADA_LD
#undef ADA_FMA
        if (ks == 0) { const f32x4 b = *(const f32x4*)(a.in[9] + l * NMODC + c0 + 4 * tid); a0 += b; a1 += b; a2 += b; }
        *(LAS f32x4*)(part + 4 * tid) = a0; *(LAS f32x4*)(part + 1536 + 4 * tid) = a1; *(LAS f32x4*)(part + 3072 + 4 * tid) = a2;
    }
    __syncthreads();
    float* mod = (float*)(a.ws + WS_MOD);
#pragma unroll
    for (int i = 0; i < 9; ++i) { const int e = tid + 512 * i, v = e / 1536, c = e - v * 1536;
        atomicAdd(mod + (size_t)v * 2 * NMODC + l * NMODC + c0 + c, part[e]); }
    __syncthreads();
}
constexpr int I_IN = 32 * 208, I_OUT = 32 * 64, I_POOL = 8 * 16, I_M1 = 32 * 256, I_M2 = 128 * 64;
constexpr int R_IN = 0, R_OUT = R_IN + I_IN, R_M1_0 = R_OUT + I_OUT, R_M2_0 = R_M1_0 + I_M1, R_POOL = R_M2_0 + I_M2, R_M1_1 = R_POOL + 4 * I_POOL, R_M2_1 = R_M1_1 + I_M1, R_END = R_M2_1 + I_M2;
__device__ __forceinline__ TrDesc tr_desc(const Args& a, int it) {
    unsigned char* ws = a.ws;
    const float* MOD = (const float*)(ws + WS_MOD); float* SW = (float*)(ws + WS_SW);
    TrDesc d; d.shp = nullptr; d.sWp = nullptr; d.row_off = 0;
    if (it < R_OUT) { d.W = a.in[12]; d.K = 2048; d.N = IN_AB; d.WT = (bf16_t*)(ws + WS_WIN); d.item = it - R_IN; }
    else if (it < R_M1_0) { d.W = a.in[13]; d.K = 2048; d.N = 2048; d.WT = (bf16_t*)(ws + WS_WOUT); d.item = it - R_OUT; }
    else if (it < R_M2_0) { d.W = a.in[20]; d.K = 2048; d.N = DFF; d.WT = (bf16_t*)(ws + WS_WM1); d.item = it - R_M1_0; d.shp = MOD + 3 * 2048; d.sWp = SW; }
    else if (it < R_POOL) { d.W = a.in[21]; d.K = DFF; d.N = 2048; d.WT = (bf16_t*)(ws + WS_WM2); d.item = it - R_M2_0; }
    else if (it < R_M1_1) { const int r = it - R_POOL, g = r / I_POOL; d.W = a.in[18] + (size_t)g * 512 * 512; d.K = 512; d.N = 512; d.WT = (bf16_t*)(ws + WS_WPOOL); d.row_off = g * 512; d.item = r % I_POOL; }
    else if (it < R_M2_1) { d.W = a.in[20] + (size_t)2048 * DFF; d.K = 2048; d.N = DFF; d.WT = (bf16_t*)(ws + WS_WM1) + (size_t)DFF * 2048; d.item = it - R_M1_1; d.shp = MOD + NMODC + 3 * 2048; d.sWp = SW + 3 * DFF; }
    else { d.W = a.in[21] + (size_t)DFF * 2048; d.K = DFF; d.N = 2048; d.WT = (bf16_t*)(ws + WS_WM2) + (size_t)2048 * DFF; d.item = it - R_M2_1; }
    return d;
}
__device__ __forceinline__ void bg_transposes(const Args& a, LAS unsigned char* lds, int lo, int hi, int w, int nw, int wave, int lane) {
    LAS float* scr = (LAS float*)(lds + wave * 16384);
    int it = lo + w; if (it >= hi) return;
    f32x4 v[8];
    TrDesc d = tr_desc(a, it); tr_load(d, v, lane);
    for (;;) {
        tr_lds_write(v, scr, lane);
        const int itn = it + nw; const bool more = itn < hi;
        TrDesc dn = d;
        if (more) { dn = tr_desc(a, itn); tr_load(dn, v, lane); }
        LDS_WAIT(); asm volatile("" ::: "memory");
        tr_finish(d, scr, lane);
        LDS_WAIT(); asm volatile("" ::: "memory");
        if (!more) break;
        d = dn; it = itn;
    }
}

__device__ __forceinline__ void norm_rows_bf16(const Args& a, const float* xa  , const float* gain, int layer, int soff, bf16_t* H, int gw, int ngw, int lane) {
    const float* mod = (const float*)(a.ws + WS_MOD);
    for (int row0 = gw; row0 < NTOK; row0 += 2 * ngw) {
        const int row1 = row0 + ngw; const bool has1 = row1 < NTOK; const int r1 = has1 ? row1 : row0;
        const float* x0 = xa ? xa + (size_t)row0 * DM : xin_row(a, row0);
        const float* x1 = xa ? xa + (size_t)r1 * DM : xin_row(a, r1);
        f32x4 v0[8], v1[8]; float ss0 = 0.f, ss1 = 0.f;
#pragma unroll
        for (int j = 0; j < 8; ++j) { v0[j] = *(const f32x4*)(x0 + 4 * (lane + 64 * j)); v1[j] = *(const f32x4*)(x1 + 4 * (lane + 64 * j)); }
#pragma unroll
        for (int j = 0; j < 8; ++j) { ss0 += v0[j].x * v0[j].x + v0[j].y * v0[j].y + v0[j].z * v0[j].z + v0[j].w * v0[j].w; ss1 += v1[j].x * v1[j].x + v1[j].y * v1[j].y + v1[j].z * v1[j].z + v1[j].w * v1[j].w; }
        const float rstd0 = rsqrtf(wave_sum(ss0) * (1.f / DM) + EPS), rstd1 = rsqrtf(wave_sum(ss1) * (1.f / DM) + EPS);
        const float* mp0 = mod + (size_t)cvec_of_row(row0) * 2 * NMODC + layer * NMODC + soff;
        const float* mp1 = mod + (size_t)cvec_of_row(r1) * 2 * NMODC + layer * NMODC + soff;
#pragma unroll
        for (int j = 0; j < 8; ++j) { const int c = 4 * (lane + 64 * j);
            const f32x4 g = *(const f32x4*)(gain + c);
            { const f32x4 sh = *(const f32x4*)(mp0 + c), sc = *(const f32x4*)(mp0 + 2048 + c); const f32x4 y = v0[j] * rstd0 * g * (sc + 1.f) + sh;
              u32x2 w; w.x = cvtpk(y.x, y.y); w.y = cvtpk(y.z, y.w); *(u32x2*)(H + (size_t)row0 * DM + c) = w; }
            if (has1) { const f32x4 sh = *(const f32x4*)(mp1 + c), sc = *(const f32x4*)(mp1 + 2048 + c); const f32x4 y = v1[j] * rstd1 * g * (sc + 1.f) + sh;
              u32x2 w; w.x = cvtpk(y.x, y.y); w.y = cvtpk(y.z, y.w); *(u32x2*)(H + (size_t)row1 * DM + c) = w; } }
    }
}
__device__ __forceinline__ void norm_rows_f32(const Args& a, const float* xa, const float* gain, int layer, int soff  , float* O, int gw, int ngw, int lane) {
    const float* mod = (const float*)(a.ws + WS_MOD);
    for (int row = gw; row < NTOK; row += ngw) {
        const float* xr = xa + (size_t)row * DM;
        const float* mp = mod + (size_t)cvec_of_row(row) * 2 * NMODC + layer * NMODC + (soff < 0 ? 0 : soff);
        f32x4 v[8]; float ss = 0.f;
#pragma unroll
        for (int j = 0; j < 8; ++j) { v[j] = *(const f32x4*)(xr + 4 * (lane + 64 * j)); ss += v[j].x * v[j].x + v[j].y * v[j].y + v[j].z * v[j].z + v[j].w * v[j].w; }
        const float rstd = rsqrtf(wave_sum(ss) * (1.f / DM) + EPS);
#pragma unroll
        for (int j = 0; j < 8; ++j) { const int c = 4 * (lane + 64 * j);
            const f32x4 g = *(const f32x4*)(gain + c);
            f32x4 y = v[j] * rstd * g;
            if (soff >= 0) { const f32x4 sh = *(const f32x4*)(mp + c), sc = *(const f32x4*)(mp + 2048 + c); y = y * (sc + 1.f) + sh; }
            *(f32x4*)(O + (size_t)row * DM + c) = y; }
    }
}
template <int HW> __device__ __forceinline__ void pool_out(const LAS float* T, bf16_t* P, int row0, int t0, int Tseq, int cb, int tid) {
    const int cq = tid & 63, tgp = tid >> 6;
#pragma unroll
    for (int j = 0; j < 8; ++j) { const int tl = tgp * 8 + j, t = t0 + tl;
        f32x4 s = {0.f, 0.f, 0.f, 0.f};
#pragma unroll
        for (int d = -HW; d < HW; ++d) { const int u = t + d; const f32x4 v = *(const LAS f32x4*)(T + (tl + 8 + d) * 256 + cq * 4); if (u >= 0 && u < Tseq) s += v; }
        const int lo = max(t - HW, 0), hi = min(t + HW, Tseq);
        const f32x4 x = *(const LAS f32x4*)(T + (tl + 8) * 256 + cq * 4);
        const f32x4 y = s * (1.f / (float)(hi - lo)) - x;
        u32x2 w; w.x = cvtpk(y.x, y.y); w.y = cvtpk(y.z, y.w);
        *(u32x2*)(P + (size_t)(row0 + tl) * DM + cb * 256 + cq * 4) = w; }
}
struct PoolItem { int row0, cb, s0, Tseq, t0; };
__device__ __forceinline__ PoolItem pool_item(int item) {
    PoolItem p; const int tt = item >> 3; p.cb = item & 7; p.row0 = tt * 64;
    if (p.row0 < NTOK_P) { p.s0 = p.row0 & ~255; p.Tseq = SEQ_P; } else { p.s0 = NTOK_P + ((p.row0 - NTOK_P) & ~1023); p.Tseq = SEQ_S; }
    p.t0 = p.row0 - p.s0; return p;
}
__device__ __forceinline__ void pool_load(const PoolItem& p, const float* XA, const float* rowss, f32x4 (&xr)[10], float (&rs)[10], int wave, int lane) {
    const int c = p.cb * 256 + lane * 4;
#pragma unroll
    for (int i = 0; i < 10; ++i) { const int t = p.t0 - 8 + wave + 8 * i; const bool ok = t >= 0 && t < p.Tseq; const int row = p.s0 + (ok ? t : p.t0);
        xr[i] = *(const f32x4*)(XA + (size_t)row * DM + c); rs[i] = rowss[row]; }
}
__device__ __forceinline__ void pool_phase(const Args& a, LAS unsigned char* lds, const float* XA, const float* rowss, bf16_t* P, int bx, int G, int tid) {
    LAS float* T = (LAS float*)lds;
    const float* MOD = (const float*)(a.ws + WS_MOD);
    const int lane = tid & 63, wave = tid >> 6;
    int item = bx; if (item >= 768) return;
    f32x4 xr[10]; float rs[10];
    PoolItem p = pool_item(item); pool_load(p, XA, rowss, xr, rs, wave, lane);
    for (;;) {
        const int c = p.cb * 256 + lane * 4, g = p.cb >> 1;
        const float* mp = MOD + (size_t)cvec_of_row(p.row0) * 2 * NMODC + NMODC;
        const f32x4 gmul = *(const f32x4*)(a.in[10] + 2048 + c) * (*(const f32x4*)(mp + 2048 + c) + 1.f), sh = *(const f32x4*)(mp + c);
#pragma unroll
        for (int i = 0; i < 10; ++i) { const int rr = wave + 8 * i; const float rstd = rsqrtf(rs[i] * (1.f / DM) + EPS);
            *(LAS f32x4*)(T + rr * 256 + lane * 4) = xr[i] * rstd * gmul + sh; }
        const int nitem = item + G; const bool more = nitem < 768;
        PoolItem pn = p;
        if (more) { pn = pool_item(nitem); pool_load(pn, XA, rowss, xr, rs, wave, lane); }
        __syncthreads();
        switch (g) { case 0: pool_out<1>(T, P, p.row0, p.t0, p.Tseq, p.cb, tid); break; case 1: pool_out<2>(T, P, p.row0, p.t0, p.Tseq, p.cb, tid); break;
                     case 2: pool_out<4>(T, P, p.row0, p.t0, p.Tseq, p.cb, tid); break; default: pool_out<8>(T, P, p.row0, p.t0, p.Tseq, p.cb, tid); break; }
        __syncthreads();
        if (!more) break;
        p = pn; item = nitem;
    }
}
__device__ __forceinline__ void final_rows(const float* XA, const float* rowss, const float* gain, float* O, int gw, int ngw, int lane) {
    for (int row = gw; row < NTOK; row += ngw) { const float rstd = rsqrtf(rowss[row] * (1.f / DM) + EPS);
#pragma unroll
        for (int j = 0; j < 8; ++j) { const int c = 4 * (lane + 64 * j);
            __builtin_nontemporal_store(__builtin_nontemporal_load((const f32x4*)(XA + (size_t)row * DM + c)) * rstd * *(const f32x4*)(gain + c), (f32x4*)(O + (size_t)row * DM + c)); } }
}

__device__ __forceinline__ void post_token(const Args& a, int row, int lane) {
    const bf16_t* ZB = (const bf16_t*)(a.ws + WS_ZB);
    bf16_t* QN = (bf16_t*)(a.ws + WS_QN);
    const bool samp = row >= NTOK_P;
    const int bb = samp ? (row - NTOK_P) >> 10 : row >> 8, t = samp ? (row - NTOK_P) & 1023 : row & 255;
    const int e0 = (lane & 31) * 4, hsel = lane >> 5;
    const int sect = e0 >> 5;
    float cs[4], sn[4];
    if (samp) {
        const float pos = (float)((sect < 2) ? (t >> 6) : (t & 63));
#pragma unroll
        for (int i = 0; i < 4; ++i) { const int j = (e0 + i) & 31; const float inv = exp2f(-(float)j * 0.41524101186092033f); const float ang = pos * inv; cs[i] = __cosf(ang); sn[i] = __sinf(ang); }
    }
    u32x2 raw6[6];
#pragma unroll
    for (int p = 0; p < 6; ++p) raw6[p] = *(const u32x2*)(ZB + (size_t)row * IN_AB + p * 256 + lane * 4);
#pragma unroll
    for (int p = 0; p < 6; ++p) {
        const int col = p * 256 + lane * 4;
        const u32x2 raw = raw6[p];
        float y[4] = {bflo(raw.x), bfhi(raw.x), bflo(raw.y), bfhi(raw.y)};
        if (p < 5) {
            const float ss = half_sum(y[0] * y[0] + y[1] * y[1] + y[2] * y[2] + y[3] * y[3]);
            const float rstd = rsqrtf(ss * (1.f / 128.f) + EPS);
            const f32x4 g = *(const f32x4*)((p < 4 ? a.in[14] : a.in[15]) + e0);
            y[0] *= rstd * g.x; y[1] *= rstd * g.y; y[2] *= rstd * g.z; y[3] *= rstd * g.w;
        }
        if (!samp && p >= 4) {
            float* o = a.out + (p == 4 ? 12582912 : 13631488) + (size_t)row * 256 + lane * 4;
            *(f32x4*)o = (f32x4){y[0], y[1], y[2], y[3]};
        }
        if (samp && p < 5) {
#pragma unroll
            for (int i = 0; i < 4; ++i) { const float py = __shfl_xor(y[i], 8); const float rot = (sect & 1) ? py : -py; y[i] = y[i] * cs[i] + rot * sn[i]; }
        }
        u32x2 w; w.x = cvtpk(y[0], y[1]); w.y = cvtpk(y[2], y[3]);
        if (p < 4) *(u32x2*)(QN + (size_t)row * 1024 + col) = w;
        else {
            bf16_t* dst;
            if (samp) dst = (bf16_t*)(a.ws + (p == 4 ? WS_KS : WS_VS)) + ((size_t)(bb * 2 + hsel) * 1280 + t) * 128 + e0;
            else      dst = (bf16_t*)(a.ws + (p == 4 ? WS_KP : WS_VP)) + ((size_t)(bb * 2 + hsel) * 256 + t) * 128 + e0;
            *(u32x2*)dst = w;
        }
    }
}
__device__ __forceinline__ void cache_item(const Args& a, int item, int lane) {
    const int which = item >> 9, b = (item >> 8) & 1, t = item & 255, hsel = lane >> 5, e0 = (lane & 31) * 4;
    const f32x4 v = *(const f32x4*)(a.in[2 + which] + ((size_t)(b * 256 + t) * 2 + hsel) * 128 + e0);
    bf16_t* dst = (bf16_t*)(a.ws + (which == 0 ? WS_KS : WS_VS)) + ((size_t)(b * 2 + hsel) * 1280 + 1024 + t) * 128 + e0;
    u32x2 w; w.x = cvtpk(v.x, v.y); w.y = cvtpk(v.z, v.w);
    *(u32x2*)dst = w;
}
__device__ __forceinline__ void combine_token(const Args& a, int row, int lane) {
    const float* OF = (const float*)(a.ws + WS_OF); const float* OB = (const float*)(a.ws + WS_OB);
    const bf16_t* ZB = (const bf16_t*)(a.ws + WS_ZB); bf16_t* A2 = (bf16_t*)(a.ws + WS_A2);
    const int e0 = (lane & 31) * 4;
    const f32x4 g = *(const f32x4*)(a.in[16] + e0);
#pragma unroll
    for (int p = 0; p < 4; ++p) {
        const int col = p * 256 + lane * 4;
        const f32x4 o = *(const f32x4*)(OF + (size_t)row * 1024 + col) + *(const f32x4*)(OB + (size_t)row * 1024 + col);
        const float ss = half_sum(o.x * o.x + o.y * o.y + o.z * o.z + o.w * o.w);
        const float rstd = rsqrtf(ss * (1.f / 128.f) + EPS);
        const u32x2 raw = *(const u32x2*)(ZB + (size_t)row * IN_AB + C_HG + col);
        const f32x4 y = o * rstd * g * (f32x4){bflo(raw.x), bfhi(raw.x), bflo(raw.y), bfhi(raw.y)};
        u32x2 w; w.x = cvtpk(y.x, y.y); w.y = cvtpk(y.z, y.w);
        *(u32x2*)(A2 + (size_t)row * DM + 1024 + col) = w;
    }
}

constexpr int HG_ROW = 136, HG_TROW = 40;
constexpr int HG_QI = 0, HG_KI = 32 * HG_ROW * 2, HG_QS = 2 * 32 * HG_ROW * 2, HG_KST = 3 * 32 * HG_ROW * 2, HG_IT = HG_KST + 128 * HG_TROW * 2, HG_A = HG_IT + 128 * HG_TROW * 2, HG_GT = HG_A + 512, HG_SEQ_BYTES = HG_GT + 4096;
static_assert(HG_SEQ_BYTES % 16 == 0 && 2 * HG_SEQ_BYTES <= RING_BYTES, "hgrn lds");
__device__ __forceinline__ int crow(int r, int hi) { return (r & 3) + 8 * (r >> 2) + 4 * hi; }
__device__ __forceinline__ int kpos(int k) { const int kp = k & 15; return (k & 16) + (((kp >> 2) & 1) << 3) + ((kp >> 3) << 2) + (kp & 3); }
#define MFMA32(a, b, c) __builtin_amdgcn_mfma_f32_32x32x16_bf16((a), (b), (c), 0, 0, 0)
__device__ __forceinline__ bf16x8 pack8(const f32x16& x, int s) {
    u32x4 p; p.x = cvtpk(x[8 * s], x[8 * s + 1]); p.y = cvtpk(x[8 * s + 2], x[8 * s + 3]); p.z = cvtpk(x[8 * s + 4], x[8 * s + 5]); p.w = cvtpk(x[8 * s + 6], x[8 * s + 7]);
    return __builtin_bit_cast(bf16x8, p);
}
struct HgRegs { f32x4 lf[4]; u32x2 qv[4], iv[4]; };
__device__ __forceinline__ void hg_load(HgRegs& R, const float* LF, const bf16_t* ZB, int rowbase, int dir, int hh, int cg, int tg, int ch) {
#pragma unroll
    for (int jj = 0; jj < 4; ++jj) { const int j = 4 * tg + jj;
        const int row = rowbase + (dir == 0 ? 32 * ch + j : 32 * (7 - ch) + 31 - j);
        R.lf[jj] = *(const f32x4*)(LF + (size_t)row * 2048 + dir * 1024 + hh * 128 + 4 * cg);
        R.qv[jj] = *(const u32x2*)(ZB + (size_t)row * IN_AB + C_HQ + hh * 128 + 4 * cg);
        R.iv[jj] = *(const u32x2*)(ZB + (size_t)row * IN_AB + C_HI + hh * 128 + 4 * cg); }
}
__device__ __forceinline__ void hg_chunk(const HgRegs& R, f32x16 (&S)[4], f32x4& ltot, LAS unsigned char* L, float* OUT, int rowbase, int dir, int hh, int ch,
                                         int cg, int tg, int r32, int hi, int e0) {
    f32x4 cb[4]; cb[0] = R.lf[0]; cb[1] = cb[0] + R.lf[1]; cb[2] = cb[1] + R.lf[2]; cb[3] = cb[2] + R.lf[3];
    *(LAS f32x4*)(L + HG_GT + (tg * 128 + 4 * cg) * 4) = cb[3];
    __syncthreads();
    f32x4 off = {0.f, 0.f, 0.f, 0.f}, bm = off, bl = off;
#pragma unroll
    for (int g = 0; g < 8; ++g) { const f32x4 t4 = *(const LAS f32x4*)(L + HG_GT + (g * 128 + 4 * cg) * 4); if (g < tg) off += t4; if (g < 4) bm += t4; bl += t4; }
    ltot += bl;
    f32x4 em, elm;
#pragma unroll
    for (int c = 0; c < 4; ++c) { em[c] = __expf(bm[c]); elm[c] = __expf(bl[c] - bm[c]); }
    if (tg == 0) { f32x4 av;
#pragma unroll
        for (int c = 0; c < 4; ++c) av[c] = __expf(bl[c]);
        *(LAS f32x4*)(L + HG_A + 16 * cg) = av; }
    float kS_[4][4], iv_[4][4];
#pragma unroll
    for (int jj = 0; jj < 4; ++jj) {
        const int j = 4 * tg + jj;
        const float q4[4] = {bflo(R.qv[jj].x), bfhi(R.qv[jj].x), bflo(R.qv[jj].y), bfhi(R.qv[jj].y)};
        iv_[jj][0] = bflo(R.iv[jj].x); iv_[jj][1] = bfhi(R.iv[jj].x); iv_[jj][2] = bflo(R.iv[jj].y); iv_[jj][3] = bfhi(R.iv[jj].y);
        float qI[4], qS[4], kI[4];
#pragma unroll
        for (int c = 0; c < 4; ++c) {
            const float b = off[c] + cb[jj][c];
            const float E1 = __expf(fminf(fmaxf(b - bm[c], -80.f), 80.f)), R1 = __builtin_amdgcn_rcpf(E1);
            const float kk = 1.f - __expf(R.lf[jj][c]);
            qI[c] = q4[c] * E1; qS[c] = qI[c] * em[c];
            kI[c] = kk * R1; kS_[jj][c] = kI[c] * elm[c];
        }
        u32x2 w; w.x = cvtpk(qI[0], qI[1]); w.y = cvtpk(qI[2], qI[3]);
        *(LAS u32x2*)(L + HG_QI + (j * HG_ROW + 4 * cg) * 2) = w;
        w.x = cvtpk(kI[0], kI[1]); w.y = cvtpk(kI[2], kI[3]);
        *(LAS u32x2*)(L + HG_KI + (j * HG_ROW + 4 * cg) * 2) = w;
        w.x = cvtpk(qS[0], qS[1]); w.y = cvtpk(qS[2], qS[3]);
        *(LAS u32x2*)(L + HG_QS + (j * HG_ROW + (4 * cg & ~31) + kpos(4 * cg & 31)) * 2) = w;
    }
    {
        const int p0 = kpos(4 * tg);
#pragma unroll
        for (int c = 0; c < 4; ++c) { u32x2 w; w.x = cvtpk(kS_[0][c], kS_[1][c]); w.y = cvtpk(kS_[2][c], kS_[3][c]);
            *(LAS u32x2*)(L + HG_KST + ((4 * cg + c) * HG_TROW + p0) * 2) = w;
            w.x = cvtpk(iv_[0][c], iv_[1][c]); w.y = cvtpk(iv_[2][c], iv_[3][c]);
            *(LAS u32x2*)(L + HG_IT + ((4 * cg + c) * HG_TROW + p0) * 2) = w; }
    }
    __syncthreads();
    f32x16 x;
#pragma unroll
    for (int i = 0; i < 16; ++i) x[i] = 0.f;
#pragma unroll
    for (int ks = 0; ks < 8; ++ks) {
        const bf16x8 fa = *(const LAS bf16x8*)(L + HG_KI + (r32 * HG_ROW + 16 * ks + 8 * hi) * 2);
        const bf16x8 fb = *(const LAS bf16x8*)(L + HG_QI + (r32 * HG_ROW + 16 * ks + 8 * hi) * 2);
        x = MFMA32(fa, fb, x);
    }
#pragma unroll
    for (int i = 0; i < 16; ++i) x[i] = (crow(i, hi) <= r32) ? x[i] : 0.f;
    f32x16 y;
#pragma unroll
    for (int i = 0; i < 16; ++i) y[i] = 0.f;
    bf16x8 fi[2];
#pragma unroll
    for (int ks = 0; ks < 2; ++ks) {
        fi[ks] = *(const LAS bf16x8*)(L + HG_IT + ((e0 + r32) * HG_TROW + 16 * ks + 8 * hi) * 2);
        y = MFMA32(fi[ks], pack8(x, ks), y);
    }
#pragma unroll
    for (int db = 0; db < 4; ++db)
#pragma unroll
        for (int ks = 0; ks < 2; ++ks) {
            const bf16x8 fq_ = *(const LAS bf16x8*)(L + HG_QS + (r32 * HG_ROW + 32 * db + 16 * ks + 8 * hi) * 2);
            y = MFMA32(pack8(S[db], ks), fq_, y);
        }
    {
        const int row = rowbase + (dir == 0 ? 32 * ch + r32 : 32 * (7 - ch) + 31 - r32);
        float* op = OUT + (size_t)row * 1024 + hh * 128 + e0 + 4 * hi;
#pragma unroll
        for (int g4 = 0; g4 < 4; ++g4) *(f32x4*)(op + 8 * g4) = (f32x4){y[4 * g4], y[4 * g4 + 1], y[4 * g4 + 2], y[4 * g4 + 3]};
    }
#pragma unroll
    for (int db = 0; db < 4; ++db) {
#pragma unroll
        for (int g4 = 0; g4 < 4; ++g4) { const f32x4 a4 = *(const LAS f32x4*)(L + HG_A + (32 * db + 8 * g4 + 4 * hi) * 4);
#pragma unroll
            for (int c = 0; c < 4; ++c) S[db][4 * g4 + c] *= a4[c]; }
#pragma unroll
        for (int ks = 0; ks < 2; ++ks) {
            const bf16x8 fk = *(const LAS bf16x8*)(L + HG_KST + ((32 * db + r32) * HG_TROW + 16 * ks + 8 * hi) * 2);
            S[db] = MFMA32(fk, fi[ks], S[db]);
        }
    }
}
__device__ __forceinline__ void hgrn_prefetch(const Args& a, int task, int tid, HgRegs& RA, HgRegs& RB) {
    const bool samp = task < 64;
    const int bb = samp ? task >> 5 : (task - 64) >> 3, hh = samp ? (task >> 2) & 7 : task & 7, seg = task & 3;
    const int rowbase = samp ? NTOK_P + bb * SEQ_S + seg * 256 : bb * SEQ_P;
    const int dir = tid >> 8, tl = tid & 255, cg = tl & 31, tg = tl >> 5;
    const bf16_t* ZB = (const bf16_t*)(a.ws + WS_ZB); const float* LF = (const float*)(a.ws + WS_LF);
    hg_load(RA, LF, ZB, rowbase, dir, hh, cg, tg, 0);
    hg_load(RB, LF, ZB, rowbase, dir, hh, cg, tg, 1);
}
__device__ __forceinline__ void hgrn_task(const Args& a, LAS unsigned char* lds0, int task, int tid, HgRegs& RA, HgRegs& RB) {
    const bool samp = task < 64;
    const int bb = samp ? task >> 5 : (task - 64) >> 3, hh = samp ? (task >> 2) & 7 : task & 7, seg = task & 3;
    const int rowbase = samp ? NTOK_P + bb * SEQ_S + seg * 256 : bb * SEQ_P;
    const int dir = tid >> 8, tl = tid & 255, lane = tid & 63, wq = (tid >> 6) & 3, r32 = lane & 31, hi = lane >> 5;
    LAS unsigned char* L = lds0 + dir * HG_SEQ_BYTES;
    const bf16_t* ZB = (const bf16_t*)(a.ws + WS_ZB); const float* LF = (const float*)(a.ws + WS_LF);
    float* OUT = (float*)(a.ws + (dir == 0 ? WS_OF : WS_OB));
    const int cg = tl & 31, tg = tl >> 5, e0 = 32 * wq;
    f32x16 S[4];
    const bool has_init = samp && (dir == 0 ? seg == 0 : seg == 3);
    if (has_init) { const float* s0 = a.in[4 + dir] + (size_t)(bb * 8 + hh) * 16384;
#pragma unroll
        for (int db = 0; db < 4; ++db)
#pragma unroll
            for (int i = 0; i < 16; ++i) S[db][i] = s0[(size_t)(32 * db + crow(i, hi)) * 128 + e0 + r32];
    } else {
#pragma unroll
        for (int db = 0; db < 4; ++db)
#pragma unroll
            for (int i = 0; i < 16; ++i) S[db][i] = 0.f;
    }
    f32x4 ltot = {0.f, 0.f, 0.f, 0.f};
#pragma unroll
    for (int ch = 0; ch < 8; ch += 2) {
        hg_chunk(RA, S, ltot, L, OUT, rowbase, dir, hh, ch, cg, tg, r32, hi, e0);
        if (ch + 2 < 8) hg_load(RA, LF, ZB, rowbase, dir, hh, cg, tg, ch + 2);
        hg_chunk(RB, S, ltot, L, OUT, rowbase, dir, hh, ch + 1, cg, tg, r32, hi, e0);
        if (ch + 3 < 8) hg_load(RB, LF, ZB, rowbase, dir, hh, cg, tg, ch + 3);
    }
    if (!samp) { float* so = a.out + (dir == 0 ? 14680064 : 16777216) + (size_t)(bb * 8 + hh) * 16384;
#pragma unroll
        for (int db = 0; db < 4; ++db)
#pragma unroll
            for (int i = 0; i < 16; ++i) so[(size_t)(32 * db + crow(i, hi)) * 128 + e0 + r32] = S[db][i];
    } else {
        const size_t sidx = (size_t)(((bb * 8 + hh) * 2 + dir) * 4 + seg);
        float* so = (float*)(a.ws + WS_SEND) + sidx * 16384;
#pragma unroll
        for (int db = 0; db < 4; ++db)
#pragma unroll
            for (int i = 0; i < 16; ++i) so[(size_t)(32 * db + crow(i, hi)) * 128 + e0 + r32] = S[db][i];
        if (tg == 0) *(f32x4*)((float*)(a.ws + WS_LSEG) + sidx * 128 + 4 * cg) = ltot;
    }
    __syncthreads();
}
constexpr int FX_QS = 0, FX_GT = 32 * HG_ROW * 2, FX_DIR_BYTES = FX_GT + 4096, FX_Z = 2 * FX_DIR_BYTES, FX_ZROW = 132, FX_RED = FX_Z + 32 * FX_ZROW * 4, FX_BYTES = FX_RED + 512;
__device__ __forceinline__ void hgfix_task(const Args& a, LAS unsigned char* lds0, int task, int tid) {
    const int bb = task >> 5, hh = (task >> 2) & 7, seg = task & 3;
    const int rowbase = NTOK_P + bb * SEQ_S + seg * 256;
    const int dir = tid >> 8, tl = tid & 255, lane = tid & 63, wq = (tid >> 6) & 3, r32 = lane & 31, hi = lane >> 5;
    LAS unsigned char* L = lds0 + dir * FX_DIR_BYTES;
    const bf16_t* ZB = (const bf16_t*)(a.ws + WS_ZB); const float* LF = (const float*)(a.ws + WS_LF);
    const float* OIN = (const float*)(a.ws + (dir == 0 ? WS_OF : WS_OB));
    bf16_t* A2 = (bf16_t*)(a.ws + WS_A2);
    const int cg = tl & 31, tg = tl >> 5, e0 = 32 * wq;
    const size_t sbase = (size_t)((bb * 8 + hh) * 2 + dir) * 4;
    const float* SEND = (const float*)(a.ws + WS_SEND); const float* LSEG = (const float*)(a.ws + WS_LSEG);
    f32x16 S[4];
#pragma unroll
    for (int db = 0; db < 4; ++db)
#pragma unroll
        for (int i = 0; i < 16; ++i) S[db][i] = 0.f;
    const int nfold = dir == 0 ? seg : 3 - seg;
    for (int f = 0; f < nfold; ++f) { const int j = dir == 0 ? f : 3 - f;
        const float* sp = SEND + (sbase + j) * 16384; const float* lp = LSEG + (sbase + j) * 128;
#pragma unroll
        for (int db = 0; db < 4; ++db)
#pragma unroll
            for (int g4 = 0; g4 < 4; ++g4) { const f32x4 l4 = *(const f32x4*)(lp + 32 * db + 8 * g4 + 4 * hi);
#pragma unroll
                for (int c = 0; c < 4; ++c) { const int i = 4 * g4 + c; S[db][i] = S[db][i] * __expf(l4[c]) + sp[(size_t)(32 * db + crow(i, hi)) * 128 + e0 + r32]; } }
    }
    bf16x8 sf[4][2];
#pragma unroll
    for (int db = 0; db < 4; ++db)
#pragma unroll
        for (int ks = 0; ks < 2; ++ks) sf[db][ks] = pack8(S[db], ks);
    f32x4 run = {0.f, 0.f, 0.f, 0.f}, ltot = {0.f, 0.f, 0.f, 0.f};
    if (dir == 1) ltot = *(const f32x4*)(LSEG + (sbase + seg) * 128 + 4 * cg);
    const f32x4 gn0 = *(const f32x4*)(a.in[16] + e0 + 4 * hi), gn1 = *(const f32x4*)(a.in[16] + e0 + 4 * hi + 8), gn2 = *(const f32x4*)(a.in[16] + e0 + 4 * hi + 16), gn3 = *(const f32x4*)(a.in[16] + e0 + 4 * hi + 24);
    f32x4 lfn[4]; u32x2 qvn[4];
#define FX_LOAD(chn) do { _Pragma("unroll") for (int jj = 0; jj < 4; ++jj) { const int row_ = rowbase + 32 * (chn) + 4 * tg + jj; \
        lfn[jj] = *(const f32x4*)(LF + (size_t)row_ * 2048 + dir * 1024 + hh * 128 + 4 * cg); \
        qvn[jj] = *(const u32x2*)(ZB + (size_t)row_ * IN_AB + C_HQ + hh * 128 + 4 * cg); } } while (0)
    FX_LOAD(0);
#pragma unroll 1
    for (int ch = 0; ch < 8; ++ch) {
        f32x4 lf[4]; u32x2 qv[4];
#pragma unroll
        for (int jj = 0; jj < 4; ++jj) { lf[jj] = lfn[jj]; qv[jj] = qvn[jj]; }
        const int row = rowbase + 32 * ch + r32;
        f32x4 zin[4]; u32x2 hgraw[4];
        { const float* ip = OIN + (size_t)row * 1024 + hh * 128 + e0 + 4 * hi; const bf16_t* hgp = ZB + (size_t)row * IN_AB + C_HG + hh * 128 + e0 + 4 * hi;
#pragma unroll
          for (int g4 = 0; g4 < 4; ++g4) { zin[g4] = *(const f32x4*)(ip + 8 * g4); hgraw[g4] = *(const u32x2*)(hgp + 8 * g4); } }
        if (ch + 1 < 8) FX_LOAD(ch + 1);
        f32x4 cb[4]; cb[0] = lf[0]; cb[1] = cb[0] + lf[1]; cb[2] = cb[1] + lf[2]; cb[3] = cb[2] + lf[3];
        *(LAS f32x4*)(L + FX_GT + (tg * 128 + 4 * cg) * 4) = cb[3];
        __syncthreads();
        f32x4 off = {0.f, 0.f, 0.f, 0.f}, bl = off;
#pragma unroll
        for (int g = 0; g < 8; ++g) { const f32x4 t4 = *(const LAS f32x4*)(L + FX_GT + (g * 128 + 4 * cg) * 4); if (g < tg) off += t4; bl += t4; }
#pragma unroll
        for (int jj = 0; jj < 4; ++jj) { const int j = 4 * tg + jj;
            const float q4[4] = {bflo(qv[jj].x), bfhi(qv[jj].x), bflo(qv[jj].y), bfhi(qv[jj].y)};
            float qB[4];
#pragma unroll
            for (int c = 0; c < 4; ++c) { const float incl = run[c] + off[c] + cb[jj][c];
                const float B = dir == 0 ? incl : ltot[c] - (incl - lf[jj][c]);
                qB[c] = q4[c] * __expf(B); }
            u32x2 w; w.x = cvtpk(qB[0], qB[1]); w.y = cvtpk(qB[2], qB[3]);
            *(LAS u32x2*)(L + FX_QS + (j * HG_ROW + (4 * cg & ~31) + kpos(4 * cg & 31)) * 2) = w; }
        run += bl;
        __syncthreads();
        f32x16 y;
#pragma unroll
        for (int i = 0; i < 16; ++i) y[i] = 0.f;
        if (nfold > 0) {
#pragma unroll
            for (int db = 0; db < 4; ++db)
#pragma unroll
                for (int ks = 0; ks < 2; ++ks) { const bf16x8 fq_ = *(const LAS bf16x8*)(L + FX_QS + (r32 * HG_ROW + 32 * db + 16 * ks + 8 * hi) * 2); y = MFMA32(sf[db][ks], fq_, y); }
        }
        f32x4 z[4];
#pragma unroll
        for (int g4 = 0; g4 < 4; ++g4) z[g4] = zin[g4] + (f32x4){y[4 * g4], y[4 * g4 + 1], y[4 * g4 + 2], y[4 * g4 + 3]};
        LAS float* Z = (LAS float*)(lds0 + FX_Z);
        if (dir == 1) {
#pragma unroll
            for (int g4 = 0; g4 < 4; ++g4) *(LAS f32x4*)(Z + r32 * FX_ZROW + e0 + 4 * hi + 8 * g4) = z[g4]; }
        __syncthreads();
        float ssq = 0.f;
        if (dir == 0) {
#pragma unroll
            for (int g4 = 0; g4 < 4; ++g4) { z[g4] += *(const LAS f32x4*)(Z + r32 * FX_ZROW + e0 + 4 * hi + 8 * g4); ssq += (z[g4].x * z[g4].x + z[g4].y * z[g4].y) + (z[g4].z * z[g4].z + z[g4].w * z[g4].w); }
            ssq += __shfl_xor(ssq, 32);
            if (hi == 0) ((LAS float*)(lds0 + FX_RED))[wq * 32 + r32] = ssq;
        }
        __syncthreads();
        if (dir == 0) {
            const LAS float* red = (const LAS float*)(lds0 + FX_RED);
            const float tot = (red[r32] + red[32 + r32]) + (red[64 + r32] + red[96 + r32]);
            const float rstd = rsqrtf(tot * (1.f / 128.f) + EPS);
            bf16_t* op = A2 + (size_t)row * DM + 1024 + hh * 128 + e0 + 4 * hi;
            const f32x4 gn[4] = {gn0, gn1, gn2, gn3};
#pragma unroll
            for (int g4 = 0; g4 < 4; ++g4) { const u32x2 raw = hgraw[g4];
                const f32x4 o = z[g4] * rstd * gn[g4] * (f32x4){bflo(raw.x), bfhi(raw.x), bflo(raw.y), bfhi(raw.y)};
                u32x2 w; w.x = cvtpk(o.x, o.y); w.y = cvtpk(o.z, o.w); *(u32x2*)(op + 8 * g4) = w; }
        }
    }
    __syncthreads();
}

namespace att {
constexpr int D = 128, NW = 8, QBLK = 32, KVBLK = 64;
constexpr float SCALE = 0.088388347648318440f;
constexpr float THR = 0.f;
constexpr int LDQ = 1024, LDK = 128, LDO = 2048;
constexpr int SHM_V = KVBLK * D * 2, SHM_K = KVBLK * D * 2, SHM_ATTN = 2 * SHM_V + 2 * SHM_K + NW * 64 * 4;
#define KSWZ(row, colB) ((row) * 256 + ((colB) ^ (((row) & 7) << 4)))
#define SBAR() __builtin_amdgcn_sched_barrier(0)
__device__ __forceinline__ unsigned cvtpk_a(float lo, float hi) { unsigned r; asm volatile("v_cvt_pk_bf16_f32 %0, %1, %2" : "=v"(r) : "v"(lo), "v"(hi)); return r; }
__device__ __forceinline__ void partialSM(f32x16& p0, f32x16& p1, float& m_reg, float& mn, float& alpha) {
  constexpr float C = SCALE * 1.4426950408889634f;
  float pmax = p0[0]; for (int r = 1; r < 16; ++r) pmax = fmaxf(pmax, p0[r]); for (int r = 0; r < 16; ++r) pmax = fmaxf(pmax, p1[r]);
  { auto rr = __builtin_amdgcn_permlane32_swap(__float_as_uint(pmax), __float_as_uint(pmax), false, false);
    pmax = fmaxf(__uint_as_float(rr[0]), __uint_as_float(rr[1])); }
  if (__builtin_expect(__all(pmax - m_reg <= THR / SCALE), 1)) { mn = m_reg; alpha = 1.f; }
  else { mn = fmaxf(m_reg, pmax); alpha = __builtin_amdgcn_exp2f((m_reg - mn) * C); m_reg = mn; }
  float mnC = -mn * C;
  for (int r = 0; r < 16; ++r) p0[r] = fmaf(p0[r], C, mnC); for (int r = 0; r < 16; ++r) p1[r] = fmaf(p1[r], C, mnC);
  for (int r = 0; r < 16; ++r) p0[r] = __builtin_amdgcn_exp2f(p0[r]);
}
__device__ __forceinline__ void finishSM(f32x16& p0, f32x16& p1, float alpha, float& l_reg, bf16x8& pa0, bf16x8& pa1, bf16x8& pa2, bf16x8& pa3) {
  for (int r = 0; r < 16; ++r) p1[r] = __builtin_amdgcn_exp2f(p1[r]);
  float ps = 0; for (int r = 0; r < 16; ++r) ps += p0[r]; for (int r = 0; r < 16; ++r) ps += p1[r];
  { auto rr = __builtin_amdgcn_permlane32_swap(__float_as_uint(ps), __float_as_uint(ps), false, false);
    ps = __uint_as_float(rr[0]) + __uint_as_float(rr[1]); }
  l_reg = l_reg * alpha + ps;
#define PK4(P, BASE, OUT) do { unsigned a0 = cvtpk_a(P[BASE + 0], P[BASE + 1]), a1 = cvtpk_a(P[BASE + 2], P[BASE + 3]);   \
    unsigned b0 = cvtpk_a(P[BASE + 4], P[BASE + 5]), b1 = cvtpk_a(P[BASE + 6], P[BASE + 7]);                              \
    auto r0 = __builtin_amdgcn_permlane32_swap(a0, b0, false, false); auto r1 = __builtin_amdgcn_permlane32_swap(a1, b1, false, false); \
    u32x4 w = {r0[0], r1[0], r0[1], r1[1]}; OUT = *reinterpret_cast<bf16x8*>(&w); } while (0)
  PK4(p0, 0, pa0); PK4(p0, 8, pa1); PK4(p1, 0, pa2); PK4(p1, 8, pa3);
#undef PK4
}
__device__ __forceinline__ void qkt(f32x16& p0, f32x16& p1, const bf16_t* Ks, const bf16x8* qr, int r32, int hi) {
  p0 = f32x16{}; p1 = f32x16{};
  for (int d0 = 0; d0 < 8; ++d0) { int cb = (d0 * 16 + hi * 8) * 2;
    bf16x8 b0 = *reinterpret_cast<const bf16x8*>((const char*)Ks + KSWZ(r32, cb));
    bf16x8 b1 = *reinterpret_cast<const bf16x8*>((const char*)Ks + KSWZ(32 + r32, cb));
    p0 = __builtin_amdgcn_mfma_f32_32x32x16_bf16(b0, qr[d0], p0, 0, 0, 0);
    p1 = __builtin_amdgcn_mfma_f32_32x32x16_bf16(b1, qr[d0], p1, 0, 0, 0); }
}
__device__ __forceinline__ int v_st(int k, int c) { const int kk = (k & ~0xC) | ((k & 4) << 1) | ((k & 8) >> 1); return ((kk >> 3) * 4 + (c >> 5)) * 512 + ((kk & 7) * 32 + (c & 31)) * 2; }
__device__ __forceinline__ int v_rd_base(int lane) { return ((lane & 3) << 3) | (((lane >> 2) & 3) << 6) | (((lane >> 4) & 1) << 5) | (((lane >> 5) & 1) << 8); }
constexpr int v_rd_off(int d0, int ks, int half) { return d0 * 512 + ks * 4096 + half * 2048; }
template <int OFF> __device__ __forceinline__ s16x4 tr_read(int vb) {
  s16x4 r; asm volatile("ds_read_b64_tr_b16 %0, %1 offset:%2" : "=&v"(r) : "v"(vb), "i"(OFF) : "memory"); return r;
}
template <int D0> __device__ __forceinline__ void pv_one(f32x16& od, int vb, bf16x8 pa0, bf16x8 pa1, bf16x8 pa2, bf16x8 pa3) {
  const s16x4 l0 = tr_read<v_rd_off(D0, 0, 0)>(vb), h0 = tr_read<v_rd_off(D0, 0, 1)>(vb), l1 = tr_read<v_rd_off(D0, 1, 0)>(vb), h1 = tr_read<v_rd_off(D0, 1, 1)>(vb);
  const s16x4 l2 = tr_read<v_rd_off(D0, 2, 0)>(vb), h2 = tr_read<v_rd_off(D0, 2, 1)>(vb), l3 = tr_read<v_rd_off(D0, 3, 0)>(vb), h3 = tr_read<v_rd_off(D0, 3, 1)>(vb);
  asm volatile("s_waitcnt lgkmcnt(0)" ::: "memory"); SBAR();
#define PK(L, H) (bf16x8){L[0], L[1], L[2], L[3], H[0], H[1], H[2], H[3]}
  od = __builtin_amdgcn_mfma_f32_32x32x16_bf16(pa0, PK(l0, h0), od, 0, 0, 0);
  od = __builtin_amdgcn_mfma_f32_32x32x16_bf16(pa1, PK(l1, h1), od, 0, 0, 0);
  od = __builtin_amdgcn_mfma_f32_32x32x16_bf16(pa2, PK(l2, h2), od, 0, 0, 0);
  od = __builtin_amdgcn_mfma_f32_32x32x16_bf16(pa3, PK(l3, h3), od, 0, 0, 0);
#undef PK
}
__device__ __forceinline__ void pv_d0(f32x16* o, int vb, bf16x8 pa0, bf16x8 pa1, bf16x8 pa2, bf16x8 pa3) {
  pv_one<0>(o[0], vb, pa0, pa1, pa2, pa3); pv_one<1>(o[1], vb, pa0, pa1, pa2, pa3); pv_one<2>(o[2], vb, pa0, pa1, pa2, pa3); pv_one<3>(o[3], vb, pa0, pa1, pa2, pa3);
}
__device__ __forceinline__ void attn_dense_body(const bf16_t* __restrict__ Qb, const bf16_t* __restrict__ Kh, const bf16_t* __restrict__ Vh,
                                                bf16_t* __restrict__ Ob, int seq, char* lds) {
  const int tid = threadIdx.x, wid = tid >> 6, lane = tid & 63, r32 = lane & 31, hi = lane >> 5;
  bf16_t* V_lds = (bf16_t*)lds; bf16_t* K_lds = (bf16_t*)(lds + 2 * SHM_V);
  float* ws = (float*)(lds + 2 * SHM_V + 2 * SHM_K) + wid * 64; float* li_l = ws; float* al_l = ws + 32;
  float m_reg = -1e30f, l_reg = 0; f32x16 o[4] = {}; bf16x8 qr[8];
  const bf16_t* Qw = Qb + (long)(wid * QBLK + r32) * LDQ + hi * 8;
#pragma unroll
  for (int d0 = 0; d0 < 8; ++d0) qr[d0] = *reinterpret_cast<const bf16x8*>(Qw + d0 * 16);
  const int sr = tid >> 4, sc = (tid & 15) * 8, vst0 = v_st(sr, sc), vst1 = v_st(32 + sr, sc);
  const int vb0 = (int)(uintptr_t)V_lds + v_rd_base(lane);
  struct { bf16x8 vs0, vs1, ks0, ks1; } sr_[2];
#define LD8(p) (*reinterpret_cast<const bf16x8*>(p))
#define SLOAD(i, k0) do { sr_[i].vs0 = LD8(&Vh[(long)((k0) + sr) * LDK + sc]); sr_[i].vs1 = LD8(&Vh[(long)((k0) + 32 + sr) * LDK + sc]); \
    sr_[i].ks0 = LD8(&Kh[(long)((k0) + sr) * LDK + sc]); sr_[i].ks1 = LD8(&Kh[(long)((k0) + 32 + sr) * LDK + sc]); } while (0)
#define SWRITE(b, i) do { *(bf16x8*)((char*)V_lds + (b) * SHM_V + vst0) = sr_[i].vs0;          \
    *(bf16x8*)((char*)V_lds + (b) * SHM_V + vst1) = sr_[i].vs1; int kc = sc * 2;               \
    *(bf16x8*)((char*)K_lds + (b) * SHM_K + KSWZ(sr, kc)) = sr_[i].ks0;                       \
    *(bf16x8*)((char*)K_lds + (b) * SHM_K + KSWZ(32 + sr, kc)) = sr_[i].ks1; } while (0)
#define SWAIT() asm volatile("s_waitcnt vmcnt(4)" ::: "memory")
#define RESC(a) do { if (__any((a) < 1.f)) { if (hi == 0) al_l[r32] = (a); asm volatile("s_waitcnt lgkmcnt(0)" ::: "memory"); \
    for (int d = 0; d < 4; ++d) for (int r = 0; r < 16; ++r) o[d][r] *= al_l[crow(r, hi)]; } } while (0)
  f32x16 pA0, pA1, pB0, pB1; float mnA, mnB, alA, alB; bf16x8 pa0, pa1, pa2, pa3; const int NT = seq / KVBLK;
  constexpr int SE = 0, SO = 1;
  SLOAD(SE, 0); asm volatile("s_waitcnt vmcnt(0)" ::: "memory"); SWRITE(0, SE); __syncthreads();
  qkt(pA0, pA1, K_lds, qr, r32, hi); partialSM(pA0, pA1, m_reg, mnA, alA);
  SLOAD(SO, KVBLK); if (2 < NT) SLOAD(SE, 2 * KVBLK);
  SWAIT(); SWRITE(1, SO); __syncthreads();
  for (int j = 1; j + 1 < NT; j += 2) {
    SBAR(); qkt(pB0, pB1, (bf16_t*)((char*)K_lds + SHM_K), qr, r32, hi);
    finishSM(pA0, pA1, alA, l_reg, pa0, pa1, pa2, pa3); SBAR();
    SLOAD(SO, (j + 2) * KVBLK); SBAR();
    pv_d0(o, vb0, pa0, pa1, pa2, pa3); partialSM(pB0, pB1, m_reg, mnB, alB);
    __syncthreads(); SWAIT(); SWRITE(0, SE);
    RESC(alB); __syncthreads();
    SBAR(); qkt(pA0, pA1, K_lds, qr, r32, hi);
    finishSM(pB0, pB1, alB, l_reg, pa0, pa1, pa2, pa3); SBAR();
    if (j + 3 < NT) SLOAD(SE, (j + 3) * KVBLK); SBAR();
    pv_d0(o, vb0 + (int)SHM_V, pa0, pa1, pa2, pa3); partialSM(pA0, pA1, m_reg, mnA, alA);
    __syncthreads(); SWAIT(); SWRITE(1, SO);
    RESC(alA); __syncthreads();
  }
  SBAR(); qkt(pB0, pB1, (bf16_t*)((char*)K_lds + SHM_K), qr, r32, hi);
  finishSM(pA0, pA1, alA, l_reg, pa0, pa1, pa2, pa3); SBAR();
  pv_d0(o, vb0, pa0, pa1, pa2, pa3); partialSM(pB0, pB1, m_reg, mnB, alB);
  __syncthreads(); RESC(alB);
  finishSM(pB0, pB1, alB, l_reg, pa0, pa1, pa2, pa3); SBAR();
  pv_d0(o, vb0 + (int)SHM_V, pa0, pa1, pa2, pa3);
  if (hi == 0) li_l[r32] = l_reg; asm volatile("s_waitcnt lgkmcnt(0)" ::: "memory");
  float rli[16];
#pragma unroll
  for (int r = 0; r < 16; ++r) rli[r] = __builtin_amdgcn_rcpf(li_l[crow(r, hi)]);
  bf16_t* Ow = Ob + (long)(wid * QBLK) * LDO;
#pragma unroll
  for (int r = 0; r < 16; ++r) { int orow = crow(r, hi);
    for (int d0 = 0; d0 < 4; ++d0) { const float v = o[d0][r] * rli[r]; Ow[(long)orow * LDO + d0 * 32 + r32] = (bf16_t)(cvtpk(v, v) & 0xffffu); } }
  __syncthreads();
#undef LD8
#undef SLOAD
#undef SWRITE
#undef SWAIT
#undef RESC
}
#undef SBAR
}

constexpr int N_PHASES = 13;
__global__ void __launch_bounds__(NWAVES * 64, 2) fwd_kernel(Args args) {
    extern __shared__ __attribute__((aligned(16))) unsigned char lds_raw[];
    LAS unsigned char* lds = (LAS unsigned char*)lds_raw;
    volatile LAS unsigned* MISC = (volatile LAS unsigned*)(lds + MISC_OFF);
    const int tid = threadIdx.x, wave = __builtin_amdgcn_readfirstlane(tid >> 6);
    const int G = gridDim.x, bx = blockIdx.x;
    const int gw = bx * NWAVES + wave, NGW = G * NWAVES;
#define lane lane_id()
    gu32* ctl = (gu32*)(args.ws + WS_CTL);
    for (int u = tid; u < (LDS_BYTES - LDSCTL_OFF) / 4; u += NWAVES * 64) ((LAS unsigned*)(lds + LDSCTL_OFF))[u] = 0u;
    __syncthreads();
    XcdBarrier bar; bar.bar = (unsigned*)(ctl + CW_BAR); bar.x = 0; bar.st = nullptr;
    if (!MK_PER_PHASE) bar = xcd_barrier_post((unsigned*)(ctl + CW_BAR), MISC + 8);
    const int lo = args.ph_lo, hi = args.ph_hi;
#define IN(k) (lo <= (k) && (k) < hi)
#define STAMP(i) do { if (PROBE_PH >= 0 && bx == 0 && tid == 0) { MISC[16 + (i)] = (unsigned)__builtin_amdgcn_s_memrealtime(); MISC[15] = (unsigned)(i); } } while (0)
#define SEAM(k) do { if (IN(k) && IN((k) + 1)) xcd_barrier(bar); STAMP((k) + 1); } while (0)
#define W_IN ((bf16_t*)(args.ws + WS_WIN))
#define W_OUT ((bf16_t*)(args.ws + WS_WOUT))
#define W_POOL ((bf16_t*)(args.ws + WS_WPOOL))
#define W_M1 ((bf16_t*)(args.ws + WS_WM1))
#define W_M2 ((bf16_t*)(args.ws + WS_WM2))
#define Hb ((bf16_t*)(args.ws + WS_H))
#define ZB ((bf16_t*)(args.ws + WS_ZB))
#define LFb ((float*)(args.ws + WS_LF))
#define A2 ((bf16_t*)(args.ws + WS_A2))
#define XA ((float*)(args.ws + WS_XA))
#define Ub ((bf16_t*)(args.ws + WS_U))
#define MOD ((const float*)(args.ws + WS_MOD))
#define ROWSS ((float*)(args.ws + WS_ROWSS))
#define SW ((float*)(args.ws + WS_SW))
#define IDLE_FIRST(nwg) (((nwg) % G) ? ((nwg) % G) : 0)

    STAMP(0);
    if (IN(0)) {
        for (int wi = bx; wi < 256; wi += G) p0_ada_item(args, lds, wi, tid);
        bg_transposes(args, lds, R_IN, R_OUT, gw, NGW, wave, lane);
    }
    SEAM(0);
    if (IN(1)) norm_rows_bf16(args, nullptr, args.in[10], 0, 0, Hb, gw, NGW, lane);
    SEAM(1);
    if (IN(2)) { pg8::Gemm g{Hb, W_IN, NTOK, IN_AB, 2048, 2048, 2048, 0, 0}; pg8::StaticOrder S; S.init(NTOK, IN_AB, 2048, G, bx);
        EpiIn E{ZB, LFb, args.in[17]}; pg8::gemm_phase<EpiIn, pg8::StaticOrder>(lds, g, S, E);
        const int f = IDLE_FIRST(624); if (bx >= f) bg_transposes(args, lds, R_OUT, R_M2_0, (bx - f) * NWAVES + wave, (G - f) * NWAVES, wave, lane); }
    SEAM(2);
    if (IN(3)) {
        HgRegs RA, RB;
        if (bx < 192) hgrn_prefetch(args, bx, tid, RA, RB);
        for (int row = gw; row < NTOK; row += NGW) post_token(args, row, lane);
        for (int it = gw; it < 1024; it += NGW) cache_item(args, it, lane);
        if (bx < 192) hgrn_task(args, lds, bx, tid, RA, RB);
        else bg_transposes(args, lds, R_M2_0, R_POOL, (bx - 192) * NWAVES + wave, (G - 192) * NWAVES, wave, lane);
    }
    SEAM(3);
    if (IN(4)) {
        if (bx < 192) { const int u = bx;
            const bf16_t *Q, *K, *V; bf16_t* O; int seq;
            if (u < 64) { const int b = u >> 5, h = (u >> 2) & 7, qb = u & 3; const size_t row0 = NTOK_P + b * SEQ_S + qb * 256;
                Q = (const bf16_t*)(args.ws + WS_QN) + row0 * 1024 + h * 128; O = A2 + row0 * DM + h * 128;
                K = (const bf16_t*)(args.ws + WS_KS) + (size_t)(b * 2 + (h >> 2)) * 1280 * 128; V = (const bf16_t*)(args.ws + WS_VS) + (size_t)(b * 2 + (h >> 2)) * 1280 * 128; seq = 1280; }
            else { const int v = u - 64, b = v >> 3, h = v & 7; const size_t row0 = b * 256;
                Q = (const bf16_t*)(args.ws + WS_QN) + row0 * 1024 + h * 128; O = A2 + row0 * DM + h * 128;
                K = (const bf16_t*)(args.ws + WS_KP) + (size_t)(b * 2 + (h >> 2)) * 256 * 128; V = (const bf16_t*)(args.ws + WS_VP) + (size_t)(b * 2 + (h >> 2)) * 256 * 128; seq = 256; }
            att::attn_dense_body(Q, K, V, O, seq, (char*)lds_raw);
        }
        if (bx >= 192) { for (int t = bx - 192; t < 64; t += G - 192) hgfix_task(args, lds, t, tid); }
        else if (bx >= 64) { for (int row = (bx - 64) * NWAVES + wave; row < NTOK_P; row += 128 * NWAVES) combine_token(args, row, lane); }
    }
    SEAM(4);
    if (IN(5)) { pg8::Gemm g{A2, W_OUT, NTOK, DM, 2048, 2048, 2048, 0, 0}; pg8::StaticOrder S; S.init(NTOK, DM, 2048, G, bx, 192);
        EpiRes<3> E{args.in[0], args.in[1], XA, MOD + 2 * 2048, nullptr, Hb, args.in[11], MOD + 4 * 2048, ROWSS}; pg8::gemm_phase<EpiRes<3>, pg8::StaticOrder, true, 3>(lds, g, S, E); }
    SEAM(5);
    if (IN(6)) { pg8::Gemm g{Hb, W_M1, NTOK, DFF, 2048, 2048, 2048, 0, 0}; pg8::StaticOrder S; S.init(NTOK, DFF, 2048, G, bx);
        EpiRelu2 E{Ub, ROWSS, SW}; pg8::gemm_phase<EpiRelu2, pg8::StaticOrder>(lds, g, S, E); }
    SEAM(6);
    if (IN(7)) { pg8::Gemm g{Ub, W_M2, NTOK, DM, DFF, DFF, DFF, 0, 0}; pg8::StaticOrder S; S.init(NTOK, DM, DFF, G, bx);
        EpiRes<4> E{XA, XA + (size_t)NTOK_P * DM, XA, MOD + 5 * 2048, nullptr, nullptr, nullptr, nullptr, ROWSS + NTOK}; pg8::gemm_phase<EpiRes<4>, pg8::StaticOrder>(lds, g, S, E);
        const int f = IDLE_FIRST(192);
        if (bx >= f) {
            const int w = (bx - f) * NWAVES + wave, nw = (G - f) * NWAVES;
            for (int wi = 256 + (bx - f); wi < 512; wi += G - f) p0_ada_item(args, lds, wi, tid);
            asm volatile("s_waitcnt vmcnt(0)" ::: "memory"); __syncthreads();
            unsigned* cnt = (unsigned*)(args.ws + WS_CTL) + CW_ADA1;
            if (tid == 0) { __builtin_amdgcn_fence(__ATOMIC_RELEASE, "agent"); asm volatile("s_waitcnt vmcnt(0)" ::: "memory"); __hip_atomic_fetch_add(cnt, 1u, __ATOMIC_RELAXED, __HIP_MEMORY_SCOPE_AGENT); }
            bg_transposes(args, lds, R_POOL, R_M1_1, w, nw, wave, lane);
            bg_transposes(args, lds, R_M2_1, R_END, w, nw, wave, lane);
            if (tid == 0) { unsigned sp = 0; while (__hip_atomic_load(cnt, __ATOMIC_RELAXED, __HIP_MEMORY_SCOPE_AGENT) < (unsigned)(G - f)) { __builtin_amdgcn_s_sleep(4); if (++sp > (1u << 22)) break; }
                __builtin_amdgcn_fence(__ATOMIC_ACQUIRE, "agent"); asm volatile("s_waitcnt vmcnt(0)" ::: "memory"); }
            __syncthreads();
            bg_transposes(args, lds, R_M1_1, R_M2_1, w, nw, wave, lane);
        } }
    SEAM(7);
    if (IN(8)) pool_phase(args, lds, XA, ROWSS + NTOK, Hb, bx, G, tid);
    SEAM(8);
    if (IN(9)) { pg8::Gemm g{Hb, W_POOL, NTOK, DM, 512, 2048, 512, 1, 512}; pg8::StaticOrder S; S.init(NTOK, DM, 512, G, bx, 192);
        EpiRes<3> E{XA, XA + (size_t)NTOK_P * DM, XA, MOD + NMODC + 2 * 2048, args.in[19], A2, args.in[11] + 2048, MOD + NMODC + 4 * 2048, ROWSS + 2 * NTOK};
        pg8::gemm_phase<EpiRes<3>, pg8::StaticOrder, true, 3>(lds, g, S, E); }
    SEAM(9);
    if (IN(10)) { pg8::Gemm g{A2, W_M1 + (size_t)DFF * 2048, NTOK, DFF, 2048, 2048, 2048, 0, 0}; pg8::StaticOrder S; S.init(NTOK, DFF, 2048, G, bx);
        EpiRelu2 E{Ub, ROWSS + 2 * NTOK, SW + 3 * DFF}; pg8::gemm_phase<EpiRelu2, pg8::StaticOrder>(lds, g, S, E); }
    SEAM(10);
    if (IN(11)) { pg8::Gemm g{Ub, W_M2 + (size_t)2048 * DFF, NTOK, DM, DFF, DFF, DFF, 0, 0}; pg8::StaticOrder S; S.init(NTOK, DM, DFF, G, bx, 192);
        EpiRes<3> E{XA, XA + (size_t)NTOK_P * DM, XA, MOD + NMODC + 5 * 2048, nullptr, nullptr, nullptr, nullptr, ROWSS + 3 * NTOK};
        pg8::gemm_phase<EpiRes<3>, pg8::StaticOrder, true, 3>(lds, g, S, E); }
    SEAM(11);
    if (IN(12)) final_rows(XA, ROWSS + 3 * NTOK, args.in[22], args.out, gw, NGW, lane);
    if (PROBE_PH >= 0 && bx == 0 && tid == 0) { STAMP(13); const unsigned d = (MISC[PROBE_B] - MISC[PROBE_A]) * PROBE_K, t0 = (unsigned)__builtin_amdgcn_s_memrealtime();
        while ((unsigned)__builtin_amdgcn_s_memrealtime() - t0 < d) __builtin_amdgcn_s_sleep(8); }
#undef IN
#undef SEAM
#undef STAMP
#undef IDLE_FIRST
#undef lane
#undef W_IN
#undef W_OUT
#undef W_POOL
#undef W_M1
#undef W_M2
#undef Hb
#undef ZB
#undef LFb
#undef A2
#undef XA
#undef Ub
#undef MOD
#undef ROWSS
#undef SW
}

extern "C" void kernel_launch(void* const* d_in, const int* in_sizes, int n_in, void* d_out, int out_size, void* d_ws, size_t ws_size, hipStream_t stream) {
    static int grid = 0;
    if (grid == 0) {
        if (n_in != 23 || out_size != 18874368 || ws_size < WS_END) { fprintf(stderr, "kernel_launch: unexpected shapes (n_in %d out %d ws %zu)\n", n_in, out_size, ws_size); grid = -1; return; }
        int dev = 0, cus = 0;
        if (hipGetDevice(&dev) != hipSuccess || hipDeviceGetAttribute(&cus, hipDeviceAttributeMultiprocessorCount, dev) != hipSuccess) { grid = -1; return; }
        if (hipFuncSetAttribute((const void*)fwd_kernel, hipFuncAttributeMaxDynamicSharedMemorySize, LDS_BYTES) != hipSuccess) { fprintf(stderr, "kernel_launch: hipFuncSetAttribute failed\n"); grid = -1; return; }
        int per_cu = 0;
        if (hipOccupancyMaxActiveBlocksPerMultiprocessor(&per_cu, (const void*)fwd_kernel, NWAVES * 64, LDS_BYTES) != hipSuccess || per_cu < 1) fprintf(stderr, "kernel_launch: occupancy query says %d\n", per_cu);
        (void)hipGetLastError();
        if (cus != 256) { fprintf(stderr, "kernel_launch: built for a 256-CU device, found %d CUs\n", cus); grid = -1; return; }
        grid = cus;
    }
    if (grid < 0) return;
    (void)hipMemsetAsync((char*)d_ws + WS_CTL, 0, CTL_ZERO_BYTES, stream);
    Args a{};
    for (int i = 0; i < 23; ++i) a.in[i] = (const float*)d_in[i];
    a.out = (float*)d_out; a.ws = (unsigned char*)d_ws;
#if MK_PER_PHASE
    for (int p = 0; p < N_PHASES; ++p) { a.ph_lo = p; a.ph_hi = p + 1; hipLaunchKernelGGL(fwd_kernel, dim3(grid), dim3(NWAVES * 64), LDS_BYTES, stream, a);
        if (p == REP_PHASE) hipLaunchKernelGGL(fwd_kernel, dim3(grid), dim3(NWAVES * 64), LDS_BYTES, stream, a); }
#else
    a.ph_lo = 0; a.ph_hi = N_PHASES;
    hipLaunchKernelGGL(fwd_kernel, dim3(grid), dim3(NWAVES * 64), LDS_BYTES, stream, a);
#endif
}
```

```cpp
#include <hip/hip_runtime.h>
#include <hip/hip_bf16.h>
#include <cstdio>
#include <cstdint>

#ifndef MK_PER_PHASE
#define MK_PER_PHASE 0
#endif

#ifndef PROBE_PH
#define PROBE_PH -1
#endif
#define PROBE_K 8
#ifndef PROBE_BX
#define PROBE_BX 0
#endif
#ifndef PROBE_A
#define PROBE_A (16 + PROBE_PH)
#define PROBE_B (17 + PROBE_PH)
#endif
#ifndef PROBE_GPH
#define PROBE_GPH -1
#endif
#ifndef REP_PHASE
#define REP_PHASE -1
#endif
constexpr int DM = 2048, NTOK_P = 4096, NTOK_S = 2048, NTOK = 6144, SEQ_P = 256, SEQ_S = 1024, NB_P = 16, NB_S = 2, PAST = 256;
constexpr int IN_AB = 6656, DFF = 8192, NMODC = 12288;
constexpr int C_Q = 0, C_K = 1024, C_V = 1280, C_HQ = 1536, C_ZF = 2560, C_ZB = 3584, C_HI = 4608, C_HG = 5632;
constexpr float EPS = 1e-6f;
constexpr int MISC_OFF = 131072 + 320;

#define GAS __attribute__((address_space(1)))
#define LAS __attribute__((address_space(3)))
typedef unsigned short bf16_t;
typedef short bf16x8 __attribute__((ext_vector_type(8)));
typedef short s16x4 __attribute__((ext_vector_type(4)));
typedef float f32x4 __attribute__((ext_vector_type(4)));
typedef float f32x2 __attribute__((ext_vector_type(2)));
typedef float f32x16 __attribute__((ext_vector_type(16)));
typedef unsigned u32x4 __attribute__((ext_vector_type(4)));
typedef unsigned u32x2 __attribute__((ext_vector_type(2)));
typedef __bf16 bf16x2_t __attribute__((ext_vector_type(2)));
typedef GAS unsigned gu32;

__device__ __forceinline__ unsigned cvtpk(float lo, float hi) { f32x2 v = {lo, hi}; bf16x2_t b = __builtin_convertvector(v, bf16x2_t); return __builtin_bit_cast(unsigned, b); }
__device__ __forceinline__ float bf2f(unsigned short u) { return __uint_as_float(((unsigned)u) << 16); }
__device__ __forceinline__ float bflo(unsigned u) { return __uint_as_float(u << 16); }
__device__ __forceinline__ float bfhi(unsigned u) { return __uint_as_float(u & 0xffff0000u); }
__device__ __forceinline__ float siluf(float x) { return x * __builtin_amdgcn_rcpf(1.f + __expf(-x)); }
__device__ __forceinline__ int lane_id() { int l; asm volatile("v_mbcnt_lo_u32_b32 %0, -1, 0\n\tv_mbcnt_hi_u32_b32 %0, -1, %0" : "=v"(l)); return l; }
__device__ __forceinline__ float wave_sum(float v) {
#pragma unroll
    for (int o = 1; o < 64; o <<= 1) v += __shfl_xor(v, o);
    return v;
}
__device__ __forceinline__ float half_sum(float v) {
#pragma unroll
    for (int o = 1; o < 32; o <<= 1) v += __shfl_xor(v, o);
    return v;
}

namespace pg8 {
#define PG8_LAS __attribute__((address_space(3)))
constexpr int BM = 256, BK = 64, HALF = 128, HTB = HALF * BK * 2, STAGE_BYTES = 8 * HTB, NXCD = 8, WGM = 8;
__host__ __device__ __forceinline__ int lds_byte(int r, int c) { const int st = (r >> 4) * 2 + (c >> 5), rr = r & 15, cc = c & 31, ob = rr * 64 + cc * 2; return st * 1024 + (ob ^ (((ob >> 9) & 1) << 5)); }
__host__ __device__ __forceinline__ void stage_rc(int b, int& R, int& C) { const int st = b / 1024, sb = b % 1024, swz = sb ^ (((sb >> 9) & 1) << 5); R = (st >> 1) * 16 + swz / 64; C = (st & 1) * 32 + (swz % 64) / 2; }
__host__ __device__ __forceinline__ int perm32(int rho) { const int n = rho >> 4, i = rho & 15; return 8 * (i >> 2) + 4 * n + (i & 3); }

struct Unit { int pm, pn, kt0, nkt, role, pidx; };
struct Gemm { const bf16_t* A; const bf16_t* Bt; int M, N, K, lda, ldb, apn_shift, apn_mul; };
struct PartCtx { float* part; unsigned* flags; unsigned epoch; };

struct StaticOrder {
    int nM, nN, nwg, G, c, nkt, pn_perm;
    __host__ __device__ void init(int M, int N, int K, int G_, int c_, int bmr = BM, int pn_perm_ = 0) { nM = M / bmr; nN = N / BM; nwg = nM * nN; G = G_; c = c_; nkt = K / BK; pn_perm = pn_perm_; }
    __host__ __device__ void unit_of(int L, Unit& u) const {
        int wgid = L; { const int q = nwg / NXCD, r = nwg % NXCD, xcd = wgid % NXCD, off = wgid / NXCD; wgid = (xcd < r ? xcd * (q + 1) : r * (q + 1) + (xcd - r) * q) + off; }
        const int nig = WGM * nN, gid = wgid / nig, fm = gid * WGM, gsz = (nM - fm) < WGM ? (nM - fm) : WGM;
        u.pm = fm + ((wgid % nig) % gsz); u.pn = (wgid % nig) / gsz;
        if (pn_perm) {
            const unsigned long long k0 = 0x4d059386d4d4d7ull, k1 = 0x51f0b0bf3488a04ull, k2 = 0x196ull; const int p = u.pn;
            u.pn = (int)(((p < 12 ? k0 : (p < 24 ? k1 : k2)) >> (5 * (p % 12))) & 31ull); }
    }
    __host__ __device__ bool next(int i, Unit& u) const {
        const long L = (long)i * G + c; if (L >= nwg) return false;
        unit_of((int)L, u); u.kt0 = 0; u.nkt = nkt; u.role = 0; u.pidx = 0; return true;
    }
};
struct SplitOrder {
    StaticOrder S;
    __host__ __device__ void init(int M, int N, int K, int G_, int c_) { S.init(M, N, K, G_, c_); }
    __host__ __device__ bool next(int i, Unit& u) const {
        const int q = S.nkt / 4;
        if (S.c < S.nwg) { if (i > 0) return false; S.unit_of(S.c, u); u.kt0 = 0; u.nkt = 3 * q; u.role = 1; u.pidx = S.c; return true; }
        if (i >= 3) return false;
        const int L = 3 * (S.c - S.nwg) + i; if (L >= S.nwg) return false;
        S.unit_of(L, u); u.kt0 = 3 * q; u.nkt = q; u.role = 2; u.pidx = L; return true;
    }
};
struct TailSplitOrder {
    StaticOrder S;
    __host__ __device__ void init(int M, int N, int K, int G_, int c_) { S.init(M, N, K, G_, c_); }
    __host__ __device__ bool next(int i, Unit& u) const {
        if (i < 2) return S.next(i, u);
        if (i > 2) return false;
        const int r = S.nwg - 2 * S.G, p = S.c >> 1; if (p >= r) return false;
        S.unit_of(2 * S.G + p, u); const int h = S.nkt / 2;
        if (S.c & 1) { u.kt0 = h; u.nkt = h; u.role = 2; } else { u.kt0 = 0; u.nkt = h; u.role = 1; }
        u.pidx = p; return true;
    }
};

template <bool PERM, class Sched>
__device__ __forceinline__ void gemm_prefetch_b(PG8_LAS unsigned char* lds, const Gemm g, const Sched& S) {
    Unit cur; if (!S.next(0, cur)) return;
    const int wid = __builtin_amdgcn_readfirstlane((int)threadIdx.x >> 6), lane = threadIdx.x & 63;
    if (wid == 0) return;
    const size_t hstepB = (size_t)HALF * g.ldb * 2, tstepB = 2 * hstepB;
    const char* cB = (const char*)g.Bt + (size_t)cur.pn * tstepB + (size_t)cur.kt0 * (BK * 2);
    const int nw = wid == 1 ? 2 : 1;
    for (int q = 0; q < nw; ++q) { const int pw = q == 0 ? wid : 0, ptid = pw * 64 + lane;
#pragma unroll
        for (int i = 0; i < 2; ++i) { int R, C; stage_rc(ptid * 16 + i * 8192, R, C); const int Rb = PERM ? ((R & ~31) + perm32(R & 31)) : R; const unsigned vo = (unsigned)(Rb * g.ldb + C) * 2u;
            __builtin_amdgcn_global_load_lds((const unsigned*)(cB + vo), (PG8_LAS unsigned*)(lds + 4 * HTB + pw * 1024 + i * 8192), 16, 0, 0);
            __builtin_amdgcn_global_load_lds((const unsigned*)(cB + hstepB + vo), (PG8_LAS unsigned*)(lds + 5 * HTB + pw * 1024 + i * 8192), 16, 0, 0); } }
}
template <class Epi, class Sched, bool ALIGN_EPI = true, int MR = 4, bool BPF = false>
__device__ __forceinline__ void gemm_phase(PG8_LAS unsigned char* lds, const Gemm g, const Sched& S, const Epi& E, const PartCtx pc = PartCtx{nullptr, nullptr, 0u}) {
    const int tid = threadIdx.x, wid = __builtin_amdgcn_readfirstlane(tid >> 6), lane = tid & 63, wr = wid >> 2, wc = wid & 3, fr = lane & 15, fq = lane >> 4;
    unsigned voffA[2], voffB[2];
#pragma unroll
    for (int i = 0; i < 2; ++i) { int R, C; stage_rc(tid * 16 + i * 8192, R, C); const int Rb = Epi::PERM ? ((R & ~31) + perm32(R & 31)) : R;
        voffA[i] = (unsigned)(R * g.lda + C) * 2u; voffB[i] = (unsigned)(Rb * g.ldb + C) * 2u; }
    const size_t kstep = (size_t)(BK * 2);
    const size_t hstepA = (size_t)(32 * MR) * g.lda * 2, hstepB = (size_t)HALF * g.ldb * 2;
    const size_t tstepA = 2 * hstepA, tstepB = 2 * hstepB;
    const unsigned ldsw = (unsigned)wid * 1024u;
    const int aoff = lds_byte(wr * (16 * MR) + fr, fq * 8), boff = lds_byte(wc * 32 + fr, fq * 8);
#define PG8_SA(b, h) (((b) * 2 + (h)) * HTB)
#define PG8_SB(b, h) ((4 + (b) * 2 + (h)) * HTB)
#define PG8_STAGE(bufoff, gbase, voff) do { _Pragma("unroll") for (int _i = 0; _i < 2; ++_i) \
        __builtin_amdgcn_global_load_lds((const unsigned*)((const char*)(gbase) + (voff)[_i]), (PG8_LAS unsigned*)(lds + (bufoff) + ldsw + _i * 8192), 16, 0, 0); } while (0)
#define PG8_LDA(dst, b, h) do { _Pragma("unroll") for (int m = 0; m < MR; ++m) _Pragma("unroll") for (int k = 0; k < 2; ++k) dst[m][k] = *(const PG8_LAS bf16x8*)(lds + PG8_SA(b, h) + aoff + m * 2048 + k * 1024); } while (0)
#define PG8_LDB(dst, b, h) do { _Pragma("unroll") for (int n = 0; n < 2; ++n) _Pragma("unroll") for (int k = 0; k < 2; ++k) dst[n][k] = *(const PG8_LAS bf16x8*)(lds + PG8_SB(b, h) + boff + n * 2048 + k * 1024); } while (0)
#define PG8_MMA(ai, bj, At, Bt) do { __builtin_amdgcn_s_setprio(1); _Pragma("unroll") for (int m = 0; m < MR; ++m) _Pragma("unroll") for (int n = 0; n < 2; ++n) _Pragma("unroll") for (int k = 0; k < 2; ++k) \
        acc[ai][bj][m][n] = __builtin_amdgcn_mfma_f32_16x16x32_bf16(Bt[n][k], At[m][k], acc[ai][bj][m][n], 0, 0, 0); __builtin_amdgcn_s_setprio(0); } while (0)
#define PG8_WAIT_V(n) asm volatile("s_waitcnt vmcnt(" #n ")" ::: "memory")
#define PG8_WAIT_L(n) asm volatile("s_waitcnt lgkmcnt(" #n ")" ::: "memory")
#define PG8_BAR __builtin_amdgcn_s_barrier()
#define PG8_SCHED __builtin_amdgcn_sched_barrier(0)
#define PG8_AOFF(u) ((size_t)(((u).pn >> g.apn_shift) * g.apn_mul) * 2)
#define GSTAMP(i) do { if (PROBE_PH >= 0 && PROBE_GPH >= 0 && blockIdx.x == PROBE_BX && tid == 0) { volatile PG8_LAS unsigned* M_ = (volatile PG8_LAS unsigned*)(lds + MISC_OFF); if (M_[15] == (unsigned)PROBE_GPH) M_[40 + (i)] = (unsigned)__builtin_amdgcn_s_memrealtime(); } } while (0)
    Unit cur, nxt; int ui = 0;
    if (!S.next(0, cur)) return;
    GSTAMP(0);
    f32x4 acc[2][2][MR][2];
#pragma unroll
    for (int a = 0; a < 2; ++a)
#pragma unroll
        for (int b = 0; b < 2; ++b)
#pragma unroll
            for (int m = 0; m < MR; ++m)
#pragma unroll
                for (int n = 0; n < 2; ++n) acc[a][b][m][n] = (f32x4){0.f, 0.f, 0.f, 0.f};
    bf16x8 At[MR][2], B0[2][2], B1[2][2];
    const char* cA = (const char*)g.A + (size_t)cur.pm * tstepA + PG8_AOFF(cur) + (size_t)cur.kt0 * kstep; const char* cB = (const char*)g.Bt + (size_t)cur.pn * tstepB + (size_t)cur.kt0 * kstep;
    {
        if constexpr (!BPF) { PG8_STAGE(PG8_SB(0, 0), cB, voffB); PG8_STAGE(PG8_SB(0, 1), cB + hstepB, voffB); }
        PG8_STAGE(PG8_SA(0, 0), cA, voffA); PG8_STAGE(PG8_SA(0, 1), cA + hstepA, voffA);
        if (wr == 1) PG8_BAR;
        PG8_WAIT_V(2); PG8_BAR;
        PG8_STAGE(PG8_SB(1, 0), cB + kstep, voffB); PG8_STAGE(PG8_SA(1, 0), cA + kstep, voffA); PG8_STAGE(PG8_SB(1, 1), cB + hstepB + kstep, voffB);
        PG8_WAIT_V(6); PG8_BAR;
    }
    for (;;) {
        const bool has_next = S.next(ui + 1, nxt);
        const char* nA = has_next ? (const char*)g.A + (size_t)nxt.pm * tstepA + PG8_AOFF(nxt) + (size_t)nxt.kt0 * kstep : cA; const char* nB = has_next ? (const char*)g.Bt + (size_t)nxt.pn * tstepB + (size_t)nxt.kt0 * kstep : cB;
        const int nt = cur.nkt;
        for (int t = 0; t < nt; t += 2) {
            const bool last = (t == nt - 2);
            const char* a1 = cA + (size_t)(t + 1) * kstep;
            const char* a2 = last ? nA : cA + (size_t)(t + 2) * kstep; const char* b2 = last ? nB : cB + (size_t)(t + 2) * kstep;
            const char* a3 = a2 + kstep; const char* b3 = b2 + kstep;
            PG8_LDB(B0, 0, 0); PG8_LDB(B1, 0, 1); PG8_SCHED; PG8_LDA(At, 0, 0); PG8_STAGE(PG8_SA(1, 1), a1 + hstepA, voffA);
            PG8_WAIT_V(8); PG8_WAIT_L(0); PG8_BAR; PG8_MMA(0, 0, At, B0); PG8_MMA(0, 1, At, B1); PG8_BAR; PG8_SCHED;
            PG8_LDA(At, 0, 1); PG8_STAGE(PG8_SB(0, 0), b2, voffB); PG8_STAGE(PG8_SB(0, 1), b2 + hstepB, voffB); PG8_STAGE(PG8_SA(0, 0), a2, voffA);
            PG8_WAIT_V(8); PG8_WAIT_L(0); PG8_BAR; PG8_MMA(1, 0, At, B0); PG8_MMA(1, 1, At, B1); PG8_BAR; PG8_SCHED;
            PG8_LDB(B0, 1, 0); PG8_LDB(B1, 1, 1); PG8_SCHED; PG8_LDA(At, 1, 0); PG8_STAGE(PG8_SA(0, 1), a2 + hstepA, voffA);
            PG8_WAIT_V(8); PG8_WAIT_L(0); PG8_BAR; PG8_MMA(0, 0, At, B0); PG8_MMA(0, 1, At, B1); PG8_BAR; PG8_SCHED;
            PG8_LDA(At, 1, 1); PG8_STAGE(PG8_SB(1, 0), b3, voffB); PG8_STAGE(PG8_SB(1, 1), b3 + hstepB, voffB); PG8_STAGE(PG8_SA(1, 0), a3, voffA);
            PG8_WAIT_V(8); PG8_WAIT_L(0); PG8_BAR; PG8_MMA(1, 0, At, B0); PG8_MMA(1, 1, At, B1); PG8_BAR; PG8_SCHED;
        }
        if constexpr (ALIGN_EPI) { if (wr == 0) PG8_BAR; }
        GSTAMP(1);
        if (cur.role == 2) {
            const __amdgpu_buffer_rsrc_t pr = __builtin_amdgcn_make_buffer_rsrc((void*)(pc.part + (size_t)cur.pidx * 65536), 0, 262144, 0x00020000);
            const unsigned pb = (unsigned)(wid * 2048 + lane) * 16u;
#pragma unroll
            for (int a = 0; a < 2; ++a)
#pragma unroll
                for (int b = 0; b < 2; ++b)
#pragma unroll
                    for (int m = 0; m < MR; ++m)
#pragma unroll
                        for (int n = 0; n < 2; ++n) __builtin_amdgcn_raw_buffer_store_b128(__builtin_bit_cast(u32x4, acc[a][b][m][n]), pr, pb + (unsigned)((((a * 2 + b) * 4 + m) * 2 + n) * 1024), 0, 16);
            asm volatile("s_waitcnt vmcnt(0)" ::: "memory"); PG8_BAR;
            if (tid == 0) __hip_atomic_store(pc.flags + 16 * cur.pidx, pc.epoch, __ATOMIC_RELAXED, __HIP_MEMORY_SCOPE_AGENT);
        } else {
            if (cur.role == 1) {
                if (wid == 0) { unsigned sp = 0; while (__hip_atomic_load(pc.flags + 16 * cur.pidx, __ATOMIC_RELAXED, __HIP_MEMORY_SCOPE_AGENT) != pc.epoch) { __builtin_amdgcn_s_sleep(2); if (++sp > (1u << 22)) break; }
                    __builtin_amdgcn_fence(__ATOMIC_ACQUIRE, "agent"); asm volatile("s_waitcnt vmcnt(0)" ::: "memory"); }
                PG8_BAR; asm volatile("" ::: "memory");
                const f32x4* ps = (const f32x4*)(pc.part + (size_t)cur.pidx * 65536) + wid * 2048 + lane;
#pragma unroll
                for (int a = 0; a < 2; ++a)
#pragma unroll
                    for (int b = 0; b < 2; ++b)
#pragma unroll
                        for (int m = 0; m < MR; ++m)
#pragma unroll
                            for (int n = 0; n < 2; ++n) acc[a][b][m][n] += ps[(((a * 2 + b) * 4 + m) * 2 + n) * 64];
            }
            E(acc, cur, wr, wc, fr, fq);
        }
        GSTAMP(2);
        if (!has_next) break;
#pragma unroll
        for (int a = 0; a < 2; ++a)
#pragma unroll
            for (int b = 0; b < 2; ++b)
#pragma unroll
                for (int m = 0; m < MR; ++m)
#pragma unroll
                    for (int n = 0; n < 2; ++n) acc[a][b][m][n] = (f32x4){0.f, 0.f, 0.f, 0.f};
        cur = nxt; cA = nA; cB = nB; ++ui;
        if constexpr (ALIGN_EPI) { if (wr == 1) PG8_BAR; }
    }
    PG8_WAIT_V(0);
    if constexpr (!ALIGN_EPI) { if (wr == 0) PG8_BAR; }
    PG8_BAR;
    GSTAMP(3);
#undef GSTAMP
#undef PG8_SA
#undef PG8_SB
#undef PG8_STAGE
#undef PG8_LDA
#undef PG8_LDB
#undef PG8_MMA
#undef PG8_WAIT_V
#undef PG8_WAIT_L
#undef PG8_BAR
#undef PG8_SCHED
#undef PG8_AOFF
}
}

constexpr size_t MiB = 1u << 20;
constexpr size_t WS_CTL = 0, CTL_ZERO_BYTES = 704 * 1024;
constexpr size_t WS_ROWSS = 64 * 1024;
constexpr size_t WS_SW = 160 * 1024;
constexpr size_t WS_MOD = 384 * 1024;
constexpr size_t WS_WIN = 2 * MiB;
constexpr size_t WS_WOUT = 28 * MiB;
constexpr size_t WS_WPOOL = 36 * MiB;
constexpr size_t WS_WM1 = 38 * MiB;
constexpr size_t WS_WM2 = 102 * MiB;
constexpr size_t WS_H = 166 * MiB;
constexpr size_t WS_ZB = 190 * MiB;
constexpr size_t WS_LF = 268 * MiB;
constexpr size_t WS_QN = 316 * MiB;
constexpr size_t WS_KP = 328 * MiB;
constexpr size_t WS_VP = 330 * MiB;
constexpr size_t WS_KS = 332 * MiB;
constexpr size_t WS_VS = 334 * MiB;
constexpr size_t WS_OF = 336 * MiB;
constexpr size_t WS_OB = 360 * MiB;
constexpr size_t WS_A2 = 384 * MiB;
constexpr size_t WS_XA = 408 * MiB;
constexpr size_t WS_U = 456 * MiB;
constexpr size_t WS_SEND = 552 * MiB;
constexpr size_t WS_LSEG = 560 * MiB;
constexpr size_t WS_PART = 562 * MiB;
constexpr size_t WS_END = 610 * MiB;
constexpr int CW_BAR = 1024;
constexpr int CW_FIN = 14464;
constexpr int CW_ADA1 = 14400;
constexpr int CW_PFLAG = 8192;

constexpr int RING_BYTES = 131072, LDSCTL_OFF = RING_BYTES, LDS_BYTES = 147456;
constexpr int NWAVES = 8;

#define RLX_AGENT __ATOMIC_RELAXED, __HIP_MEMORY_SCOPE_AGENT
#define LDS_WAIT() asm volatile("s_waitcnt lgkmcnt(0)" ::: "memory")
#define VM_WAIT() asm volatile("s_waitcnt vmcnt(0)" ::: "memory")

#define XB_TMO      128
#define XB_XCNT(j)  (256  + 64 * (j))
#define XB_XSUB(j)  (1280 + 64 * (j))
#define XB_XGEN(j)  (2304 + 64 * (j))
#define XB_TOP      3328
#define XB_TOPGEN   3392
#define XCD_BAR_WORDS 3456
#define XB_SPIN_CAP (1u << 18)
__device__ __forceinline__ unsigned xb_ld(unsigned* p)              { return __hip_atomic_load(p, __ATOMIC_RELAXED, __HIP_MEMORY_SCOPE_AGENT); }
__device__ __forceinline__ unsigned xb_add(unsigned* p, unsigned v) { return __hip_atomic_fetch_add(p, v, __ATOMIC_RELAXED, __HIP_MEMORY_SCOPE_AGENT); }
__device__ __forceinline__ unsigned xb_xcc_id() { return (unsigned)__builtin_amdgcn_s_getreg((3 << 11) | 20) & 0xFu; }
#define XB_SPIN(cond, bar) do { unsigned _sp = 0; while (cond) { __builtin_amdgcn_s_sleep(1); \
    if ((++_sp & 255u) == 0u) { if (xb_ld(&(bar)[XB_TMO])) break; if (_sp > XB_SPIN_CAP) { atomicAdd(&(bar)[XB_TMO], 1u); break; } } } } while (0)
struct XcdBarrier { unsigned* bar; unsigned x; volatile LAS unsigned* st; };
__device__ __forceinline__ XcdBarrier xcd_barrier_post(unsigned* bar, volatile LAS unsigned* st) {
    XcdBarrier b; b.bar = bar; b.x = xb_xcc_id(); b.st = st;
    if (threadIdx.x == 0) (void)xb_add(&bar[XB_XCNT(b.x)], 1u);
    return b;
}
__device__ __forceinline__ void xcd_barrier_complete(unsigned* bar, unsigned x, unsigned& nloc, unsigned& nx) {
    const unsigned G = gridDim.x * gridDim.y * gridDim.z;
    unsigned sum, cnt, mine, sp = 0u;
    for (;;) {
        sum = 0u; cnt = 0u; mine = 0u;
#pragma unroll
        for (unsigned j = 0; j < 16; ++j) { const unsigned c = xb_ld(&bar[XB_XCNT(j)]); sum += c; cnt += (c > 0u) ? 1u : 0u; mine = (j == x) ? c : mine; }
        if (sum == G) break;
        __builtin_amdgcn_s_sleep(1);
        if ((++sp & 255u) == 0u) { if (xb_ld(&bar[XB_TMO])) break; if (sp > XB_SPIN_CAP) { atomicAdd(&bar[XB_TMO], 1u); break; } }
    }
    nloc = mine > 0u ? mine : 1u; nx = cnt > 0u ? cnt : 1u;
}
__device__ __forceinline__ void xcd_barrier_a(const XcdBarrier& b) {
    asm volatile("s_waitcnt vmcnt(0)" ::: "memory");
    __syncthreads();
}
__device__ __forceinline__ void xcd_barrier_b(const XcdBarrier& b) {
    if (threadIdx.x == 0) {
        unsigned* bar = b.bar;
        __builtin_amdgcn_s_waitcnt(0);
        unsigned nloc = b.st[0], nx = b.st[1];
        if (nloc == 0u) { xcd_barrier_complete(bar, b.x, nloc, nx); b.st[0] = nloc; b.st[1] = nx; }
        const unsigned old = xb_add(&bar[XB_XSUB(b.x)], 1u);
        const unsigned gen = old / nloc;
        if (old + 1u == (gen + 1u) * nloc) {
            __builtin_amdgcn_fence(__ATOMIC_RELEASE, "agent");
            asm volatile("s_waitcnt vmcnt(0)" ::: "memory");
            const unsigned og = xb_add(&bar[XB_TOP], 1u);
            const unsigned tg = og / nx;
            if (og + 1u == (tg + 1u) * nx) xb_add(&bar[XB_TOPGEN], 1u);
            else XB_SPIN(xb_ld(&bar[XB_TOPGEN]) == tg, bar);
            __builtin_amdgcn_fence(__ATOMIC_ACQUIRE, "agent");
            xb_add(&bar[XB_XGEN(b.x)], 1u);
            asm volatile("s_waitcnt vmcnt(0)" ::: "memory");
        } else {
            XB_SPIN(xb_ld(&bar[XB_XGEN(b.x)]) == gen, bar);
            __builtin_amdgcn_fence(__ATOMIC_ACQUIRE, "agent");
            asm volatile("s_waitcnt vmcnt(0)" ::: "memory");
        }
    }
    asm volatile("s_waitcnt vmcnt(0)" ::: "memory");
    __syncthreads();
}
__device__ __forceinline__ void xcd_barrier(const XcdBarrier& b) { xcd_barrier_a(b); xcd_barrier_b(b); }


struct Args { const float* in[23]; float* out; unsigned char* ws; int ph_lo, ph_hi; };

__device__ __forceinline__ int cvec_of_row(int row) { return row < NTOK_P ? 0 : 1 + ((row - NTOK_P) >> 10); }
__device__ __forceinline__ const float* xin_row(const Args& a, int row) { return row < NTOK_P ? a.in[0] + (size_t)row * DM : a.in[1] + (size_t)(row - NTOK_P) * DM; }

struct EpiIn {
    static constexpr bool PERM = true;
    bf16_t* ZB; float* LF; const float* lb_raw;
    __device__ __forceinline__ void operator()(const f32x4 (&acc)[2][2][4][2], const pg8::Unit& u, int wr, int wc, int fr, int fq) const {
        const int row0 = u.pm * 256 + wr * 64 + fr, colt = u.pn * 256, cl = wc * 32 + 8 * fq;
        if (colt >= C_ZF && colt < C_HI) {
#pragma unroll
            for (int bj = 0; bj < 2; ++bj) {
                const int c2 = colt + bj * 128 + cl - C_ZF, dir = c2 >> 10, ch = c2 & 1023;
                float lb[8];
#pragma unroll
                for (int e = 0; e < 8; ++e) { const float x0 = lb_raw[dir * 3072 + ch + e], x1 = lb_raw[dir * 3072 + 1024 + ch + e], x2 = lb_raw[dir * 3072 + 2048 + ch + e];
                    lb[e] = 1.f / (1.f + __expf(x1 - x0) + __expf(x2 - x0)); }
#pragma unroll
                for (int ai = 0; ai < 2; ++ai)
#pragma unroll
                    for (int m = 0; m < 4; ++m) {
                        float* dst = LF + (size_t)(row0 + ai * 128 + m * 16) * 2048 + c2;
                        f32x4 o[2];
#pragma unroll
                        for (int n = 0; n < 2; ++n)
#pragma unroll
                            for (int e = 0; e < 4; ++e) { const float z = acc[ai][bj][m][n][e], sg = __builtin_amdgcn_rcpf(1.f + __expf(-z)), l = lb[n * 4 + e]; o[n][e] = __logf(l + (1.f - l) * sg); }
                        *(f32x4*)dst = o[0]; *(f32x4*)(dst + 4) = o[1];
                    }
            }
        } else {
            const bool act = (colt >= C_HQ && colt < C_ZF) || colt >= C_HG;
#pragma unroll
            for (int ai = 0; ai < 2; ++ai)
#pragma unroll
                for (int m = 0; m < 4; ++m) {
                    bf16_t* rowp = ZB + (size_t)(row0 + ai * 128 + m * 16) * IN_AB + colt + cl;
#pragma unroll
                    for (int bj = 0; bj < 2; ++bj) { f32x4 v0 = acc[ai][bj][m][0], v1 = acc[ai][bj][m][1];
                        if (act) {
#pragma unroll
                            for (int e = 0; e < 4; ++e) { v0[e] = siluf(v0[e]); v1[e] = siluf(v1[e]); } }
                        u32x4 w; w.x = cvtpk(v0[0], v0[1]); w.y = cvtpk(v0[2], v0[3]); w.z = cvtpk(v1[0], v1[1]); w.w = cvtpk(v1[2], v1[3]);
                        *(u32x4*)(rowp + bj * 128) = w; }
                }
        }
    }
};
template <int MR, bool BIN = false, bool OUTB = false> struct EpiRes {
    static constexpr bool PERM = true;
    static constexpr int RG = (MR == 3) ? 3 : 2, GR = BIN ? RG : 2 * RG, NG = 2 * 2 * MR / RG;
    const float* baseP; const float* baseS; float* out; const float* gate; const float* pscale;
    bf16_t* XG; const float* ngain; const float* nsc;
    float* rowss;
    static __device__ __forceinline__ constexpr int g_bj(int q) { return MR == 3 ? (q >> 1) : (q >> 2); }
    static __device__ __forceinline__ constexpr int g_ai(int q) { return MR == 3 ? (q & 1) : ((q >> 1) & 1); }
    static __device__ __forceinline__ constexpr int g_m(int q, int r) { return MR == 3 ? r : 2 * (q & 1) + r; }
    __device__ __forceinline__ void operator()(const f32x4 (&acc)[2][2][MR][2], const pg8::Unit& u, int wr, int wc, int fr, int fq) const {
        const int ucol = u.pn * 256 + wc * 32;
        const int R0 = u.pm * (64 * MR) + wr * (16 * MR);
        const unsigned lv = (unsigned)(fr * DM + 8 * fq) * 4u, lv2 = (unsigned)(fr * DM + 8 * fq) * 2u, lq = (unsigned)fq * 32u;
        float ss[2][MR];
#pragma unroll
        for (int ai = 0; ai < 2; ++ai)
#pragma unroll
            for (int m = 0; m < MR; ++m) ss[ai][m] = 0.f;
        u32x4 bcur[GR], bnxt[GR];
#define ER_ROW2(ai, m) (R0 + (ai) * (32 * MR) + (m) * 16)
#define ER_BASE(R) ((const char*)((R) < NTOK_P ? baseP + (size_t)(R) * DM : baseS + (size_t)((R) - NTOK_P) * DM))
#define ER_LOAD(dst, q) do { _Pragma("unroll") for (int r = 0; r < RG; ++r) { \
            if constexpr (BIN) { dst[r] = *(const u32x4*)((const char*)baseP + ((size_t)ER_ROW2(g_ai(q), g_m(q, r)) * DM + ucol + g_bj(q) * 128) * 2 + lv2); } \
            else { const char* p_ = ER_BASE(ER_ROW2(g_ai(q), g_m(q, r))) + (size_t)(ucol + g_bj(q) * 128) * 4 + lv; dst[BIN ? 0 : 2 * r] = *(const u32x4*)p_; dst[BIN ? 0 : 2 * r + 1] = *(const u32x4*)(p_ + 16); } } } while (0)
        ER_LOAD(bcur, 0);
        const int cvA = cvec_of_row(u.pm * (64 * MR)), cvB = cvec_of_row(u.pm * (64 * MR) + 64 * MR - 1); const bool uni = cvA == cvB;
        f32x4 g4u[2] = {{0.f, 0.f, 0.f, 0.f}, {0.f, 0.f, 0.f, 0.f}}, gmu[2] = {{0.f, 0.f, 0.f, 0.f}, {0.f, 0.f, 0.f, 0.f}};
#define ER_GATES(G4, GM, cv_) do { const char* gq_ = (const char*)(gate + (size_t)(cv_) * 2 * NMODC + cu) + lq; G4[0] = *(const f32x4*)gq_; G4[1] = *(const f32x4*)(gq_ + 16); \
            if (pscale) { const char* pq_ = (const char*)(pscale + cu) + lq; G4[0] = G4[0] * *(const f32x4*)pq_; G4[1] = G4[1] * *(const f32x4*)(pq_ + 16); } \
            if (XG) { const char* nq_ = (const char*)(ngain + cu) + lq; const char* sq_ = (const char*)(nsc + (size_t)(cv_) * 2 * NMODC + cu) + lq; \
                GM[0] = *(const f32x4*)nq_ * (*(const f32x4*)sq_ + 1.f); GM[1] = *(const f32x4*)(nq_ + 16) * (*(const f32x4*)(sq_ + 16) + 1.f); } } while (0)
#pragma unroll
        for (int q = 0; q < NG; ++q) {
            const int bj = g_bj(q), ai = g_ai(q), cu = ucol + bj * 128;
            if (uni && (q == 0 || g_bj(q) != g_bj(q > 0 ? q - 1 : 0))) ER_GATES(g4u, gmu, cvA);
            if (q < NG - 1) ER_LOAD(bnxt, q + 1);
            asm volatile("" ::: "memory");
#pragma unroll
            for (int r = 0; r < RG; ++r) {
                const int m = g_m(q, r), R = ER_ROW2(ai, m);
                f32x4 g4[2] = {g4u[0], g4u[1]}, gm[2] = {gmu[0], gmu[1]};
                if (!uni) ER_GATES(g4, gm, cvec_of_row(R));
                f32x4 b0, b1;
                if constexpr (BIN) { const u32x4 bw = bcur[r]; b0 = (f32x4){bflo(bw.x), bfhi(bw.x), bflo(bw.y), bfhi(bw.y)}; b1 = (f32x4){bflo(bw.z), bfhi(bw.z), bflo(bw.w), bfhi(bw.w)}; }
                else { b0 = __builtin_bit_cast(f32x4, bcur[BIN ? 0 : 2 * r]); b1 = __builtin_bit_cast(f32x4, bcur[BIN ? 0 : 2 * r + 1]); }
                const f32x4 x0 = b0 + g4[0] * acc[ai][bj][m][0], x1 = b1 + g4[1] * acc[ai][bj][m][1];
                if constexpr (OUTB) { u32x4 wo; wo.x = cvtpk(x0.x, x0.y); wo.y = cvtpk(x0.z, x0.w); wo.z = cvtpk(x1.x, x1.y); wo.w = cvtpk(x1.z, x1.w); *(u32x4*)((char*)((bf16_t*)out + (size_t)R * DM + cu) + lv2) = wo; }
                else { char* op_ = (char*)(out + (size_t)R * DM + cu) + lv; *(f32x4*)op_ = x0; *(f32x4*)(op_ + 16) = x1; }
                ss[ai][m] += ((x0.x * x0.x + x0.y * x0.y) + (x0.z * x0.z + x0.w * x0.w)) + ((x1.x * x1.x + x1.y * x1.y) + (x1.z * x1.z + x1.w * x1.w));
                if (XG) { const f32x4 y0 = x0 * gm[0], y1 = x1 * gm[1]; u32x4 w; w.x = cvtpk(y0.x, y0.y); w.y = cvtpk(y0.z, y0.w); w.z = cvtpk(y1.x, y1.y); w.w = cvtpk(y1.z, y1.w);
                    *(u32x4*)((char*)(XG + (size_t)R * DM + cu) + lv2) = w; } }
            asm volatile("" ::: "memory");
#pragma unroll
            for (int r = 0; r < GR; ++r) bcur[r] = bnxt[r];
        }
#undef ER_GATES
#undef ER_LOAD
#undef ER_BASE
#pragma unroll
        for (int ai = 0; ai < 2; ++ai)
#pragma unroll
            for (int m = 0; m < MR; ++m) { float s = ss[ai][m]; s += __shfl_xor(s, 16); s += __shfl_xor(s, 32);
                if (fq == 0) atomicAdd(rowss + ER_ROW2(ai, m) + fr, s); }
#undef ER_ROW2
    }
};
struct EpiFinal {
    static constexpr bool PERM = true;
    const float* baseP; const float* baseS; float* out; const float* gate; const float* fgain; float* rowss; unsigned* pcnt;
    __device__ __forceinline__ void operator()(const f32x4 (&acc)[2][2][3][2], const pg8::Unit& u, int wr, int wc, int fr, int fq) const {
        const int ucol = u.pn * 256 + wc * 32, R0 = u.pm * 192 + wr * 48;
        unsigned lv = (unsigned)(fr * DM + 8 * fq) * 4u, lq = (unsigned)fq * 32u;
        asm volatile("" : "+v"(lv), "+v"(lq));
        const int cvA = cvec_of_row(u.pm * 192), cvB = cvec_of_row(u.pm * 192 + 191);
        f32x4 bcur[6], bnxt[6];
#define EF_ROW(ai, m) (R0 + (ai) * 96 + (m) * 16)
#define EF_BASE(R) ((const char*)((R) < NTOK_P ? baseP + (size_t)(R) * DM : baseS + (size_t)((R) - NTOK_P) * DM))
#define EF_LOAD(dst, q) do { _Pragma("unroll") for (int r = 0; r < 3; ++r) { const char* p_ = EF_BASE(EF_ROW((q) & 1, r)) + (size_t)(ucol + ((q) >> 1) * 128) * 4 + lv; \
            dst[2 * r] = *(const f32x4*)p_; dst[2 * r + 1] = *(const f32x4*)(p_ + 16); } } while (0)
#define EF_GATES(G4, cv_) do { const char* gq_ = (const char*)(gate + (size_t)(cv_) * 2 * NMODC + cu) + lq; G4[0] = *(const f32x4*)gq_; G4[1] = *(const f32x4*)(gq_ + 16); } while (0)
        {
            float ss[2][3];
#pragma unroll
            for (int ai = 0; ai < 2; ++ai)
#pragma unroll
                for (int m = 0; m < 3; ++m) ss[ai][m] = 0.f;
            EF_LOAD(bcur, 0);
            f32x4 gA[2] = {{0.f, 0.f, 0.f, 0.f}, {0.f, 0.f, 0.f, 0.f}}, gB[2] = {{0.f, 0.f, 0.f, 0.f}, {0.f, 0.f, 0.f, 0.f}};
#pragma unroll
            for (int q = 0; q < 4; ++q) {
                const int bj = q >> 1, ai = q & 1, cu = ucol + bj * 128;
                if (q == 0 || q == 2) { EF_GATES(gA, cvA); EF_GATES(gB, cvB); }
                if (q < 3) EF_LOAD(bnxt, q + 1);
                asm volatile("" ::: "memory");
#pragma unroll
                for (int r = 0; r < 3; ++r) {
                    const bool useB = cvec_of_row(EF_ROW(ai, r)) != cvA;
                    const f32x4 g4[2] = {useB ? gB[0] : gA[0], useB ? gB[1] : gA[1]};
                    const f32x4 x0 = bcur[2 * r] + g4[0] * acc[ai][bj][r][0], x1 = bcur[2 * r + 1] + g4[1] * acc[ai][bj][r][1];
                    ss[ai][r] += ((x0.x * x0.x + x0.y * x0.y) + (x0.z * x0.z + x0.w * x0.w)) + ((x1.x * x1.x + x1.y * x1.y) + (x1.z * x1.z + x1.w * x1.w)); }
                asm volatile("" ::: "memory");
#pragma unroll
                for (int r = 0; r < 6; ++r) bcur[r] = bnxt[r];
            }
#pragma unroll
            for (int ai = 0; ai < 2; ++ai)
#pragma unroll
                for (int m = 0; m < 3; ++m) { float s = ss[ai][m]; s += __shfl_xor(s, 16); s += __shfl_xor(s, 32);
                    if (fq == 0) atomicAdd(rowss + EF_ROW(ai, m) + fr, s); }
        }
        EF_LOAD(bcur, 0);
        asm volatile("s_waitcnt vmcnt(6)" ::: "memory"); __builtin_amdgcn_s_barrier();
        if (threadIdx.x == 0) { unsigned* c = pcnt + 16 * u.pm;
            __builtin_amdgcn_fence(__ATOMIC_RELEASE, "agent"); asm volatile("s_waitcnt vmcnt(0)" ::: "memory"); __hip_atomic_fetch_add(c, 1u, __ATOMIC_RELAXED, __HIP_MEMORY_SCOPE_AGENT);
            unsigned sp = 0; while (__hip_atomic_load(c, __ATOMIC_RELAXED, __HIP_MEMORY_SCOPE_AGENT) < 8u) { __builtin_amdgcn_s_sleep(1); if (++sp > (1u << 22)) break; }
            __builtin_amdgcn_fence(__ATOMIC_ACQUIRE, "agent"); asm volatile("s_waitcnt vmcnt(0)" ::: "memory"); }
        __builtin_amdgcn_s_barrier(); asm volatile("" : "+v"(lv), "+v"(lq) :: "memory");
        {
            float rs[2][3];
#pragma unroll
            for (int ai = 0; ai < 2; ++ai)
#pragma unroll
                for (int m = 0; m < 3; ++m) rs[ai][m] = rsqrtf(__hip_atomic_load(rowss + EF_ROW(ai, m) + fr, __ATOMIC_RELAXED, __HIP_MEMORY_SCOPE_AGENT) * (1.f / DM) + EPS);
            f32x4 gA[2] = {{0.f, 0.f, 0.f, 0.f}, {0.f, 0.f, 0.f, 0.f}}, gB[2] = {{0.f, 0.f, 0.f, 0.f}, {0.f, 0.f, 0.f, 0.f}}, fg[2] = {{0.f, 0.f, 0.f, 0.f}, {0.f, 0.f, 0.f, 0.f}};
#pragma unroll
            for (int q = 0; q < 4; ++q) {
                const int bj = q >> 1, ai = q & 1, cu = ucol + bj * 128;
                if (q == 0 || q == 2) { EF_GATES(gA, cvA); EF_GATES(gB, cvB); const char* fp_ = (const char*)(fgain + cu) + lq; fg[0] = *(const f32x4*)fp_; fg[1] = *(const f32x4*)(fp_ + 16); }
                if (q < 3) EF_LOAD(bnxt, q + 1);
                asm volatile("" ::: "memory");
#pragma unroll
                for (int r = 0; r < 3; ++r) {
                    const int R = EF_ROW(ai, r);
                    const bool useB = cvec_of_row(R) != cvA;
                    const f32x4 g4[2] = {useB ? gB[0] : gA[0], useB ? gB[1] : gA[1]};
                    const f32x4 x0 = bcur[2 * r] + g4[0] * acc[ai][bj][r][0], x1 = bcur[2 * r + 1] + g4[1] * acc[ai][bj][r][1];
                    char* op_ = (char*)(out + (size_t)R * DM + cu) + lv;
                    __builtin_nontemporal_store(x0 * rs[ai][r] * fg[0], (f32x4*)op_); __builtin_nontemporal_store(x1 * rs[ai][r] * fg[1], (f32x4*)(op_ + 16)); }
                asm volatile("" ::: "memory");
#pragma unroll
                for (int r = 0; r < 6; ++r) bcur[r] = bnxt[r];
            }
        }
#undef EF_GATES
#undef EF_LOAD
#undef EF_BASE
#undef EF_ROW
    }
};
struct EpiRelu2 {
    static constexpr bool PERM = true;
    bf16_t* U; const float* rowss; const float* sW;
    __device__ __forceinline__ void operator()(const f32x4 (&acc)[2][2][4][2], const pg8::Unit& u, int wr, int wc, int fr, int fq) const {
        const int row0 = u.pm * 256 + wr * 64 + fr, col0 = u.pn * 256 + wc * 32 + 8 * fq;
        const int cv = u.pm < 16 ? 0 : 1 + ((u.pm - 16) >> 2);
        f32x4 sw[2][2];
#pragma unroll
        for (int bj = 0; bj < 2; ++bj)
#pragma unroll
            for (int n = 0; n < 2; ++n) sw[bj][n] = *(const f32x4*)(sW + (size_t)cv * DFF + col0 + bj * 128 + 4 * n);
#pragma unroll
        for (int ai = 0; ai < 2; ++ai)
#pragma unroll
            for (int m = 0; m < 4; ++m) { const int row = row0 + ai * 128 + m * 16; bf16_t* rowp = U + (size_t)row * DFF + col0;
                const float rs = rsqrtf(rowss[row] * (1.f / DM) + EPS);
#pragma unroll
                for (int bj = 0; bj < 2; ++bj) { f32x4 v0 = acc[ai][bj][m][0] * rs + sw[bj][0], v1 = acc[ai][bj][m][1] * rs + sw[bj][1];
#pragma unroll
                    for (int e = 0; e < 4; ++e) { const float a = fmaxf(v0[e], 0.f), b = fmaxf(v1[e], 0.f); v0[e] = a * a; v1[e] = b * b; }
                    u32x4 w; w.x = cvtpk(v0[0], v0[1]); w.y = cvtpk(v0[2], v0[3]); w.z = cvtpk(v1[0], v1[1]); w.w = cvtpk(v1[2], v1[3]);
                    *(u32x4*)(rowp + bj * 128) = w; } }
    }
};

struct TrDesc { const float* W; bf16_t* WT; const float* shp; float* sWp; int K, N, row_off, item; };
__device__ __forceinline__ void tr_load(const TrDesc& d, f32x4 (&v)[8], int lane) {
    const int nblk = d.N / 32, kb = d.item / nblk, nb = d.item % nblk, k0 = 64 * kb, n0 = 32 * nb;
    const float* p = d.W + (size_t)(k0 + (lane >> 3)) * d.N + n0 + 4 * (lane & 7);
#pragma unroll
    for (int i = 0; i < 8; ++i) v[i] = __builtin_nontemporal_load((const f32x4*)(p + (size_t)(8 * i) * d.N));
}
__device__ __forceinline__ void tr_lds_write(const f32x4 (&v)[8], LAS float* scr, int lane) {
#pragma unroll
    for (int i = 0; i < 8; ++i) *(LAS f32x4*)(scr + (8 * i + (lane >> 3)) * 32 + ((4 * (lane & 7)) ^ (4 * i))) = v[i];
}
__device__ __forceinline__ void tr_finish(const TrDesc& d, LAS float* scr, int lane) {
    const int nblk = d.N / 32, kb = d.item / nblk, nb = d.item % nblk, k0 = 64 * kb, n0 = 32 * nb;
    if (d.shp) {
        const float h0 = d.shp[k0 + lane], h1 = d.shp[2 * NMODC + k0 + lane], h2 = d.shp[4 * NMODC + k0 + lane];
        float s0 = 0.f, s1 = 0.f, s2 = 0.f; const int n = lane & 31;
#pragma unroll 4
        for (int k = 0; k < 64; ++k) { const float w = scr[k * 32 + (n ^ (4 * ((k >> 3) & 7)))];
            s0 += w * __builtin_bit_cast(float, __builtin_amdgcn_readlane(__builtin_bit_cast(int, h0), k));
            s1 += w * __builtin_bit_cast(float, __builtin_amdgcn_readlane(__builtin_bit_cast(int, h1), k));
            s2 += w * __builtin_bit_cast(float, __builtin_amdgcn_readlane(__builtin_bit_cast(int, h2), k)); }
        if (lane < 32) { atomicAdd(d.sWp + n0 + n, s0); atomicAdd(d.sWp + DFF + n0 + n, s1); atomicAdd(d.sWp + 2 * DFF + n0 + n, s2); }
    }
    const int c = lane & 7;
#pragma unroll
    for (int j = 0; j < 4; ++j) { const int n = (lane >> 3) + 8 * j; const LAS float* s = scr + (8 * c) * 32 + (n ^ (4 * c));
        u32x4 o; o.x = cvtpk(s[0 * 32], s[1 * 32]); o.y = cvtpk(s[2 * 32], s[3 * 32]); o.z = cvtpk(s[4 * 32], s[5 * 32]); o.w = cvtpk(s[6 * 32], s[7 * 32]);
        *(u32x4*)(d.WT + (size_t)(d.row_off + n0 + n) * d.K + k0 + 8 * c) = o; }
}
__device__ __forceinline__ void p0_ada_item(const Args& a, LAS unsigned char* lds, int wi, int tid) {
    LAS float* sc = (LAS float*)lds;
    LAS float* part = (LAS float*)(lds + 24576);
    const int l = wi / 192, c0 = 64 * (wi % 192), cq = tid & 15, rs = tid >> 4;
    for (int i = tid; i < 3 * 2048; i += NWAVES * 64) { const int v = i >> 11, k = i & 2047; const float x = v == 0 ? a.in[7][k] : a.in[6][(v - 1) * 2048 + k]; sc[i] = siluf(x); }
    __syncthreads();
    {
        f32x4 a0 = {0.f, 0.f, 0.f, 0.f}, a1 = a0, a2 = a0;
        const float* wp = a.in[8] + ((size_t)l * 2048 + rs) * NMODC + c0 + 4 * cq;
        f32x4 wA[8], wB[8];
#define ADA_LD(dst, b) do { _Pragma("unroll") for (int r_ = 0; r_ < 8; ++r_) dst[r_] = __builtin_nontemporal_load((const f32x4*)(wp + (size_t)(((b) * 8 + r_) * 32) * NMODC)); } while (0)
#define ADA_FMA(srcv, b) do { _Pragma("unroll") for (int r_ = 0; r_ < 8; ++r_) { const int k = rs + 32 * ((b) * 8 + r_); a0 += srcv[r_] * sc[k]; a1 += srcv[r_] * sc[2048 + k]; a2 += srcv[r_] * sc[4096 + k]; } } while (0)
        ADA_LD(wA, 0); ADA_LD(wB, 1); asm volatile("" ::: "memory");
        ADA_FMA(wA, 0); ADA_LD(wA, 2); asm volatile("" ::: "memory");
        ADA_FMA(wB, 1); ADA_LD(wB, 3); asm volatile("" ::: "memory");
        ADA_FMA(wA, 2); ADA_LD(wA, 4); asm volatile("" ::: "memory");
        ADA_FMA(wB, 3); ADA_LD(wB, 5); asm volatile("" ::: "memory");
        ADA_FMA(wA, 4); ADA_LD(wA, 6); asm volatile("" ::: "memory");
        ADA_FMA(wB, 5); ADA_LD(wB, 7); asm volatile("" ::: "memory");
        ADA_FMA(wA, 6); ADA_FMA(wB, 7);
#undef ADA_LD
#undef ADA_FMA
        *(LAS f32x4*)(part + (rs * 3 + 0) * 64 + 4 * cq) = a0; *(LAS f32x4*)(part + (rs * 3 + 1) * 64 + 4 * cq) = a1; *(LAS f32x4*)(part + (rs * 3 + 2) * 64 + 4 * cq) = a2;
    }
    __syncthreads();
    if (tid < 192) { const int v = tid >> 6, c = tid & 63; float s = a.in[9][l * NMODC + c0 + c];
#pragma unroll 8
        for (int r = 0; r < 32; ++r) s += part[(r * 3 + v) * 64 + c];
        ((float*)(a.ws + WS_MOD))[(size_t)v * 2 * NMODC + l * NMODC + c0 + c] = s; }
    __syncthreads();
}
constexpr int P0_NOADA = 5248;
constexpr int I_IN = 32 * 208, I_OUT = 32 * 64, I_POOL = 8 * 16, I_M1 = 32 * 256, I_M2 = 128 * 64;
constexpr int R_IN = 0, R_OUT = R_IN + I_IN, R_M1_0 = R_OUT + I_OUT, R_M2_0 = R_M1_0 + I_M1, R_POOL = R_M2_0 + I_M2, R_M1_1 = R_POOL + 4 * I_POOL, R_M2_1 = R_M1_1 + I_M1, R_END = R_M2_1 + I_M2;
__device__ __forceinline__ TrDesc tr_desc(const Args& a, int it) {
    unsigned char* ws = a.ws;
    const float* MOD = (const float*)(ws + WS_MOD); float* SW = (float*)(ws + WS_SW);
    TrDesc d; d.shp = nullptr; d.sWp = nullptr; d.row_off = 0;
    if (it < R_OUT) { d.W = a.in[12]; d.K = 2048; d.N = IN_AB; d.WT = (bf16_t*)(ws + WS_WIN); d.item = it - R_IN; }
    else if (it < R_M1_0) { d.W = a.in[13]; d.K = 2048; d.N = 2048; d.WT = (bf16_t*)(ws + WS_WOUT); d.item = it - R_OUT; }
    else if (it < R_M2_0) { d.W = a.in[20]; d.K = 2048; d.N = DFF; d.WT = (bf16_t*)(ws + WS_WM1); d.item = it - R_M1_0; d.shp = MOD + 3 * 2048; d.sWp = SW; }
    else if (it < R_POOL) { d.W = a.in[21]; d.K = DFF; d.N = 2048; d.WT = (bf16_t*)(ws + WS_WM2); d.item = it - R_M2_0; }
    else if (it < R_M1_1) { const int r = it - R_POOL, g = r / I_POOL; d.W = a.in[18] + (size_t)g * 512 * 512; d.K = 512; d.N = 512; d.WT = (bf16_t*)(ws + WS_WPOOL); d.row_off = g * 512; d.item = r % I_POOL; }
    else if (it < R_M2_1) { d.W = a.in[20] + (size_t)2048 * DFF; d.K = 2048; d.N = DFF; d.WT = (bf16_t*)(ws + WS_WM1) + (size_t)DFF * 2048; d.item = it - R_M1_1; d.shp = MOD + NMODC + 3 * 2048; d.sWp = SW + 3 * DFF; }
    else { d.W = a.in[21] + (size_t)DFF * 2048; d.K = DFF; d.N = 2048; d.WT = (bf16_t*)(ws + WS_WM2) + (size_t)2048 * DFF; d.item = it - R_M2_1; }
    return d;
}
__device__ __forceinline__ void bg_transposes(const Args& a, LAS unsigned char* lds, int lo, int hi, int w, int nw, int wave, int lane) {
    LAS float* scr = (LAS float*)(lds + wave * 16384);
    int it = lo + w; if (it >= hi) return;
    f32x4 v[8];
    TrDesc d = tr_desc(a, it); tr_load(d, v, lane);
    for (;;) {
        tr_lds_write(v, scr, lane);
        const int itn = it + nw; const bool more = itn < hi;
        TrDesc dn = d;
        if (more) { dn = tr_desc(a, itn); tr_load(dn, v, lane); }
        LDS_WAIT(); asm volatile("" ::: "memory");
        tr_finish(d, scr, lane);
        LDS_WAIT(); asm volatile("" ::: "memory");
        if (!more) break;
        d = dn; it = itn;
    }
}

__device__ __forceinline__ void norm_rows_bf16(const Args& a, const float* xa  , const float* gain, int layer, int soff, bf16_t* H, int gw, int ngw, int lane) {
    const float* mod = (const float*)(a.ws + WS_MOD);
    for (int row0 = gw; row0 < NTOK; row0 += 2 * ngw) {
        const int row1 = row0 + ngw; const bool has1 = row1 < NTOK; const int r1 = has1 ? row1 : row0;
        const float* x0 = xa ? xa + (size_t)row0 * DM : xin_row(a, row0);
        const float* x1 = xa ? xa + (size_t)r1 * DM : xin_row(a, r1);
        f32x4 v0[8], v1[8]; float ss0 = 0.f, ss1 = 0.f;
#pragma unroll
        for (int j = 0; j < 8; ++j) { v0[j] = *(const f32x4*)(x0 + 4 * (lane + 64 * j)); v1[j] = *(const f32x4*)(x1 + 4 * (lane + 64 * j)); }
#pragma unroll
        for (int j = 0; j < 8; ++j) { ss0 += v0[j].x * v0[j].x + v0[j].y * v0[j].y + v0[j].z * v0[j].z + v0[j].w * v0[j].w; ss1 += v1[j].x * v1[j].x + v1[j].y * v1[j].y + v1[j].z * v1[j].z + v1[j].w * v1[j].w; }
        const float rstd0 = rsqrtf(wave_sum(ss0) * (1.f / DM) + EPS), rstd1 = rsqrtf(wave_sum(ss1) * (1.f / DM) + EPS);
        const float* mp0 = mod + (size_t)cvec_of_row(row0) * 2 * NMODC + layer * NMODC + soff;
        const float* mp1 = mod + (size_t)cvec_of_row(r1) * 2 * NMODC + layer * NMODC + soff;
#pragma unroll
        for (int j = 0; j < 8; ++j) { const int c = 4 * (lane + 64 * j);
            const f32x4 g = *(const f32x4*)(gain + c);
            { const f32x4 sh = *(const f32x4*)(mp0 + c), sc = *(const f32x4*)(mp0 + 2048 + c); const f32x4 y = v0[j] * rstd0 * g * (sc + 1.f) + sh;
              u32x2 w; w.x = cvtpk(y.x, y.y); w.y = cvtpk(y.z, y.w); *(u32x2*)(H + (size_t)row0 * DM + c) = w; }
            if (has1) { const f32x4 sh = *(const f32x4*)(mp1 + c), sc = *(const f32x4*)(mp1 + 2048 + c); const f32x4 y = v1[j] * rstd1 * g * (sc + 1.f) + sh;
              u32x2 w; w.x = cvtpk(y.x, y.y); w.y = cvtpk(y.z, y.w); *(u32x2*)(H + (size_t)row1 * DM + c) = w; } }
    }
}
__device__ __forceinline__ void norm1_load(const Args& a, f32x4 (&v)[3][8], int bx, int wave, int lane) {
#pragma unroll
    for (int i = 0; i < 3; ++i) { const float* xp = xin_row(a, 24 * bx + 3 * wave + i);
#pragma unroll
        for (int j = 0; j < 8; ++j) v[i][j] = *(const f32x4*)(xp + 4 * (lane + 64 * j)); }
}
__device__ __forceinline__ void norm1_finish(const Args& a, const f32x4 (&v)[3][8], const float* gain, bf16_t* H, int bx, int wave, int lane) {
    const float* mod = (const float*)(a.ws + WS_MOD);
#pragma unroll
    for (int i = 0; i < 3; ++i) { const int row = 24 * bx + 3 * wave + i; float ss = 0.f;
#pragma unroll
        for (int j = 0; j < 8; ++j) ss += v[i][j].x * v[i][j].x + v[i][j].y * v[i][j].y + v[i][j].z * v[i][j].z + v[i][j].w * v[i][j].w;
        const float rstd = rsqrtf(wave_sum(ss) * (1.f / DM) + EPS);
        const float* mp = mod + (size_t)cvec_of_row(row) * 2 * NMODC;
#pragma unroll
        for (int j = 0; j < 8; ++j) { const int c = 4 * (lane + 64 * j);
            const f32x4 g = *(const f32x4*)(gain + c), sh = *(const f32x4*)(mp + c), sc = *(const f32x4*)(mp + 2048 + c);
            const f32x4 y = v[i][j] * rstd * g * (sc + 1.f) + sh;
            u32x2 w; w.x = cvtpk(y.x, y.y); w.y = cvtpk(y.z, y.w); *(u32x2*)(H + (size_t)row * DM + c) = w; } }
}
__device__ __forceinline__ void norm_rows_f32(const Args& a, const float* xa, const float* gain, int layer, int soff  , float* O, int gw, int ngw, int lane) {
    const float* mod = (const float*)(a.ws + WS_MOD);
    for (int row = gw; row < NTOK; row += ngw) {
        const float* xr = xa + (size_t)row * DM;
        const float* mp = mod + (size_t)cvec_of_row(row) * 2 * NMODC + layer * NMODC + (soff < 0 ? 0 : soff);
        f32x4 v[8]; float ss = 0.f;
#pragma unroll
        for (int j = 0; j < 8; ++j) { v[j] = *(const f32x4*)(xr + 4 * (lane + 64 * j)); ss += v[j].x * v[j].x + v[j].y * v[j].y + v[j].z * v[j].z + v[j].w * v[j].w; }
        const float rstd = rsqrtf(wave_sum(ss) * (1.f / DM) + EPS);
#pragma unroll
        for (int j = 0; j < 8; ++j) { const int c = 4 * (lane + 64 * j);
            const f32x4 g = *(const f32x4*)(gain + c);
            f32x4 y = v[j] * rstd * g;
            if (soff >= 0) { const f32x4 sh = *(const f32x4*)(mp + c), sc = *(const f32x4*)(mp + 2048 + c); y = y * (sc + 1.f) + sh; }
            *(f32x4*)(O + (size_t)row * DM + c) = y; }
    }
}
template <int HW> __device__ __forceinline__ void pool_out(const LAS float* T, bf16_t* P, int row0, int t0, int Tseq, int cb, int tid) {
    const int cq = tid & 63, tgp = tid >> 6;
    f32x4 s = {0.f, 0.f, 0.f, 0.f};
    { const int t = t0 + tgp * 8;
#pragma unroll
      for (int d = -HW; d < HW; ++d) { const int u = t + d; const f32x4 v = *(const LAS f32x4*)(T + (tgp * 8 + 8 + d) * 256 + cq * 4); if (u >= 0 && u < Tseq) s += v; } }
#pragma unroll
    for (int j = 0; j < 8; ++j) { const int tl = tgp * 8 + j, t = t0 + tl;
        if (j > 0) { const int uo = t - 1 - HW, un = t + HW - 1;
            const f32x4 vo = *(const LAS f32x4*)(T + (tl + 8 - 1 - HW) * 256 + cq * 4), vn = *(const LAS f32x4*)(T + (tl + 8 + HW - 1) * 256 + cq * 4);
            if (uo >= 0 && uo < Tseq) s -= vo;
            if (un >= 0 && un < Tseq) s += vn; }
        const int lo = max(t - HW, 0), hi = min(t + HW, Tseq);
        const f32x4 x = *(const LAS f32x4*)(T + (tl + 8) * 256 + cq * 4);
        const f32x4 y = s * (1.f / (float)(hi - lo)) - x;
        u32x2 w; w.x = cvtpk(y.x, y.y); w.y = cvtpk(y.z, y.w);
        *(u32x2*)(P + (size_t)(row0 + tl) * DM + cb * 256 + cq * 4) = w; }
}
struct PoolItem { int row0, cb, s0, Tseq, t0; };
__device__ __forceinline__ PoolItem pool_item(int item) {
    PoolItem p; const int tt = item >> 3; p.cb = ((item & 7) + 3 * (item >> 8)) & 7; p.row0 = tt * 64;
    if (p.row0 < NTOK_P) { p.s0 = p.row0 & ~255; p.Tseq = SEQ_P; } else { p.s0 = NTOK_P + ((p.row0 - NTOK_P) & ~1023); p.Tseq = SEQ_S; }
    p.t0 = p.row0 - p.s0; return p;
}
__device__ __forceinline__ void pool_load(const PoolItem& p, const float* XA, const float* rowss, f32x4 (&xr)[10], float (&rs)[10], int wave, int lane) {
    const int c = p.cb * 256 + lane * 4;
#pragma unroll
    for (int i = 0; i < 10; ++i) { const int t = p.t0 - 8 + wave + 8 * i; const bool ok = t >= 0 && t < p.Tseq; const int row = p.s0 + (ok ? t : p.t0);
        xr[i] = *(const f32x4*)(XA + (size_t)row * DM + c); rs[i] = rowss[row]; }
}
__device__ __forceinline__ void pool_phase(const Args& a, LAS unsigned char* lds, const float* XA, const float* rowss, bf16_t* P, int bx, int G, int tid) {
    LAS float* T = (LAS float*)lds;
    const float* MOD = (const float*)(a.ws + WS_MOD);
    const int lane = tid & 63, wave = tid >> 6;
    int item = bx; if (item >= 768) return;
    f32x4 xr[10]; float rs[10];
    PoolItem p = pool_item(item); pool_load(p, XA, rowss, xr, rs, wave, lane);
    for (;;) {
        const int c = p.cb * 256 + lane * 4, g = p.cb >> 1;
        const float* mp = MOD + (size_t)cvec_of_row(p.row0) * 2 * NMODC + NMODC;
        const f32x4 gmul = *(const f32x4*)(a.in[10] + 2048 + c) * (*(const f32x4*)(mp + 2048 + c) + 1.f), sh = *(const f32x4*)(mp + c);
#pragma unroll
        for (int i = 0; i < 10; ++i) { const int rr = wave + 8 * i; const float rstd = rsqrtf(rs[i] * (1.f / DM) + EPS);
            *(LAS f32x4*)(T + rr * 256 + lane * 4) = xr[i] * rstd * gmul + sh; }
        const int nitem = item + G; const bool more = nitem < 768;
        PoolItem pn = p;
        if (more) { pn = pool_item(nitem); pool_load(pn, XA, rowss, xr, rs, wave, lane); }
        __syncthreads();
        switch (g) { case 0: pool_out<1>(T, P, p.row0, p.t0, p.Tseq, p.cb, tid); break; case 1: pool_out<2>(T, P, p.row0, p.t0, p.Tseq, p.cb, tid); break;
                     case 2: pool_out<4>(T, P, p.row0, p.t0, p.Tseq, p.cb, tid); break; default: pool_out<8>(T, P, p.row0, p.t0, p.Tseq, p.cb, tid); break; }
        __syncthreads();
        if (!more) break;
        p = pn; item = nitem;
    }
}
__device__ __forceinline__ void final_rows(const float* XA, const float* rowss, const float* gain, float* O, int gw, int ngw, int lane) {
    for (int row = gw; row < NTOK; row += ngw) { const float rstd = rsqrtf(rowss[row] * (1.f / DM) + EPS);
#pragma unroll
        for (int j = 0; j < 8; ++j) { const int c = 4 * (lane + 64 * j);
            __builtin_nontemporal_store(__builtin_nontemporal_load((const f32x4*)(XA + (size_t)row * DM + c)) * rstd * *(const f32x4*)(gain + c), (f32x4*)(O + (size_t)row * DM + c)); } }
}

__device__ __forceinline__ void post_token(const Args& a, int row, int lane) {
    const bf16_t* ZB = (const bf16_t*)(a.ws + WS_ZB);
    bf16_t* QN = (bf16_t*)(a.ws + WS_QN);
    const bool samp = row >= NTOK_P;
    const int bb = samp ? (row - NTOK_P) >> 10 : row >> 8, t = samp ? (row - NTOK_P) & 1023 : row & 255;
    const int e0 = (lane & 31) * 4, hsel = lane >> 5;
    const int sect = e0 >> 5;
    float cs[4], sn[4];
    if (samp) {
        const float pos = (float)((sect < 2) ? (t >> 6) : (t & 63));
#pragma unroll
        for (int i = 0; i < 4; ++i) { const int j = (e0 + i) & 31; const float inv = exp2f(-(float)j * 0.41524101186092033f); const float ang = pos * inv; cs[i] = __cosf(ang); sn[i] = __sinf(ang); }
    }
    u32x2 raw6[6];
#pragma unroll
    for (int p = 0; p < 6; ++p) raw6[p] = *(const u32x2*)(ZB + (size_t)row * IN_AB + p * 256 + lane * 4);
#pragma unroll
    for (int p = 0; p < 6; ++p) {
        const int col = p * 256 + lane * 4;
        const u32x2 raw = raw6[p];
        float y[4] = {bflo(raw.x), bfhi(raw.x), bflo(raw.y), bfhi(raw.y)};
        if (p < 5) {
            const float ss = half_sum(y[0] * y[0] + y[1] * y[1] + y[2] * y[2] + y[3] * y[3]);
            const float rstd = rsqrtf(ss * (1.f / 128.f) + EPS);
            const f32x4 g = *(const f32x4*)((p < 4 ? a.in[14] : a.in[15]) + e0);
            y[0] *= rstd * g.x; y[1] *= rstd * g.y; y[2] *= rstd * g.z; y[3] *= rstd * g.w;
        }
        if (!samp && p >= 4) {
            float* o = a.out + (p == 4 ? 12582912 : 13631488) + (size_t)row * 256 + lane * 4;
            *(f32x4*)o = (f32x4){y[0], y[1], y[2], y[3]};
        }
        if (samp && p < 5) {
#pragma unroll
            for (int i = 0; i < 4; ++i) { const float py = __shfl_xor(y[i], 8); const float rot = (sect & 1) ? py : -py; y[i] = y[i] * cs[i] + rot * sn[i]; }
        }
        u32x2 w; w.x = cvtpk(y[0], y[1]); w.y = cvtpk(y[2], y[3]);
        if (p < 4) *(u32x2*)(QN + (size_t)row * 1024 + col) = w;
        else {
            bf16_t* dst;
            if (samp) dst = (bf16_t*)(a.ws + (p == 4 ? WS_KS : WS_VS)) + ((size_t)(bb * 2 + hsel) * 1280 + t) * 128 + e0;
            else      dst = (bf16_t*)(a.ws + (p == 4 ? WS_KP : WS_VP)) + ((size_t)(bb * 2 + hsel) * 256 + t) * 128 + e0;
            *(u32x2*)dst = w;
        }
    }
}
__device__ __forceinline__ void cache_item(const Args& a, int item, int lane) {
    const int which = item >> 9, b = (item >> 8) & 1, t = item & 255, hsel = lane >> 5, e0 = (lane & 31) * 4;
    const f32x4 v = *(const f32x4*)(a.in[2 + which] + ((size_t)(b * 256 + t) * 2 + hsel) * 128 + e0);
    bf16_t* dst = (bf16_t*)(a.ws + (which == 0 ? WS_KS : WS_VS)) + ((size_t)(b * 2 + hsel) * 1280 + 1024 + t) * 128 + e0;
    u32x2 w; w.x = cvtpk(v.x, v.y); w.y = cvtpk(v.z, v.w);
    *(u32x2*)dst = w;
}
__device__ __forceinline__ void combine_token(const Args& a, int row, int lane) {
    const float* OF = (const float*)(a.ws + WS_OF); const float* OB = (const float*)(a.ws + WS_OB);
    const bf16_t* ZB = (const bf16_t*)(a.ws + WS_ZB); bf16_t* A2 = (bf16_t*)(a.ws + WS_A2);
    const int e0 = (lane & 31) * 4;
    const f32x4 g = *(const f32x4*)(a.in[16] + e0);
#pragma unroll
    for (int p = 0; p < 4; ++p) {
        const int col = p * 256 + lane * 4;
        const f32x4 o = *(const f32x4*)(OF + (size_t)row * 1024 + col) + *(const f32x4*)(OB + (size_t)row * 1024 + col);
        const float ss = half_sum(o.x * o.x + o.y * o.y + o.z * o.z + o.w * o.w);
        const float rstd = rsqrtf(ss * (1.f / 128.f) + EPS);
        const u32x2 raw = *(const u32x2*)(ZB + (size_t)row * IN_AB + C_HG + col);
        const f32x4 y = o * rstd * g * (f32x4){bflo(raw.x), bfhi(raw.x), bflo(raw.y), bfhi(raw.y)};
        u32x2 w; w.x = cvtpk(y.x, y.y); w.y = cvtpk(y.z, y.w);
        *(u32x2*)(A2 + (size_t)row * DM + 1024 + col) = w;
    }
}

constexpr int HG_ROW = 136, HG_TROW = 40;
constexpr int HG_QI = 0, HG_KI = 32 * HG_ROW * 2, HG_QS = 2 * 32 * HG_ROW * 2, HG_KST = 3 * 32 * HG_ROW * 2, HG_IT = HG_KST + 128 * HG_TROW * 2, HG_A = HG_IT + 128 * HG_TROW * 2, HG_GT = HG_A + 512, HG_SEQ_BYTES = HG_GT + 4096;
static_assert(HG_SEQ_BYTES % 16 == 0 && 2 * HG_SEQ_BYTES <= RING_BYTES, "hgrn lds");
__device__ __forceinline__ int crow(int r, int hi) { return (r & 3) + 8 * (r >> 2) + 4 * hi; }
__device__ __forceinline__ int kpos(int k) { const int kp = k & 15; return (k & 16) + (((kp >> 2) & 1) << 3) + ((kp >> 3) << 2) + (kp & 3); }
#define MFMA32(a, b, c) __builtin_amdgcn_mfma_f32_32x32x16_bf16((a), (b), (c), 0, 0, 0)
__device__ __forceinline__ bf16x8 pack8(const f32x16& x, int s) {
    u32x4 p; p.x = cvtpk(x[8 * s], x[8 * s + 1]); p.y = cvtpk(x[8 * s + 2], x[8 * s + 3]); p.z = cvtpk(x[8 * s + 4], x[8 * s + 5]); p.w = cvtpk(x[8 * s + 6], x[8 * s + 7]);
    return __builtin_bit_cast(bf16x8, p);
}
struct HgRegs { f32x4 lf[4]; u32x2 qv[4], iv[4]; };
__device__ __forceinline__ void hg_load(HgRegs& R, const float* LF, const bf16_t* ZB, int rowbase, int dir, int hh, int cg, int tg, int ch) {
#pragma unroll
    for (int jj = 0; jj < 4; ++jj) { const int j = 4 * tg + jj;
        const int row = rowbase + (dir == 0 ? 32 * ch + j : 32 * (7 - ch) + 31 - j);
        R.lf[jj] = *(const f32x4*)(LF + (size_t)row * 2048 + dir * 1024 + hh * 128 + 4 * cg);
        R.qv[jj] = *(const u32x2*)(ZB + (size_t)row * IN_AB + C_HQ + hh * 128 + 4 * cg);
        R.iv[jj] = *(const u32x2*)(ZB + (size_t)row * IN_AB + C_HI + hh * 128 + 4 * cg); }
}
__device__ __forceinline__ void hg_chunk(const HgRegs& R, f32x16 (&S)[4], f32x4& ltot, LAS unsigned char* L, float* OUT, int rowbase, int dir, int hh, int ch,
                                         int cg, int tg, int r32, int hi, int e0) {
    f32x4 cb[4]; cb[0] = R.lf[0]; cb[1] = cb[0] + R.lf[1]; cb[2] = cb[1] + R.lf[2]; cb[3] = cb[2] + R.lf[3];
    *(LAS f32x4*)(L + HG_GT + (tg * 128 + 4 * cg) * 4) = cb[3];
    __syncthreads();
    f32x4 off = {0.f, 0.f, 0.f, 0.f}, bm = off, bl = off;
#pragma unroll
    for (int g = 0; g < 8; ++g) { const f32x4 t4 = *(const LAS f32x4*)(L + HG_GT + (g * 128 + 4 * cg) * 4); if (g < tg) off += t4; if (g < 4) bm += t4; bl += t4; }
    ltot += bl;
    f32x4 em, elm;
#pragma unroll
    for (int c = 0; c < 4; ++c) { em[c] = __expf(bm[c]); elm[c] = __expf(bl[c] - bm[c]); }
    if (tg == 0) { f32x4 av;
#pragma unroll
        for (int c = 0; c < 4; ++c) av[c] = __expf(bl[c]);
        *(LAS f32x4*)(L + HG_A + 16 * cg) = av; }
    float kS_[4][4], iv_[4][4];
#pragma unroll
    for (int jj = 0; jj < 4; ++jj) {
        const int j = 4 * tg + jj;
        const float q4[4] = {bflo(R.qv[jj].x), bfhi(R.qv[jj].x), bflo(R.qv[jj].y), bfhi(R.qv[jj].y)};
        iv_[jj][0] = bflo(R.iv[jj].x); iv_[jj][1] = bfhi(R.iv[jj].x); iv_[jj][2] = bflo(R.iv[jj].y); iv_[jj][3] = bfhi(R.iv[jj].y);
        float qI[4], qS[4], kI[4];
#pragma unroll
        for (int c = 0; c < 4; ++c) {
            const float b = off[c] + cb[jj][c];
            const float E1 = __expf(fminf(fmaxf(b - bm[c], -80.f), 80.f)), R1 = __builtin_amdgcn_rcpf(E1);
            const float kk = 1.f - __expf(R.lf[jj][c]);
            qI[c] = q4[c] * E1; qS[c] = qI[c] * em[c];
            kI[c] = kk * R1; kS_[jj][c] = kI[c] * elm[c];
        }
        u32x2 w; w.x = cvtpk(qI[0], qI[1]); w.y = cvtpk(qI[2], qI[3]);
        *(LAS u32x2*)(L + HG_QI + (j * HG_ROW + 4 * cg) * 2) = w;
        w.x = cvtpk(kI[0], kI[1]); w.y = cvtpk(kI[2], kI[3]);
        *(LAS u32x2*)(L + HG_KI + (j * HG_ROW + 4 * cg) * 2) = w;
        w.x = cvtpk(qS[0], qS[1]); w.y = cvtpk(qS[2], qS[3]);
        *(LAS u32x2*)(L + HG_QS + (j * HG_ROW + (4 * cg & ~31) + kpos(4 * cg & 31)) * 2) = w;
    }
    {
        const int p0 = kpos(4 * tg);
#pragma unroll
        for (int c = 0; c < 4; ++c) { u32x2 w; w.x = cvtpk(kS_[0][c], kS_[1][c]); w.y = cvtpk(kS_[2][c], kS_[3][c]);
            *(LAS u32x2*)(L + HG_KST + ((4 * cg + c) * HG_TROW + p0) * 2) = w;
            w.x = cvtpk(iv_[0][c], iv_[1][c]); w.y = cvtpk(iv_[2][c], iv_[3][c]);
            *(LAS u32x2*)(L + HG_IT + ((4 * cg + c) * HG_TROW + p0) * 2) = w; }
    }
    __syncthreads();
    f32x16 x;
#pragma unroll
    for (int i = 0; i < 16; ++i) x[i] = 0.f;
#pragma unroll
    for (int ks = 0; ks < 8; ++ks) {
        const bf16x8 fa = *(const LAS bf16x8*)(L + HG_KI + (r32 * HG_ROW + 16 * ks + 8 * hi) * 2);
        const bf16x8 fb = *(const LAS bf16x8*)(L + HG_QI + (r32 * HG_ROW + 16 * ks + 8 * hi) * 2);
        x = MFMA32(fa, fb, x);
    }
#pragma unroll
    for (int i = 0; i < 16; ++i) x[i] = (crow(i, hi) <= r32) ? x[i] : 0.f;
    f32x16 y;
#pragma unroll
    for (int i = 0; i < 16; ++i) y[i] = 0.f;
    bf16x8 fi[2];
#pragma unroll
    for (int ks = 0; ks < 2; ++ks) {
        fi[ks] = *(const LAS bf16x8*)(L + HG_IT + ((e0 + r32) * HG_TROW + 16 * ks + 8 * hi) * 2);
        y = MFMA32(fi[ks], pack8(x, ks), y);
    }
#pragma unroll
    for (int db = 0; db < 4; ++db)
#pragma unroll
        for (int ks = 0; ks < 2; ++ks) {
            const bf16x8 fq_ = *(const LAS bf16x8*)(L + HG_QS + (r32 * HG_ROW + 32 * db + 16 * ks + 8 * hi) * 2);
            y = MFMA32(pack8(S[db], ks), fq_, y);
        }
    {
        const int row = rowbase + (dir == 0 ? 32 * ch + r32 : 32 * (7 - ch) + 31 - r32);
        float* op = OUT + (size_t)row * 1024 + hh * 128 + e0 + 4 * hi;
#pragma unroll
        for (int g4 = 0; g4 < 4; ++g4) *(f32x4*)(op + 8 * g4) = (f32x4){y[4 * g4], y[4 * g4 + 1], y[4 * g4 + 2], y[4 * g4 + 3]};
    }
#pragma unroll
    for (int db = 0; db < 4; ++db) {
#pragma unroll
        for (int g4 = 0; g4 < 4; ++g4) { const f32x4 a4 = *(const LAS f32x4*)(L + HG_A + (32 * db + 8 * g4 + 4 * hi) * 4);
#pragma unroll
            for (int c = 0; c < 4; ++c) S[db][4 * g4 + c] *= a4[c]; }
#pragma unroll
        for (int ks = 0; ks < 2; ++ks) {
            const bf16x8 fk = *(const LAS bf16x8*)(L + HG_KST + ((32 * db + r32) * HG_TROW + 16 * ks + 8 * hi) * 2);
            S[db] = MFMA32(fk, fi[ks], S[db]);
        }
    }
}
__device__ __forceinline__ void hgrn_prefetch(const Args& a, int task, int tid, HgRegs& RA, HgRegs& RB) {
    const bool samp = task < 64;
    const int bb = samp ? task >> 5 : (task - 64) >> 3, hh = samp ? (task >> 2) & 7 : task & 7, seg = task & 3;
    const int rowbase = samp ? NTOK_P + bb * SEQ_S + seg * 256 : bb * SEQ_P;
    const int dir = tid >> 8, tl = tid & 255, cg = tl & 31, tg = tl >> 5;
    const bf16_t* ZB = (const bf16_t*)(a.ws + WS_ZB); const float* LF = (const float*)(a.ws + WS_LF);
    hg_load(RA, LF, ZB, rowbase, dir, hh, cg, tg, 0);
    hg_load(RB, LF, ZB, rowbase, dir, hh, cg, tg, 1);
}
__device__ __forceinline__ void hgrn_task(const Args& a, LAS unsigned char* lds0, int task, int tid, HgRegs& RA, HgRegs& RB) {
    const bool samp = task < 64;
    const int bb = samp ? task >> 5 : (task - 64) >> 3, hh = samp ? (task >> 2) & 7 : task & 7, seg = task & 3;
    const int rowbase = samp ? NTOK_P + bb * SEQ_S + seg * 256 : bb * SEQ_P;
    const int dir = tid >> 8, tl = tid & 255, lane = tid & 63, wq = (tid >> 6) & 3, r32 = lane & 31, hi = lane >> 5;
    LAS unsigned char* L = lds0 + dir * HG_SEQ_BYTES;
    const bf16_t* ZB = (const bf16_t*)(a.ws + WS_ZB); const float* LF = (const float*)(a.ws + WS_LF);
    float* OUT = (float*)(a.ws + (dir == 0 ? WS_OF : WS_OB));
    const int cg = tl & 31, tg = tl >> 5, e0 = 32 * wq;
    f32x16 S[4];
    const bool has_init = samp && (dir == 0 ? seg == 0 : seg == 3);
    if (has_init) { const float* s0 = a.in[4 + dir] + (size_t)(bb * 8 + hh) * 16384;
#pragma unroll
        for (int db = 0; db < 4; ++db)
#pragma unroll
            for (int i = 0; i < 16; ++i) S[db][i] = s0[(size_t)(32 * db + crow(i, hi)) * 128 + e0 + r32];
    } else {
#pragma unroll
        for (int db = 0; db < 4; ++db)
#pragma unroll
            for (int i = 0; i < 16; ++i) S[db][i] = 0.f;
    }
    f32x4 ltot = {0.f, 0.f, 0.f, 0.f};
#pragma unroll
    for (int ch = 0; ch < 8; ch += 2) {
        hg_chunk(RA, S, ltot, L, OUT, rowbase, dir, hh, ch, cg, tg, r32, hi, e0);
        if (ch + 2 < 8) hg_load(RA, LF, ZB, rowbase, dir, hh, cg, tg, ch + 2);
        hg_chunk(RB, S, ltot, L, OUT, rowbase, dir, hh, ch + 1, cg, tg, r32, hi, e0);
        if (ch + 3 < 8) hg_load(RB, LF, ZB, rowbase, dir, hh, cg, tg, ch + 3);
    }
    if (!samp) { float* so = a.out + (dir == 0 ? 14680064 : 16777216) + (size_t)(bb * 8 + hh) * 16384;
#pragma unroll
        for (int db = 0; db < 4; ++db)
#pragma unroll
            for (int i = 0; i < 16; ++i) so[(size_t)(32 * db + crow(i, hi)) * 128 + e0 + r32] = S[db][i];
    } else {
        const size_t sidx = (size_t)(((bb * 8 + hh) * 2 + dir) * 4 + seg);
        float* so = (float*)(a.ws + WS_SEND) + sidx * 16384;
#pragma unroll
        for (int db = 0; db < 4; ++db)
#pragma unroll
            for (int i = 0; i < 16; ++i) so[(size_t)(32 * db + crow(i, hi)) * 128 + e0 + r32] = S[db][i];
        if (tg == 0) *(f32x4*)((float*)(a.ws + WS_LSEG) + sidx * 128 + 4 * cg) = ltot;
    }
    __syncthreads();
}
constexpr int FX_QS = 0, FX_GT = 32 * HG_ROW * 2, FX_DIR_BYTES = FX_GT + 4096, FX_Z = 2 * FX_DIR_BYTES, FX_ZROW = 132, FX_RED = FX_Z + 32 * FX_ZROW * 4, FX_BYTES = FX_RED + 512;
__device__ __forceinline__ void hgfix_task(const Args& a, LAS unsigned char* lds0, int task, int tid) {
    const int bb = task >> 5, hh = (task >> 2) & 7, seg = task & 3;
    const int rowbase = NTOK_P + bb * SEQ_S + seg * 256;
    const int dir = tid >> 8, tl = tid & 255, lane = tid & 63, wq = (tid >> 6) & 3, r32 = lane & 31, hi = lane >> 5;
    LAS unsigned char* L = lds0 + dir * FX_DIR_BYTES;
    const bf16_t* ZB = (const bf16_t*)(a.ws + WS_ZB); const float* LF = (const float*)(a.ws + WS_LF);
    const float* OIN = (const float*)(a.ws + (dir == 0 ? WS_OF : WS_OB));
    bf16_t* A2 = (bf16_t*)(a.ws + WS_A2);
    const int cg = tl & 31, tg = tl >> 5, e0 = 32 * wq;
    const size_t sbase = (size_t)((bb * 8 + hh) * 2 + dir) * 4;
    const float* SEND = (const float*)(a.ws + WS_SEND); const float* LSEG = (const float*)(a.ws + WS_LSEG);
    f32x16 S[4];
#pragma unroll
    for (int db = 0; db < 4; ++db)
#pragma unroll
        for (int i = 0; i < 16; ++i) S[db][i] = 0.f;
    const int nfold = dir == 0 ? seg : 3 - seg;
    for (int f = 0; f < nfold; ++f) { const int j = dir == 0 ? f : 3 - f;
        const float* sp = SEND + (sbase + j) * 16384; const float* lp = LSEG + (sbase + j) * 128;
#pragma unroll
        for (int db = 0; db < 4; ++db)
#pragma unroll
            for (int g4 = 0; g4 < 4; ++g4) { const f32x4 l4 = *(const f32x4*)(lp + 32 * db + 8 * g4 + 4 * hi);
#pragma unroll
                for (int c = 0; c < 4; ++c) { const int i = 4 * g4 + c; S[db][i] = S[db][i] * __expf(l4[c]) + sp[(size_t)(32 * db + crow(i, hi)) * 128 + e0 + r32]; } }
    }
    bf16x8 sf[4][2];
#pragma unroll
    for (int db = 0; db < 4; ++db)
#pragma unroll
        for (int ks = 0; ks < 2; ++ks) sf[db][ks] = pack8(S[db], ks);
    f32x4 run = {0.f, 0.f, 0.f, 0.f}, ltot = {0.f, 0.f, 0.f, 0.f};
    if (dir == 1) ltot = *(const f32x4*)(LSEG + (sbase + seg) * 128 + 4 * cg);
    const f32x4 gn0 = *(const f32x4*)(a.in[16] + e0 + 4 * hi), gn1 = *(const f32x4*)(a.in[16] + e0 + 4 * hi + 8), gn2 = *(const f32x4*)(a.in[16] + e0 + 4 * hi + 16), gn3 = *(const f32x4*)(a.in[16] + e0 + 4 * hi + 24);
    f32x4 lfn[4]; u32x2 qvn[4];
#define FX_LOAD(chn) do { _Pragma("unroll") for (int jj = 0; jj < 4; ++jj) { const int row_ = rowbase + 32 * (chn) + 4 * tg + jj; \
        lfn[jj] = *(const f32x4*)(LF + (size_t)row_ * 2048 + dir * 1024 + hh * 128 + 4 * cg); \
        qvn[jj] = *(const u32x2*)(ZB + (size_t)row_ * IN_AB + C_HQ + hh * 128 + 4 * cg); } } while (0)
    FX_LOAD(0);
#pragma unroll 1
    for (int ch = 0; ch < 8; ++ch) {
        f32x4 lf[4]; u32x2 qv[4];
#pragma unroll
        for (int jj = 0; jj < 4; ++jj) { lf[jj] = lfn[jj]; qv[jj] = qvn[jj]; }
        const int row = rowbase + 32 * ch + r32;
        f32x4 zin[4]; u32x2 hgraw[4];
        { const float* ip = OIN + (size_t)row * 1024 + hh * 128 + e0 + 4 * hi; const bf16_t* hgp = ZB + (size_t)row * IN_AB + C_HG + hh * 128 + e0 + 4 * hi;
#pragma unroll
          for (int g4 = 0; g4 < 4; ++g4) { zin[g4] = *(const f32x4*)(ip + 8 * g4); hgraw[g4] = *(const u32x2*)(hgp + 8 * g4); } }
        if (ch + 1 < 8) FX_LOAD(ch + 1);
        f32x4 cb[4]; cb[0] = lf[0]; cb[1] = cb[0] + lf[1]; cb[2] = cb[1] + lf[2]; cb[3] = cb[2] + lf[3];
        *(LAS f32x4*)(L + FX_GT + (tg * 128 + 4 * cg) * 4) = cb[3];
        __syncthreads();
        f32x4 off = {0.f, 0.f, 0.f, 0.f}, bl = off;
#pragma unroll
        for (int g = 0; g < 8; ++g) { const f32x4 t4 = *(const LAS f32x4*)(L + FX_GT + (g * 128 + 4 * cg) * 4); if (g < tg) off += t4; bl += t4; }
#pragma unroll
        for (int jj = 0; jj < 4; ++jj) { const int j = 4 * tg + jj;
            const float q4[4] = {bflo(qv[jj].x), bfhi(qv[jj].x), bflo(qv[jj].y), bfhi(qv[jj].y)};
            float qB[4];
#pragma unroll
            for (int c = 0; c < 4; ++c) { const float incl = run[c] + off[c] + cb[jj][c];
                const float B = dir == 0 ? incl : ltot[c] - (incl - lf[jj][c]);
                qB[c] = q4[c] * __expf(B); }
            u32x2 w; w.x = cvtpk(qB[0], qB[1]); w.y = cvtpk(qB[2], qB[3]);
            *(LAS u32x2*)(L + FX_QS + (j * HG_ROW + (4 * cg & ~31) + kpos(4 * cg & 31)) * 2) = w; }
        run += bl;
        __syncthreads();
        f32x16 y;
#pragma unroll
        for (int i = 0; i < 16; ++i) y[i] = 0.f;
        if (nfold > 0) {
#pragma unroll
            for (int db = 0; db < 4; ++db)
#pragma unroll
                for (int ks = 0; ks < 2; ++ks) { const bf16x8 fq_ = *(const LAS bf16x8*)(L + FX_QS + (r32 * HG_ROW + 32 * db + 16 * ks + 8 * hi) * 2); y = MFMA32(sf[db][ks], fq_, y); }
        }
        f32x4 z[4];
#pragma unroll
        for (int g4 = 0; g4 < 4; ++g4) z[g4] = zin[g4] + (f32x4){y[4 * g4], y[4 * g4 + 1], y[4 * g4 + 2], y[4 * g4 + 3]};
        LAS float* Z = (LAS float*)(lds0 + FX_Z);
        if (dir == 1) {
#pragma unroll
            for (int g4 = 0; g4 < 4; ++g4) *(LAS f32x4*)(Z + r32 * FX_ZROW + e0 + 4 * hi + 8 * g4) = z[g4]; }
        __syncthreads();
        float ssq = 0.f;
        if (dir == 0) {
#pragma unroll
            for (int g4 = 0; g4 < 4; ++g4) { z[g4] += *(const LAS f32x4*)(Z + r32 * FX_ZROW + e0 + 4 * hi + 8 * g4); ssq += (z[g4].x * z[g4].x + z[g4].y * z[g4].y) + (z[g4].z * z[g4].z + z[g4].w * z[g4].w); }
            ssq += __shfl_xor(ssq, 32);
            if (hi == 0) ((LAS float*)(lds0 + FX_RED))[wq * 32 + r32] = ssq;
        }
        __syncthreads();
        if (dir == 0) {
            const LAS float* red = (const LAS float*)(lds0 + FX_RED);
            const float tot = (red[r32] + red[32 + r32]) + (red[64 + r32] + red[96 + r32]);
            const float rstd = rsqrtf(tot * (1.f / 128.f) + EPS);
            bf16_t* op = A2 + (size_t)row * DM + 1024 + hh * 128 + e0 + 4 * hi;
            const f32x4 gn[4] = {gn0, gn1, gn2, gn3};
#pragma unroll
            for (int g4 = 0; g4 < 4; ++g4) { const u32x2 raw = hgraw[g4];
                const f32x4 o = z[g4] * rstd * gn[g4] * (f32x4){bflo(raw.x), bfhi(raw.x), bflo(raw.y), bfhi(raw.y)};
                u32x2 w; w.x = cvtpk(o.x, o.y); w.y = cvtpk(o.z, o.w); *(u32x2*)(op + 8 * g4) = w; }
        }
    }
    __syncthreads();
}

namespace att {
constexpr int D = 128, NW = 8, QBLK = 32, KVBLK = 64;
constexpr float SCALE = 0.088388347648318440f;
constexpr float THR = 0.f;
constexpr int LDQ = 1024, LDK = 128, LDO = 2048;
constexpr int SHM_V = KVBLK * D * 2, SHM_K = KVBLK * D * 2, SHM_ATTN = 2 * SHM_V + 2 * SHM_K + NW * 64 * 4;
#define KSWZ(row, colB) ((row) * 256 + ((colB) ^ (((row) & 7) << 4)))
#define SBAR() __builtin_amdgcn_sched_barrier(0)
__device__ __forceinline__ unsigned cvtpk_a(float lo, float hi) { unsigned r; asm volatile("v_cvt_pk_bf16_f32 %0, %1, %2" : "=v"(r) : "v"(lo), "v"(hi)); return r; }
__device__ __forceinline__ void partialSM(f32x16& p0, f32x16& p1, float& m_reg, float& mn, float& alpha) {
  constexpr float C = SCALE * 1.4426950408889634f;
  float pmax = p0[0]; for (int r = 1; r < 16; ++r) pmax = fmaxf(pmax, p0[r]); for (int r = 0; r < 16; ++r) pmax = fmaxf(pmax, p1[r]);
  { auto rr = __builtin_amdgcn_permlane32_swap(__float_as_uint(pmax), __float_as_uint(pmax), false, false);
    pmax = fmaxf(__uint_as_float(rr[0]), __uint_as_float(rr[1])); }
  if (__builtin_expect(__all(pmax - m_reg <= THR / SCALE), 1)) { mn = m_reg; alpha = 1.f; }
  else { mn = fmaxf(m_reg, pmax); alpha = __builtin_amdgcn_exp2f((m_reg - mn) * C); m_reg = mn; }
  float mnC = -mn * C;
  for (int r = 0; r < 16; ++r) p0[r] = fmaf(p0[r], C, mnC); for (int r = 0; r < 16; ++r) p1[r] = fmaf(p1[r], C, mnC);
  for (int r = 0; r < 16; ++r) p0[r] = __builtin_amdgcn_exp2f(p0[r]);
}
__device__ __forceinline__ void finishSM(f32x16& p0, f32x16& p1, float alpha, float& l_reg, bf16x8& pa0, bf16x8& pa1, bf16x8& pa2, bf16x8& pa3) {
  for (int r = 0; r < 16; ++r) p1[r] = __builtin_amdgcn_exp2f(p1[r]);
  float ps = 0; for (int r = 0; r < 16; ++r) ps += p0[r]; for (int r = 0; r < 16; ++r) ps += p1[r];
  { auto rr = __builtin_amdgcn_permlane32_swap(__float_as_uint(ps), __float_as_uint(ps), false, false);
    ps = __uint_as_float(rr[0]) + __uint_as_float(rr[1]); }
  l_reg = l_reg * alpha + ps;
#define PK4(P, BASE, OUT) do { unsigned a0 = cvtpk_a(P[BASE + 0], P[BASE + 1]), a1 = cvtpk_a(P[BASE + 2], P[BASE + 3]);   \
    unsigned b0 = cvtpk_a(P[BASE + 4], P[BASE + 5]), b1 = cvtpk_a(P[BASE + 6], P[BASE + 7]);                              \
    auto r0 = __builtin_amdgcn_permlane32_swap(a0, b0, false, false); auto r1 = __builtin_amdgcn_permlane32_swap(a1, b1, false, false); \
    u32x4 w = {r0[0], r1[0], r0[1], r1[1]}; OUT = *reinterpret_cast<bf16x8*>(&w); } while (0)
  PK4(p0, 0, pa0); PK4(p0, 8, pa1); PK4(p1, 0, pa2); PK4(p1, 8, pa3);
#undef PK4
}
__device__ __forceinline__ void qkt(f32x16& p0, f32x16& p1, const bf16_t* Ks, const bf16x8* qr, int r32, int hi) {
  p0 = f32x16{}; p1 = f32x16{};
  for (int d0 = 0; d0 < 8; ++d0) { int cb = (d0 * 16 + hi * 8) * 2;
    bf16x8 b0 = *reinterpret_cast<const bf16x8*>((const char*)Ks + KSWZ(r32, cb));
    bf16x8 b1 = *reinterpret_cast<const bf16x8*>((const char*)Ks + KSWZ(32 + r32, cb));
    p0 = __builtin_amdgcn_mfma_f32_32x32x16_bf16(b0, qr[d0], p0, 0, 0, 0);
    p1 = __builtin_amdgcn_mfma_f32_32x32x16_bf16(b1, qr[d0], p1, 0, 0, 0); }
}
__device__ __forceinline__ int v_st(int k, int c) { const int kk = (k & ~0xC) | ((k & 4) << 1) | ((k & 8) >> 1); return ((kk >> 3) * 4 + (c >> 5)) * 512 + ((kk & 7) * 32 + (c & 31)) * 2; }
__device__ __forceinline__ int v_rd_base(int lane) { return ((lane & 3) << 3) | (((lane >> 2) & 3) << 6) | (((lane >> 4) & 1) << 5) | (((lane >> 5) & 1) << 8); }
constexpr int v_rd_off(int d0, int ks, int half) { return d0 * 512 + ks * 4096 + half * 2048; }
template <int OFF> __device__ __forceinline__ s16x4 tr_read(int vb) {
  s16x4 r; asm volatile("ds_read_b64_tr_b16 %0, %1 offset:%2" : "=&v"(r) : "v"(vb), "i"(OFF) : "memory"); return r;
}
template <int D0> __device__ __forceinline__ void pv_one(f32x16& od, int vb, bf16x8 pa0, bf16x8 pa1, bf16x8 pa2, bf16x8 pa3) {
  const s16x4 l0 = tr_read<v_rd_off(D0, 0, 0)>(vb), h0 = tr_read<v_rd_off(D0, 0, 1)>(vb), l1 = tr_read<v_rd_off(D0, 1, 0)>(vb), h1 = tr_read<v_rd_off(D0, 1, 1)>(vb);
  const s16x4 l2 = tr_read<v_rd_off(D0, 2, 0)>(vb), h2 = tr_read<v_rd_off(D0, 2, 1)>(vb), l3 = tr_read<v_rd_off(D0, 3, 0)>(vb), h3 = tr_read<v_rd_off(D0, 3, 1)>(vb);
  asm volatile("s_waitcnt lgkmcnt(0)" ::: "memory"); SBAR();
#define PK(L, H) (bf16x8){L[0], L[1], L[2], L[3], H[0], H[1], H[2], H[3]}
  od = __builtin_amdgcn_mfma_f32_32x32x16_bf16(pa0, PK(l0, h0), od, 0, 0, 0);
  od = __builtin_amdgcn_mfma_f32_32x32x16_bf16(pa1, PK(l1, h1), od, 0, 0, 0);
  od = __builtin_amdgcn_mfma_f32_32x32x16_bf16(pa2, PK(l2, h2), od, 0, 0, 0);
  od = __builtin_amdgcn_mfma_f32_32x32x16_bf16(pa3, PK(l3, h3), od, 0, 0, 0);
#undef PK
}
__device__ __forceinline__ void pv_d0(f32x16* o, int vb, bf16x8 pa0, bf16x8 pa1, bf16x8 pa2, bf16x8 pa3) {
  pv_one<0>(o[0], vb, pa0, pa1, pa2, pa3); pv_one<1>(o[1], vb, pa0, pa1, pa2, pa3); pv_one<2>(o[2], vb, pa0, pa1, pa2, pa3); pv_one<3>(o[3], vb, pa0, pa1, pa2, pa3);
}
__device__ __forceinline__ void attn_dense_body(const bf16_t* __restrict__ Qb, const bf16_t* __restrict__ Kh, const bf16_t* __restrict__ Vh,
                                                bf16_t* __restrict__ Ob, int seq, char* lds) {
  const int tid = threadIdx.x, wid = tid >> 6, lane = tid & 63, r32 = lane & 31, hi = lane >> 5;
  bf16_t* V_lds = (bf16_t*)lds; bf16_t* K_lds = (bf16_t*)(lds + 2 * SHM_V);
  float* ws = (float*)(lds + 2 * SHM_V + 2 * SHM_K) + wid * 64; float* li_l = ws; float* al_l = ws + 32;
  float m_reg = -1e30f, l_reg = 0; f32x16 o[4] = {}; bf16x8 qr[8];
  const bf16_t* Qw = Qb + (long)(wid * QBLK + r32) * LDQ + hi * 8;
#pragma unroll
  for (int d0 = 0; d0 < 8; ++d0) qr[d0] = *reinterpret_cast<const bf16x8*>(Qw + d0 * 16);
  const int sr = tid >> 4, sc = (tid & 15) * 8, vst0 = v_st(sr, sc), vst1 = v_st(32 + sr, sc);
  const int vb0 = (int)(uintptr_t)V_lds + v_rd_base(lane);
  struct { bf16x8 vs0, vs1, ks0, ks1; } sr_[2];
#define LD8(p) (*reinterpret_cast<const bf16x8*>(p))
#define SLOAD(i, k0) do { sr_[i].vs0 = LD8(&Vh[(long)((k0) + sr) * LDK + sc]); sr_[i].vs1 = LD8(&Vh[(long)((k0) + 32 + sr) * LDK + sc]); \
    sr_[i].ks0 = LD8(&Kh[(long)((k0) + sr) * LDK + sc]); sr_[i].ks1 = LD8(&Kh[(long)((k0) + 32 + sr) * LDK + sc]); } while (0)
#define SWRITE(b, i) do { *(bf16x8*)((char*)V_lds + (b) * SHM_V + vst0) = sr_[i].vs0;          \
    *(bf16x8*)((char*)V_lds + (b) * SHM_V + vst1) = sr_[i].vs1; int kc = sc * 2;               \
    *(bf16x8*)((char*)K_lds + (b) * SHM_K + KSWZ(sr, kc)) = sr_[i].ks0;                       \
    *(bf16x8*)((char*)K_lds + (b) * SHM_K + KSWZ(32 + sr, kc)) = sr_[i].ks1; } while (0)
#define SWAIT() asm volatile("s_waitcnt vmcnt(4)" ::: "memory")
#define RESC(a) do { if (__any((a) < 1.f)) { if (hi == 0) al_l[r32] = (a); asm volatile("s_waitcnt lgkmcnt(0)" ::: "memory"); \
    for (int d = 0; d < 4; ++d) for (int r = 0; r < 16; ++r) o[d][r] *= al_l[crow(r, hi)]; } } while (0)
  f32x16 pA0, pA1, pB0, pB1; float mnA, mnB, alA, alB; bf16x8 pa0, pa1, pa2, pa3; const int NT = seq / KVBLK;
  constexpr int SE = 0, SO = 1;
  SLOAD(SE, 0); asm volatile("s_waitcnt vmcnt(0)" ::: "memory"); SWRITE(0, SE); __syncthreads();
  qkt(pA0, pA1, K_lds, qr, r32, hi); partialSM(pA0, pA1, m_reg, mnA, alA);
  SLOAD(SO, KVBLK); if (2 < NT) SLOAD(SE, 2 * KVBLK);
  SWAIT(); SWRITE(1, SO); __syncthreads();
  for (int j = 1; j + 1 < NT; j += 2) {
    SBAR(); qkt(pB0, pB1, (bf16_t*)((char*)K_lds + SHM_K), qr, r32, hi);
    finishSM(pA0, pA1, alA, l_reg, pa0, pa1, pa2, pa3); SBAR();
    SLOAD(SO, (j + 2) * KVBLK); SBAR();
    pv_d0(o, vb0, pa0, pa1, pa2, pa3); partialSM(pB0, pB1, m_reg, mnB, alB);
    __syncthreads(); SWAIT(); SWRITE(0, SE);
    RESC(alB); __syncthreads();
    SBAR(); qkt(pA0, pA1, K_lds, qr, r32, hi);
    finishSM(pB0, pB1, alB, l_reg, pa0, pa1, pa2, pa3); SBAR();
    if (j + 3 < NT) SLOAD(SE, (j + 3) * KVBLK); SBAR();
    pv_d0(o, vb0 + (int)SHM_V, pa0, pa1, pa2, pa3); partialSM(pA0, pA1, m_reg, mnA, alA);
    __syncthreads(); SWAIT(); SWRITE(1, SO);
    RESC(alA); __syncthreads();
  }
  SBAR(); qkt(pB0, pB1, (bf16_t*)((char*)K_lds + SHM_K), qr, r32, hi);
  finishSM(pA0, pA1, alA, l_reg, pa0, pa1, pa2, pa3); SBAR();
  pv_d0(o, vb0, pa0, pa1, pa2, pa3); partialSM(pB0, pB1, m_reg, mnB, alB);
  __syncthreads(); RESC(alB);
  finishSM(pB0, pB1, alB, l_reg, pa0, pa1, pa2, pa3); SBAR();
  pv_d0(o, vb0 + (int)SHM_V, pa0, pa1, pa2, pa3);
  if (hi == 0) li_l[r32] = l_reg; asm volatile("s_waitcnt lgkmcnt(0)" ::: "memory");
  float rli[16];
#pragma unroll
  for (int r = 0; r < 16; ++r) rli[r] = __builtin_amdgcn_rcpf(li_l[crow(r, hi)]);
  bf16_t* Ow = Ob + (long)(wid * QBLK) * LDO;
#pragma unroll
  for (int r = 0; r < 16; ++r) { int orow = crow(r, hi);
    for (int d0 = 0; d0 < 4; ++d0) { const float v = o[d0][r] * rli[r]; Ow[(long)orow * LDO + d0 * 32 + r32] = (bf16_t)(cvtpk(v, v) & 0xffffu); } }
  __syncthreads();
#undef LD8
#undef SLOAD
#undef SWRITE
#undef SWAIT
#undef RESC
}
#undef SBAR
}

constexpr int N_PHASES = 13;
__global__ void __launch_bounds__(NWAVES * 64, 2) fwd_kernel(Args args) {
    extern __shared__ __attribute__((aligned(16))) unsigned char lds_raw[];
    LAS unsigned char* lds = (LAS unsigned char*)lds_raw;
    volatile LAS unsigned* MISC = (volatile LAS unsigned*)(lds + MISC_OFF);
    const int tid = threadIdx.x, wave = __builtin_amdgcn_readfirstlane(tid >> 6);
    const int G = gridDim.x, bx = blockIdx.x;
    const int gw = bx * NWAVES + wave, NGW = G * NWAVES;
#define lane lane_id()
    gu32* ctl = (gu32*)(args.ws + WS_CTL);
    for (int u = tid; u < (LDS_BYTES - LDSCTL_OFF) / 4; u += NWAVES * 64) ((LAS unsigned*)(lds + LDSCTL_OFF))[u] = 0u;
    __syncthreads();
    XcdBarrier bar; bar.bar = (unsigned*)(ctl + CW_BAR); bar.x = 0; bar.st = nullptr;
    if (!MK_PER_PHASE) bar = xcd_barrier_post((unsigned*)(ctl + CW_BAR), MISC + 8);
    const int lo = args.ph_lo, hi = args.ph_hi;
#define IN(k) (lo <= (k) && (k) < hi)
#define STAMP(i) do { if (PROBE_PH >= 0 && bx == PROBE_BX && tid == 0) { MISC[16 + (i)] = (unsigned)__builtin_amdgcn_s_memrealtime(); MISC[15] = (unsigned)(i); } } while (0)
#define SEAM_PF(k, PFSTMT) do { if (PROBE_PH >= 0 && bx == PROBE_BX && tid == 0) MISC[48 + (k)] = (unsigned)__builtin_amdgcn_s_memrealtime(); \
        if (IN(k) && IN((k) + 1)) { xcd_barrier_a(bar); PFSTMT; xcd_barrier_b(bar); } STAMP((k) + 1); } while (0)
#define SEAM(k) do { if (PROBE_PH >= 0 && bx == PROBE_BX && tid == 0) MISC[48 + (k)] = (unsigned)__builtin_amdgcn_s_memrealtime(); if (IN(k) && IN((k) + 1)) xcd_barrier(bar); STAMP((k) + 1); } while (0)
#define W_IN ((bf16_t*)(args.ws + WS_WIN))
#define W_OUT ((bf16_t*)(args.ws + WS_WOUT))
#define W_POOL ((bf16_t*)(args.ws + WS_WPOOL))
#define W_M1 ((bf16_t*)(args.ws + WS_WM1))
#define W_M2 ((bf16_t*)(args.ws + WS_WM2))
#define Hb ((bf16_t*)(args.ws + WS_H))
#define ZB ((bf16_t*)(args.ws + WS_ZB))
#define LFb ((float*)(args.ws + WS_LF))
#define A2 ((bf16_t*)(args.ws + WS_A2))
#define XA ((float*)(args.ws + WS_XA))
#define X1B ((bf16_t*)(args.ws + WS_OF))
#define Ub ((bf16_t*)(args.ws + WS_U))
#define MOD ((const float*)(args.ws + WS_MOD))
#define ROWSS ((float*)(args.ws + WS_ROWSS))
#define SW ((float*)(args.ws + WS_SW))
#define IDLE_FIRST(nwg) (((nwg) % G) ? ((nwg) % G) : 0)

    STAMP(0);
    if (IN(0)) {
        for (int wi = bx; wi < 192; wi += G) p0_ada_item(args, lds, wi, tid);
        if (bx < 192) bg_transposes(args, lds, R_IN + P0_NOADA, R_OUT, bx * NWAVES + wave, 192 * NWAVES, wave, lane);
        else bg_transposes(args, lds, R_IN, R_IN + P0_NOADA, (bx - 192) * NWAVES + wave, 64 * NWAVES, wave, lane);
    }
    f32x4 xv[3][8];
    if (PROBE_PH >= 0 && bx == PROBE_BX && tid == 0) MISC[48] = (unsigned)__builtin_amdgcn_s_memrealtime();
    if (IN(0) && IN(1)) { xcd_barrier_a(bar); if (wave != 0) norm1_load(args, xv, bx, wave, lane); xcd_barrier_b(bar); }
    STAMP(1);
    if (IN(1)) { if (wave == 0 || !(IN(0) && IN(1))) norm1_load(args, xv, bx, wave, lane); norm1_finish(args, xv, args.in[10], Hb, bx, wave, lane); }
    pg8::Gemm g2{Hb, W_IN, NTOK, IN_AB, 2048, 2048, 2048, 0, 0}; pg8::StaticOrder S2; S2.init(NTOK, IN_AB, 2048, G, bx, 256, 1);
    SEAM_PF(1, (pg8::gemm_prefetch_b<true>(lds, g2, S2)));
    if (IN(2)) { EpiIn E{ZB, LFb, args.in[17]}; pg8::gemm_phase<EpiIn, pg8::StaticOrder, true, 4, !MK_PER_PHASE>(lds, g2, S2, E);
        const int f = IDLE_FIRST(624); if (bx >= f) bg_transposes(args, lds, R_OUT, R_M2_0, (bx - f) * NWAVES + wave, (G - f) * NWAVES, wave, lane); }
    SEAM(2);
    if (IN(3)) {
        if (bx < 192) { HgRegs RA, RB; hgrn_prefetch(args, bx, tid, RA, RB); hgrn_task(args, lds, bx, tid, RA, RB); }
        else { const int w = (bx - 192) * NWAVES + wave, nw = (G - 192) * NWAVES;
            for (int row = w; row < NTOK; row += nw) post_token(args, row, lane);
            for (int it = w; it < 1024; it += nw) cache_item(args, it, lane); }
    }
    SEAM(3);
    if (IN(4)) {
        if (bx < 192) { const int u = bx;
            const bf16_t *Q, *K, *V; bf16_t* O; int seq;
            if (u < 64) { const int b = u >> 5, h = (u >> 2) & 7, qb = u & 3; const size_t row0 = NTOK_P + b * SEQ_S + qb * 256;
                Q = (const bf16_t*)(args.ws + WS_QN) + row0 * 1024 + h * 128; O = A2 + row0 * DM + h * 128;
                K = (const bf16_t*)(args.ws + WS_KS) + (size_t)(b * 2 + (h >> 2)) * 1280 * 128; V = (const bf16_t*)(args.ws + WS_VS) + (size_t)(b * 2 + (h >> 2)) * 1280 * 128; seq = 1280; }
            else { const int v = u - 64, b = v >> 3, h = v & 7; const size_t row0 = b * 256;
                Q = (const bf16_t*)(args.ws + WS_QN) + row0 * 1024 + h * 128; O = A2 + row0 * DM + h * 128;
                K = (const bf16_t*)(args.ws + WS_KP) + (size_t)(b * 2 + (h >> 2)) * 256 * 128; V = (const bf16_t*)(args.ws + WS_VP) + (size_t)(b * 2 + (h >> 2)) * 256 * 128; seq = 256; }
            att::attn_dense_body(Q, K, V, O, seq, (char*)lds_raw);
        }
        if (bx >= 192) { for (int t = bx - 192; t < 64; t += G - 192) hgfix_task(args, lds, t, tid); }
        if (bx < 64 || bx >= 192) bg_transposes(args, lds, R_M2_0, R_M2_0 + 1024, ((bx < 64 ? bx : bx - 128)) * NWAVES + wave, 128 * NWAVES, wave, lane);
        else if (bx >= 64) { for (int row = (bx - 64) * NWAVES + wave; row < NTOK_P; row += 128 * NWAVES) combine_token(args, row, lane);
            bg_transposes(args, lds, R_M2_0 + 1024, R_POOL, (bx - 64) * NWAVES + wave, 128 * NWAVES, wave, lane); }
    }
    pg8::Gemm g5{A2, W_OUT, NTOK, DM, 2048, 2048, 2048, 0, 0}; pg8::StaticOrder S5; S5.init(NTOK, DM, 2048, G, bx, 192);
    SEAM_PF(4, (pg8::gemm_prefetch_b<true>(lds, g5, S5)));
    if (IN(5)) { EpiRes<3, false, true> E{args.in[0], args.in[1], (float*)X1B, MOD + 2 * 2048, nullptr, Hb, args.in[11], MOD + 4 * 2048, ROWSS}; pg8::gemm_phase<EpiRes<3, false, true>, pg8::StaticOrder, true, 3, !MK_PER_PHASE>(lds, g5, S5, E); }
    pg8::Gemm g6{Hb, W_M1, NTOK, DFF, 2048, 2048, 2048, 0, 0}; pg8::StaticOrder S6; S6.init(NTOK, DFF, 2048, G, bx);
    SEAM_PF(5, (pg8::gemm_prefetch_b<true>(lds, g6, S6)));
    if (IN(6)) { EpiRelu2 E{Ub, ROWSS, SW}; pg8::gemm_phase<EpiRelu2, pg8::StaticOrder, true, 4, !MK_PER_PHASE>(lds, g6, S6, E); }
    pg8::Gemm g7{Ub, W_M2, NTOK, DM, DFF, DFF, DFF, 0, 0}; pg8::StaticOrder S7; S7.init(NTOK, DM, DFF, G, bx);
    SEAM_PF(6, (pg8::gemm_prefetch_b<true>(lds, g7, S7)));
    if (IN(7)) { EpiRes<4, true, false> E{(const float*)X1B, nullptr, XA, MOD + 5 * 2048, nullptr, nullptr, nullptr, nullptr, ROWSS + NTOK}; pg8::gemm_phase<EpiRes<4, true, false>, pg8::StaticOrder, true, 4, !MK_PER_PHASE>(lds, g7, S7, E);
        const int f = IDLE_FIRST(192);
        if (bx >= f) {
            const int w = (bx - f) * NWAVES + wave, nw = (G - f) * NWAVES;
            for (int wi = 192 + (bx - f); wi < 384; wi += G - f) p0_ada_item(args, lds, wi, tid);
            asm volatile("s_waitcnt vmcnt(0)" ::: "memory"); __syncthreads();
            unsigned* cnt = (unsigned*)(args.ws + WS_CTL) + CW_ADA1;
            if (tid == 0) { __builtin_amdgcn_fence(__ATOMIC_RELEASE, "agent"); asm volatile("s_waitcnt vmcnt(0)" ::: "memory"); __hip_atomic_fetch_add(cnt, 1u, __ATOMIC_RELAXED, __HIP_MEMORY_SCOPE_AGENT); }
            bg_transposes(args, lds, R_POOL, R_M1_1, w, nw, wave, lane);
            bg_transposes(args, lds, R_M2_1, R_END, w, nw, wave, lane);
            if (tid == 0) { unsigned sp = 0; while (__hip_atomic_load(cnt, __ATOMIC_RELAXED, __HIP_MEMORY_SCOPE_AGENT) < (unsigned)(G - f)) { __builtin_amdgcn_s_sleep(4); if (++sp > (1u << 22)) break; }
                __builtin_amdgcn_fence(__ATOMIC_ACQUIRE, "agent"); asm volatile("s_waitcnt vmcnt(0)" ::: "memory"); }
            __syncthreads();
            bg_transposes(args, lds, R_M1_1, R_M2_1, w, nw, wave, lane);
        } }
    SEAM(7);
    if (IN(8)) pool_phase(args, lds, XA, ROWSS + NTOK, Hb, bx, G, tid);
    pg8::Gemm g9{Hb, W_POOL, NTOK, DM, 512, 2048, 512, 1, 512}; pg8::StaticOrder S9; S9.init(NTOK, DM, 512, G, bx, 192);
    SEAM_PF(8, (pg8::gemm_prefetch_b<true>(lds, g9, S9)));
    if (IN(9)) { EpiRes<3> E{XA, XA + (size_t)NTOK_P * DM, XA, MOD + NMODC + 2 * 2048, args.in[19], A2, args.in[11] + 2048, MOD + NMODC + 4 * 2048, ROWSS + 2 * NTOK};
        pg8::gemm_phase<EpiRes<3>, pg8::StaticOrder, true, 3, !MK_PER_PHASE>(lds, g9, S9, E); }
    pg8::Gemm g10{A2, W_M1 + (size_t)DFF * 2048, NTOK, DFF, 2048, 2048, 2048, 0, 0}; pg8::StaticOrder S10; S10.init(NTOK, DFF, 2048, G, bx);
    SEAM_PF(9, (pg8::gemm_prefetch_b<true>(lds, g10, S10)));
    if (IN(10)) { EpiRelu2 E{Ub, ROWSS + 2 * NTOK, SW + 3 * DFF}; pg8::gemm_phase<EpiRelu2, pg8::StaticOrder, true, 4, !MK_PER_PHASE>(lds, g10, S10, E); }
    pg8::Gemm g11{Ub, W_M2 + (size_t)2048 * DFF, NTOK, DM, DFF, DFF, DFF, 0, 0}; pg8::StaticOrder S11; S11.init(NTOK, DM, DFF, G, bx, 192);
    SEAM_PF(10, (pg8::gemm_prefetch_b<true>(lds, g11, S11)));
    if (IN(11)) { EpiFinal E{XA, XA + (size_t)NTOK_P * DM, args.out, MOD + NMODC + 5 * 2048, args.in[22], ROWSS + 3 * NTOK, (unsigned*)(args.ws + WS_CTL) + CW_FIN};
        pg8::gemm_phase<EpiFinal, pg8::StaticOrder, true, 3, !MK_PER_PHASE>(lds, g11, S11, E); }
    STAMP(12);
    if (PROBE_PH >= 0 && bx == PROBE_BX && tid == 0) { STAMP(13); const unsigned d = (MISC[PROBE_B] - MISC[PROBE_A]) * PROBE_K, t0 = (unsigned)__builtin_amdgcn_s_memrealtime();
        while ((unsigned)__builtin_amdgcn_s_memrealtime() - t0 < d) __builtin_amdgcn_s_sleep(8); }
#undef IN
#undef SEAM
#undef SEAM_PF
#undef STAMP
#undef IDLE_FIRST
#undef lane
#undef W_IN
#undef W_OUT
#undef W_POOL
#undef W_M1
#undef W_M2
#undef Hb
#undef ZB
#undef LFb
#undef A2
#undef XA
#undef X1B
#undef Ub
#undef MOD
#undef ROWSS
#undef SW
}

extern "C" void kernel_launch(void* const* d_in, const int* in_sizes, int n_in, void* d_out, int out_size, void* d_ws, size_t ws_size, hipStream_t stream) {
    static int grid = 0;
    if (grid == 0) {
        if (n_in != 23 || out_size != 18874368 || ws_size < WS_END) { fprintf(stderr, "kernel_launch: unexpected shapes (n_in %d out %d ws %zu)\n", n_in, out_size, ws_size); grid = -1; return; }
        int dev = 0, cus = 0;
        if (hipGetDevice(&dev) != hipSuccess || hipDeviceGetAttribute(&cus, hipDeviceAttributeMultiprocessorCount, dev) != hipSuccess) { grid = -1; return; }
        if (hipFuncSetAttribute((const void*)fwd_kernel, hipFuncAttributeMaxDynamicSharedMemorySize, LDS_BYTES) != hipSuccess) { fprintf(stderr, "kernel_launch: hipFuncSetAttribute failed\n"); grid = -1; return; }
        int per_cu = 0;
        if (hipOccupancyMaxActiveBlocksPerMultiprocessor(&per_cu, (const void*)fwd_kernel, NWAVES * 64, LDS_BYTES) != hipSuccess || per_cu < 1) fprintf(stderr, "kernel_launch: occupancy query says %d\n", per_cu);
        (void)hipGetLastError();
        if (cus != 256) { fprintf(stderr, "kernel_launch: built for a 256-CU device, found %d CUs\n", cus); grid = -1; return; }
        grid = cus;
    }
    if (grid < 0) return;
    (void)hipMemsetAsync((char*)d_ws + WS_CTL, 0, CTL_ZERO_BYTES, stream);
    Args a{};
    for (int i = 0; i < 23; ++i) a.in[i] = (const float*)d_in[i];
    a.out = (float*)d_out; a.ws = (unsigned char*)d_ws;
#if MK_PER_PHASE
    for (int p = 0; p < N_PHASES; ++p) { a.ph_lo = p; a.ph_hi = p + 1; hipLaunchKernelGGL(fwd_kernel, dim3(grid), dim3(NWAVES * 64), LDS_BYTES, stream, a);
        if (p == REP_PHASE) hipLaunchKernelGGL(fwd_kernel, dim3(grid), dim3(NWAVES * 64), LDS_BYTES, stream, a); }
#else
    a.ph_lo = 0; a.ph_hi = N_PHASES;
    hipLaunchKernelGGL(fwd_kernel, dim3(grid), dim3(NWAVES * 64), LDS_BYTES, stream, a);
#endif
}
```
